# Optimizing an MI355X kernel written in HIP

```python
import math
import jax, jax.numpy as jnp
from jax import lax
import numpy as np

D_MODEL = 1024
BATCH = 1
SEQ = 16384
DEPTH = 1

D_MIX = D_MODEL
D_CONV = D_MIX // 2
CONV_WIDTH = 31
N_HEADS = 8
N_KV = 2
HPG = N_HEADS // N_KV
HEAD_DIM = 64
D_ATT = N_HEADS * HEAD_DIM
D_KV = N_KV * HEAD_DIM
N_GATES = 3
D_IN = 2 * D_CONV + D_ATT + 6 * D_KV + N_GATES * N_HEADS
CMP_LEN = 32
CMP_STRIDE = 16
CMP_HIDDEN = 128
SLC_LEN = 64
SLC_TOPK = 16
WINDOW = 512
Q_BLOCK = 128
FORCE_SCORE = 1.0e4
N_BUCKETS = 32
MAX_DIST = 128
D_FF = 2816
FFN_RES = 0.5
EPS = 1e-6

kernel_name = "hymba_conformer_nsa_macaron_block"


def rmsnorm(x, g):
    xf = x.astype(jnp.float32)
    y = xf * lax.rsqrt(jnp.mean(xf * xf, -1, keepdims=True) + EPS)
    return (y * g.astype(jnp.float32)).astype(x.dtype)


def layernorm(x, g, b):
    xf = x.astype(jnp.float32)
    mu = jnp.mean(xf, -1, keepdims=True)
    var = jnp.mean(jnp.square(xf - mu), -1, keepdims=True)
    y = (xf - mu) * lax.rsqrt(var + EPS)
    return (y * g.astype(jnp.float32) + b.astype(jnp.float32)).astype(x.dtype)


def modulate(h, shift, scale):
    return h * (1.0 + scale[:, None, :]) + shift[:, None, :]


def swiglu(h, w_gu, w_down):
    g, u = jnp.split(h @ w_gu, 2, axis=-1)
    return (jax.nn.silu(g) * u) @ w_down


def t5_bucket(dist):
    max_exact = N_BUCKETS // 2
    d = jnp.maximum(dist, 0)
    df = jnp.maximum(d, 1).astype(jnp.float32)
    large = max_exact + (jnp.log(df / max_exact) / math.log(MAX_DIST / max_exact)
                         * (N_BUCKETS - max_exact)).astype(jnp.int32)
    large = jnp.minimum(large, N_BUCKETS - 1)
    return jnp.where(d < max_exact, d, large)


def masked_softmax(logits, mask):
    s = jnp.where(mask, logits.astype(jnp.float32), -1e30)
    m = jnp.max(s, -1, keepdims=True)
    p = jnp.exp(s - m) * mask
    return p / jnp.maximum(jnp.sum(p, -1, keepdims=True), 1e-30)


def conformer_conv(u, w_dw, b_dw, ln_g, ln_b):
    a, gt = jnp.split(u, 2, axis=-1)
    h = a * jax.nn.sigmoid(gt)
    hp = jnp.pad(h, ((0, 0), (CONV_WIDTH - 1, 0), (0, 0)))
    y = lax.conv_general_dilated(hp, w_dw[:, None, :], window_strides=(1,), padding='VALID',
                                 dimension_numbers=('NWC', 'WIO', 'NWC'),
                                 feature_group_count=D_CONV) + b_dw
    return jax.nn.silu(layernorm(y, ln_g, ln_b))


def compress(kv, pe, w1, w2):
    b = kv.shape[0]
    n_cmp = (SEQ - CMP_LEN) // CMP_STRIDE + 1
    idx = jnp.arange(n_cmp)[:, None] * CMP_STRIDE + jnp.arange(CMP_LEN)[None, :]
    blk = kv[:, idx] + pe[None, None, :, None, :]
    blk = jnp.swapaxes(blk, 2, 3).reshape(b, n_cmp, N_KV, CMP_LEN * HEAD_DIM)
    return jax.nn.silu(blk @ w1) @ w2


def nsa_attention(q, k_cmp, v_cmp, k_slc, v_slc, k_win, v_win, gates, rel_bias):
    b = q.shape[0]
    n_cmp = k_cmp.shape[1]
    n_slc = SEQ // SLC_LEN
    n_top = min(SLC_TOPK, n_slc)
    n_qb = SEQ // Q_BLOCK
    scale = HEAD_DIM ** -0.5
    tbl = rel_bias.reshape(N_KV, HPG, N_BUCKETS)
    g_ix = jnp.arange(N_KV)[None, :, None, None, None]
    h_ix = jnp.arange(HPG)[None, None, :, None, None]
    cmp_start = jnp.arange(n_cmp) * CMP_STRIDE
    cmp_end = cmp_start + CMP_LEN - 1
    slc_start = jnp.arange(n_slc) * SLC_LEN
    overlap = ((cmp_start[:, None] < slc_start[None, :] + SLC_LEN)
               & (cmp_start[:, None] + CMP_LEN > slc_start[None, :])).astype(jnp.float32)
    k_slc_t = jnp.swapaxes(k_slc, 1, 2)
    v_slc_t = jnp.swapaxes(v_slc, 1, 2)
    pad = ((0, 0), (WINDOW, 0), (0, 0), (0, 0))
    k_win_p = jnp.pad(k_win, pad)
    v_win_p = jnp.pad(v_win, pad)
    blk_off = jnp.arange(SLC_LEN)
    win_off = jnp.arange(WINDOW + Q_BLOCK)

    def one_block(qb):
        q0 = qb * Q_BLOCK
        t = q0 + jnp.arange(Q_BLOCK)
        qq = lax.dynamic_slice_in_dim(q, q0, Q_BLOCK, 1)
        d_c = t[:, None] - cmp_end[None, :]
        s = jnp.einsum('bqghd,bngd->bghqn', qq, k_cmp) * scale + tbl[:, :, t5_bucket(d_c)]
        p_c = masked_softmax(s, d_c >= 0)
        o_c = jnp.einsum('bghqn,bngd->bqghd', p_c, v_cmp)
        imp = jnp.einsum('bghqn,nj->bgqj', p_c, overlap)
        cur = (t // SLC_LEN)[:, None]
        jj = jnp.arange(n_slc)[None, :]
        forced = (jj == 0) | (jj == cur) | (jj == cur - 1)
        score = jnp.where(forced, FORCE_SCORE, jnp.where(jj <= cur, imp, -1.0))
        _, sel = lax.top_k(score, n_top)
        pos = (sel[..., None] * SLC_LEN + blk_off).reshape(b, N_KV, Q_BLOCK, n_top * SLC_LEN)
        flat = pos.reshape(b, N_KV, Q_BLOCK * n_top * SLC_LEN, 1)
        k_g = jnp.take_along_axis(k_slc_t, flat, axis=2).reshape(b, N_KV, Q_BLOCK, n_top * SLC_LEN, HEAD_DIM)
        v_g = jnp.take_along_axis(v_slc_t, flat, axis=2).reshape(b, N_KV, Q_BLOCK, n_top * SLC_LEN, HEAD_DIM)
        d_s = t[None, None, :, None] - pos
        s = jnp.einsum('bqghd,bgqkd->bghqk', qq, k_g) * scale
        s = s + tbl[g_ix, h_ix, t5_bucket(d_s)[:, :, None]]
        p_s = masked_softmax(s, (d_s >= 0)[:, :, None])
        o_s = jnp.einsum('bghqk,bgqkd->bqghd', p_s, v_g)
        k_wb = lax.dynamic_slice_in_dim(k_win_p, q0, WINDOW + Q_BLOCK, 1)
        v_wb = lax.dynamic_slice_in_dim(v_win_p, q0, WINDOW + Q_BLOCK, 1)
        kpos = q0 - WINDOW + win_off
        d_w = t[:, None] - kpos[None, :]
        m_w = (d_w >= 0) & (d_w < WINDOW) & (kpos[None, :] >= 0)
        s = jnp.einsum('bqghd,bkgd->bghqk', qq, k_wb) * scale + tbl[:, :, t5_bucket(d_w)]
        p_w = masked_softmax(s, m_w)
        o_w = jnp.einsum('bghqk,bkgd->bqghd', p_w, v_wb)
        g = jax.nn.sigmoid(lax.dynamic_slice_in_dim(gates, q0, Q_BLOCK, 1).astype(jnp.float32))
        return g[..., 0:1] * o_c + g[..., 1:2] * o_s + g[..., 2:3] * o_w

    o = lax.map(one_block, jnp.arange(n_qb))
    return jnp.moveaxis(o, 0, 1).reshape(b, SEQ, D_ATT)


def setup_inputs(seed: int = 0) -> dict:
    key = jax.random.key(seed)
    ks = jax.random.split(key, 32)
    L = DEPTH

    def nrm(k, shape, s):
        return jax.random.normal(k, shape, jnp.float32) * s

    return {
        "x": nrm(ks[0], (BATCH, SEQ, D_MODEL), 1.0),
        "c": nrm(ks[1], (BATCH, D_MODEL), 1.0),
        "w_ada": nrm(ks[2], (L, D_MODEL, 9 * D_MODEL), D_MODEL ** -0.5),
        "b_ada": nrm(ks[3], (L, 9 * D_MODEL), 0.01),
        "g_ffn1": 1.0 + nrm(ks[4], (L, D_MODEL), 0.02),
        "w_gu1": nrm(ks[5], (L, D_MODEL, 2 * D_FF), D_MODEL ** -0.5),
        "w_down1": nrm(ks[6], (L, D_FF, D_MODEL), D_FF ** -0.5),
        "g_mix": 1.0 + nrm(ks[7], (L, D_MODEL), 0.02),
        "w_in": nrm(ks[8], (L, D_MODEL, D_IN), D_MODEL ** -0.5),
        "w_dw": nrm(ks[9], (L, CONV_WIDTH, D_CONV), CONV_WIDTH ** -0.5),
        "b_dw": nrm(ks[10], (L, D_CONV), 0.01),
        "ln_g": 1.0 + nrm(ks[11], (L, D_CONV), 0.02),
        "ln_b": nrm(ks[12], (L, D_CONV), 0.01),
        "pe_k": nrm(ks[13], (L, CMP_LEN, HEAD_DIM), 0.1),
        "pe_v": nrm(ks[14], (L, CMP_LEN, HEAD_DIM), 0.1),
        "w_ck1": nrm(ks[15], (L, CMP_LEN * HEAD_DIM, CMP_HIDDEN), (CMP_LEN * HEAD_DIM) ** -0.5),
        "w_ck2": nrm(ks[16], (L, CMP_HIDDEN, HEAD_DIM), CMP_HIDDEN ** -0.5),
        "w_cv1": nrm(ks[17], (L, CMP_LEN * HEAD_DIM, CMP_HIDDEN), (CMP_LEN * HEAD_DIM) ** -0.5),
        "w_cv2": nrm(ks[18], (L, CMP_HIDDEN, HEAD_DIM), CMP_HIDDEN ** -0.5),
        "rel_bias": nrm(ks[19], (N_HEADS, N_BUCKETS), 0.5),
        "w_out": nrm(ks[20], (L, D_MIX, D_MODEL), D_MIX ** -0.5),
        "g_ffn2": 1.0 + nrm(ks[21], (L, D_MODEL), 0.02),
        "w_gu2": nrm(ks[22], (L, D_MODEL, 2 * D_FF), D_MODEL ** -0.5),
        "w_down2": nrm(ks[23], (L, D_FF, D_MODEL), D_FF ** -0.5),
        "g_final": 1.0 + nrm(ks[24], (D_MODEL,), 0.02),
    }


def reference(x, c, w_ada, b_ada, g_ffn1, w_gu1, w_down1, g_mix, w_in, w_dw, b_dw, ln_g, ln_b,
              pe_k, pe_v, w_ck1, w_ck2, w_cv1, w_cv2, rel_bias, w_out, g_ffn2, w_gu2, w_down2,
              g_final):
    b = x.shape[0]
    splits = [2 * D_CONV, 2 * D_CONV + D_ATT]
    splits += [splits[-1] + D_KV * (i + 1) for i in range(6)]
    for l in range(DEPTH):
        mod = jax.nn.silu(c) @ w_ada[l] + b_ada[l]
        sh1, sc1, gt1, sh2, sc2, gt2, sh3, sc3, gt3 = jnp.split(mod, 9, axis=-1)
        h = modulate(rmsnorm(x, g_ffn1[l]), sh1, sc1)
        x = x + FFN_RES * gt1[:, None, :] * swiglu(h, w_gu1[l], w_down1[l])
        h = modulate(rmsnorm(x, g_mix[l]), sh2, sc2)
        u = h @ w_in[l]
        u_conv, q, kc, vc, ksl, vsl, kw, vw, gl = jnp.split(u, splits, axis=-1)
        y_conv = conformer_conv(u_conv, w_dw[l], b_dw[l], ln_g[l], ln_b[l])
        to_kv = lambda a: a.reshape(b, SEQ, N_KV, HEAD_DIM)
        k_cmp = compress(to_kv(kc), pe_k[l], w_ck1[l], w_ck2[l])
        v_cmp = compress(to_kv(vc), pe_v[l], w_cv1[l], w_cv2[l])
        y_att = nsa_attention(q.reshape(b, SEQ, N_KV, HPG, HEAD_DIM), k_cmp, v_cmp,
                              to_kv(ksl), to_kv(vsl), to_kv(kw), to_kv(vw),
                              gl.reshape(b, SEQ, N_KV, HPG, N_GATES), rel_bias).astype(x.dtype)
        y = jnp.concatenate([y_conv, y_att], axis=-1)
        x = x + gt2[:, None, :] * (y @ w_out[l])
        h = modulate(rmsnorm(x, g_ffn2[l]), sh3, sc3)
        x = x + FFN_RES * gt3[:, None, :] * swiglu(h, w_gu2[l], w_down2[l])
    return rmsnorm(x, g_final)
```

```cpp
#include <hip/hip_runtime.h>
#include <cstdio>
#include <cstdint>
namespace pg8 {
#define PG8_LAS __attribute__((address_space(3)))
typedef unsigned short bf16_t;
typedef short bf16x8 __attribute__((ext_vector_type(8)));
typedef float f32x4 __attribute__((ext_vector_type(4)));
typedef unsigned u32x4 __attribute__((ext_vector_type(4)));
constexpr int BM = 256, BK = 64, HALF = 128, HTB = HALF * BK * 2  , STAGE_BYTES = 8 * HTB, NXCD = 8, WGM = 8;

__host__ __device__ __forceinline__ int lds_byte(int r, int c) { const int st = (r >> 4) * 2 + (c >> 5), rr = r & 15, cc = c & 31, ob = rr * 64 + cc * 2; return st * 1024 + (ob ^ (((ob >> 9) & 1) << 5)); }
__host__ __device__ __forceinline__ void stage_rc(int b, int& R, int& C) { const int st = b / 1024, sb = b % 1024, swz = sb ^ (((sb >> 9) & 1) << 5); R = (st >> 1) * 16 + swz / 64; C = (st & 1) * 32 + (swz % 64) / 2; }
__host__ __device__ __forceinline__ int perm32(int rho) { const int n = rho >> 4, i = rho & 15; return 8 * (i >> 2) + 4 * n + (i & 3); }

struct Unit { int pm, pn; };
struct Gemm { const bf16_t* A; const bf16_t* Bt; int M, N, K; };

struct StaticOrder {
    int nM, nN, nwg, G, c;
    __host__ __device__ void init(int M, int N, int G_, int c_) { nM = M / BM; nN = N / BM; nwg = nM * nN; G = G_; c = c_; }
    __host__ __device__ bool next(int i, Unit& u) const {
        const long L = (long)i * G + c; if (L >= nwg) return false;
        int wgid = (int)L; { const int q = nwg / NXCD, r = nwg % NXCD, xcd = wgid % NXCD, off = wgid / NXCD; wgid = (xcd < r ? xcd * (q + 1) : r * (q + 1) + (xcd - r) * q) + off; }
        const int nig = WGM * nN, gid = wgid / nig, fm = gid * WGM, gsz = (nM - fm) < WGM ? (nM - fm) : WGM;
        u.pm = fm + ((wgid % nig) % gsz); u.pn = (wgid % nig) / gsz; return true;
    }
    __device__ __forceinline__ void a_ready(const Unit&) const {}
    __device__ __forceinline__ void done(const Unit&) const {}
};


__device__ __forceinline__ unsigned cvt_pk_bf16(float lo, float hi) { unsigned r; asm volatile("v_cvt_pk_bf16_f32 %0, %1, %2" : "=v"(r) : "v"(lo), "v"(hi)); return r; }
__device__ __forceinline__ float sigmoid_f(float x) { return __builtin_amdgcn_rcpf(1.0f + __builtin_amdgcn_exp2f(-1.4426950408889634f * x)); }
__device__ __forceinline__ float silu_f(float x) { return x * sigmoid_f(x); }

template <bool GLU> __device__ __forceinline__ void gated_store(const f32x4 (&acc)[2][2][4][2], bf16_t* O, int ldc, int row0, int col0) {
#pragma unroll
    for (int ai = 0; ai < 2; ++ai)
#pragma unroll
        for (int m = 0; m < 4; ++m) { bf16_t* rowp = O + (size_t)(row0 + ai * HALF + m * 16) * ldc + col0;
            float v[8];
#pragma unroll
            for (int n = 0; n < 2; ++n)
#pragma unroll
                for (int e = 0; e < 4; ++e) { const float a = acc[ai][0][m][n][e], b = acc[ai][1][m][n][e]; v[n * 4 + e] = GLU ? a * sigmoid_f(b) : silu_f(a) * b; }
            u32x4 w; w.x = cvt_pk_bf16(v[0], v[1]); w.y = cvt_pk_bf16(v[2], v[3]); w.z = cvt_pk_bf16(v[4], v[5]); w.w = cvt_pk_bf16(v[6], v[7]);
            *(u32x4*)rowp = w; }
}
struct EpiSwiGLU {
    static constexpr bool PERM = true, AFTER_DRAIN = false;
    bf16_t* O; int ldc;
    __device__ __forceinline__ void operator()(const f32x4 (&acc)[2][2][4][2], const Unit& u, int wr, int wc, int fr, int fq) const {
        gated_store<false>(acc, O, ldc, u.pm * BM + wr * 64 + fr, u.pn * HALF + wc * 32 + 8 * fq);
    }
};
struct EpiResid {
    static constexpr bool PERM = false, AFTER_DRAIN = false;
    const float* base; float* out; int ldc; const float* gate; float scale;
    __device__ __forceinline__ void operator()(const f32x4 (&acc)[2][2][4][2], const Unit& u, int wr, int wc, int fr, int fq) const {
        const int col0 = u.pn * BM + wc * 32 + 4 * fq, row0 = u.pm * BM + wr * 64 + fr;
        f32x4 cf[2][2];
#pragma unroll
        for (int bj = 0; bj < 2; ++bj)
#pragma unroll
            for (int n = 0; n < 2; ++n) cf[bj][n] = *(const f32x4*)(gate + col0 + bj * HALF + n * 16) * scale;
#pragma unroll
        for (int ai = 0; ai < 2; ++ai)
#pragma unroll
            for (int m = 0; m < 4; ++m) { const size_t off = (size_t)(row0 + ai * HALF + m * 16) * ldc + col0;
#pragma unroll
                for (int bj = 0; bj < 2; ++bj)
#pragma unroll
                    for (int n = 0; n < 2; ++n) { const f32x4 bs = *(const f32x4*)(base + off + bj * HALF + n * 16); *(f32x4*)(out + off + bj * HALF + n * 16) = bs + cf[bj][n] * acc[ai][bj][m][n]; }
                if (m & 1) asm volatile("" ::: "memory"); }
    }
};
struct EpiMix {
    static constexpr bool PERM = true, AFTER_DRAIN = false;
    bf16_t* HG; bf16_t* Q; bf16_t* KV; float* GT;
    __device__ __forceinline__ void operator()(const f32x4 (&acc)[2][2][4][2], const Unit& u, int wr, int wc, int fr, int fq) const {
        const int row0 = u.pm * BM + wr * 64 + fr, c8 = wc * 32 + 8 * fq;
        if (u.pn < 4) { gated_store<true>(acc, HG, 512, row0, u.pn * HALF + c8); return; }
        if (u.pn == 9) {
            if (c8 < 24) {
#pragma unroll
                for (int ai = 0; ai < 2; ++ai)
#pragma unroll
                    for (int m = 0; m < 4; ++m) { float* rowp = GT + (size_t)(row0 + ai * HALF + m * 16) * 24 + c8;
#pragma unroll
                        for (int n = 0; n < 2; ++n) { const f32x4 a = acc[ai][0][m][n]; *(f32x4*)(rowp + 4 * n) = (f32x4){sigmoid_f(a[0]), sigmoid_f(a[1]), sigmoid_f(a[2]), sigmoid_f(a[3])}; } }
            }
            return;
        }
        bf16_t* O; int ldc, colt; float sc;
        if (u.pn < 6) { O = Q; ldc = 512; colt = (u.pn - 4) * BM; sc = 0.125f; } else { O = KV; ldc = 768; colt = (u.pn - 6) * BM; sc = 1.0f; }
#pragma unroll
        for (int ai = 0; ai < 2; ++ai)
#pragma unroll
            for (int m = 0; m < 4; ++m) { bf16_t* rowp = O + (size_t)(row0 + ai * HALF + m * 16) * ldc + colt + c8;
#pragma unroll
                for (int bj = 0; bj < 2; ++bj) { const f32x4 v0 = acc[ai][bj][m][0] * sc, v1 = acc[ai][bj][m][1] * sc;
                    u32x4 w; w.x = cvt_pk_bf16(v0[0], v0[1]); w.y = cvt_pk_bf16(v0[2], v0[3]); w.z = cvt_pk_bf16(v1[0], v1[1]); w.w = cvt_pk_bf16(v1[2], v1[3]);
                    *(u32x4*)(rowp + bj * HALF) = w; } }
    }
};

template <class Epi, class Sched, bool ALIGN_EPI = false, bool SP2 = false>
__device__ __forceinline__ void gemm_phase(PG8_LAS unsigned char* lds, const Gemm g, const Sched& S, const Epi& E) {
    const int tid = threadIdx.x, wid = __builtin_amdgcn_readfirstlane(tid >> 6), lane = tid & 63, wr = wid >> 2, wc = wid & 3, fr = lane & 15, fq = lane >> 4;
    const int K = g.K, nt = K / BK;
    unsigned voffA[2], voffB[2];
#pragma unroll
    for (int i = 0; i < 2; ++i) { int R, C; stage_rc(tid * 16 + i * 8192, R, C); const int Rb = Epi::PERM ? ((R & ~31) + perm32(R & 31)) : R;
        voffA[i] = (unsigned)(R * K + C) * 2u; voffB[i] = (unsigned)(Rb * K + C) * 2u; }
    const size_t kstep = (size_t)(BK * 2);
    const size_t hstep = (size_t)HALF * K * 2;
    const size_t tstep = 2 * hstep;
    const unsigned ldsw = (unsigned)wid * 1024u;
    const int aoff = lds_byte(wr * 64 + fr, fq * 8), boff = lds_byte(wc * 32 + fr, fq * 8);
#define PG8_SA(b, h) (((b) * 2 + (h)) * HTB)
#define PG8_SB(b, h) ((4 + (b) * 2 + (h)) * HTB)
#define PG8_STAGE(bufoff, gbase, voff) do { _Pragma("unroll") for (int _i = 0; _i < 2; ++_i) \
        __builtin_amdgcn_global_load_lds((const unsigned*)((const char*)(gbase) + (voff)[_i]), (PG8_LAS unsigned*)(lds + (bufoff) + ldsw + _i * 8192), 16, 0, 0); } while (0)
#define PG8_LDA(dst, b, h) do { _Pragma("unroll") for (int m = 0; m < 4; ++m) _Pragma("unroll") for (int k = 0; k < 2; ++k) dst[m][k] = *(const PG8_LAS bf16x8*)(lds + PG8_SA(b, h) + aoff + m * 2048 + k * 1024); } while (0)
#define PG8_LDB(dst, b, h) do { _Pragma("unroll") for (int n = 0; n < 2; ++n) _Pragma("unroll") for (int k = 0; k < 2; ++k) dst[n][k] = *(const PG8_LAS bf16x8*)(lds + PG8_SB(b, h) + boff + n * 2048 + k * 1024); } while (0)
#define PG8_MMA(ai, bj, At, Bt) do { __builtin_amdgcn_s_setprio(1); _Pragma("unroll") for (int m = 0; m < 4; ++m) _Pragma("unroll") for (int n = 0; n < 2; ++n) _Pragma("unroll") for (int k = 0; k < 2; ++k) \
        acc[ai][bj][m][n] = __builtin_amdgcn_mfma_f32_16x16x32_bf16(Bt[n][k], At[m][k], acc[ai][bj][m][n], 0, 0, 0); __builtin_amdgcn_s_setprio(0); } while (0)
#define PG8_WAIT_V(n) asm volatile("s_waitcnt vmcnt(" #n ")" ::: "memory")
#define PG8_WAIT_L(n) asm volatile("s_waitcnt lgkmcnt(" #n ")" ::: "memory")
#define PG8_BAR __builtin_amdgcn_s_barrier()
#define PG8_SCHED __builtin_amdgcn_sched_barrier(0)
    Unit cur, nxt; int ui = 0;
    if (!S.next(0, cur)) return;
    f32x4 acc[2][2][4][2];
#pragma unroll
    for (int a = 0; a < 2; ++a)
#pragma unroll
        for (int b = 0; b < 2; ++b)
#pragma unroll
            for (int m = 0; m < 4; ++m)
#pragma unroll
                for (int n = 0; n < 2; ++n) acc[a][b][m][n] = (f32x4){0.f, 0.f, 0.f, 0.f};
    bf16x8 At[4][2], B0[2][2], B1[2][2];
    const char* cA = (const char*)g.A + (size_t)cur.pm * tstep; const char* cB = (const char*)g.Bt + (size_t)cur.pn * tstep;
    S.a_ready(cur);
    if constexpr (SP2) {
        PG8_STAGE(PG8_SB(0, 0), cB, voffB); PG8_STAGE(PG8_SB(0, 1), cB + hstep, voffB); PG8_STAGE(PG8_SA(0, 0), cA, voffA); PG8_STAGE(PG8_SA(0, 1), cA + hstep, voffA);
        if (wr == 1) PG8_BAR;
        PG8_WAIT_V(2); PG8_BAR;
        PG8_STAGE(PG8_SB(1, 0), cB + kstep, voffB); PG8_STAGE(PG8_SA(1, 0), cA + kstep, voffA); PG8_STAGE(PG8_SB(1, 1), cB + hstep + kstep, voffB);
        PG8_WAIT_V(6); PG8_BAR;
    } else {
        PG8_STAGE(PG8_SB(0, 0), cB, voffB); PG8_STAGE(PG8_SA(0, 0), cA, voffA); PG8_STAGE(PG8_SB(0, 1), cB + hstep, voffB); PG8_STAGE(PG8_SA(0, 1), cA + hstep, voffA);
        if (wr == 1) PG8_BAR;
        PG8_WAIT_V(4); PG8_BAR;
        PG8_STAGE(PG8_SB(1, 0), cB + kstep, voffB); PG8_STAGE(PG8_SA(1, 0), cA + kstep, voffA); PG8_STAGE(PG8_SB(1, 1), cB + hstep + kstep, voffB);
        PG8_WAIT_V(6); PG8_BAR;
    }
    for (;;) {
        const bool has_next = S.next(ui + 1, nxt);
        const char* nA = has_next ? (const char*)g.A + (size_t)nxt.pm * tstep : cA; const char* nB = has_next ? (const char*)g.Bt + (size_t)nxt.pn * tstep : cB;
        for (int t = 0; t < nt; t += 2) {
            const bool last = (t == nt - 2);
            const char* a1 = cA + (size_t)(t + 1) * kstep;
            const char* a2 = last ? nA : cA + (size_t)(t + 2) * kstep; const char* b2 = last ? nB : cB + (size_t)(t + 2) * kstep;
            const char* a3 = a2 + kstep; const char* b3 = b2 + kstep;
            if (last && has_next) S.a_ready(nxt);
            if constexpr (SP2) {
            PG8_LDB(B0, 0, 0); PG8_LDB(B1, 0, 1); PG8_SCHED; PG8_LDA(At, 0, 0); PG8_STAGE(PG8_SA(1, 1), a1 + hstep, voffA);
            PG8_WAIT_V(8); PG8_WAIT_L(0); PG8_BAR; PG8_MMA(0, 0, At, B0); PG8_MMA(0, 1, At, B1); PG8_BAR; PG8_SCHED;
            PG8_LDA(At, 0, 1); PG8_STAGE(PG8_SB(0, 0), b2, voffB); PG8_STAGE(PG8_SB(0, 1), b2 + hstep, voffB); PG8_STAGE(PG8_SA(0, 0), a2, voffA);
            PG8_WAIT_V(8); PG8_WAIT_L(0); PG8_BAR; PG8_MMA(1, 0, At, B0); PG8_MMA(1, 1, At, B1); PG8_BAR; PG8_SCHED;
            PG8_LDB(B0, 1, 0); PG8_LDB(B1, 1, 1); PG8_SCHED; PG8_LDA(At, 1, 0); PG8_STAGE(PG8_SA(0, 1), a2 + hstep, voffA);
            PG8_WAIT_V(8); PG8_WAIT_L(0); PG8_BAR; PG8_MMA(0, 0, At, B0); PG8_MMA(0, 1, At, B1); PG8_BAR; PG8_SCHED;
            PG8_LDA(At, 1, 1); PG8_STAGE(PG8_SB(1, 0), b3, voffB); PG8_STAGE(PG8_SB(1, 1), b3 + hstep, voffB); PG8_STAGE(PG8_SA(1, 0), a3, voffA);
            PG8_WAIT_V(8); PG8_WAIT_L(0); PG8_BAR; PG8_MMA(1, 0, At, B0); PG8_MMA(1, 1, At, B1); PG8_BAR; PG8_SCHED;
            } else {
            PG8_LDB(B0, 0, 0); PG8_SCHED; PG8_LDA(At, 0, 0); PG8_STAGE(PG8_SA(1, 1), a1 + hstep, voffA);
            PG8_WAIT_L(8); PG8_BAR; PG8_WAIT_L(0); PG8_MMA(0, 0, At, B0); PG8_BAR; PG8_SCHED;
            PG8_LDB(B1, 0, 1); PG8_STAGE(PG8_SB(0, 0), b2, voffB);
            PG8_BAR; PG8_WAIT_L(0); PG8_MMA(0, 1, At, B1); PG8_BAR;
            PG8_LDA(At, 0, 1); PG8_STAGE(PG8_SA(0, 0), a2, voffA);
            PG8_BAR; PG8_WAIT_L(0); PG8_MMA(1, 0, At, B0); PG8_BAR; PG8_SCHED;
            PG8_STAGE(PG8_SB(0, 1), b2 + hstep, voffB);
            PG8_WAIT_V(6); PG8_BAR; PG8_MMA(1, 1, At, B1); PG8_BAR;
            PG8_LDB(B0, 1, 0); PG8_SCHED; PG8_LDA(At, 1, 0); PG8_STAGE(PG8_SA(0, 1), a2 + hstep, voffA);
            PG8_WAIT_L(8); PG8_BAR; PG8_WAIT_L(0); PG8_MMA(0, 0, At, B0); PG8_BAR; PG8_SCHED;
            PG8_LDB(B1, 1, 1); PG8_STAGE(PG8_SB(1, 0), b3, voffB);
            PG8_BAR; PG8_WAIT_L(0); PG8_MMA(0, 1, At, B1); PG8_BAR;
            PG8_LDA(At, 1, 1); PG8_STAGE(PG8_SA(1, 0), a3, voffA);
            PG8_BAR; PG8_WAIT_L(0); PG8_MMA(1, 0, At, B0); PG8_BAR; PG8_SCHED;
            PG8_STAGE(PG8_SB(1, 1), b3 + hstep, voffB);
            PG8_WAIT_V(6); PG8_BAR; PG8_MMA(1, 1, At, B1); PG8_BAR;
            }
        }
        if constexpr (ALIGN_EPI) { if (wr == 0) PG8_BAR; }
        if constexpr (!Epi::AFTER_DRAIN) { E(acc, cur, wr, wc, fr, fq); S.done(cur); }
        if (!has_next) break;
#pragma unroll
        for (int a = 0; a < 2; ++a)
#pragma unroll
            for (int b = 0; b < 2; ++b)
#pragma unroll
                for (int m = 0; m < 4; ++m)
#pragma unroll
                    for (int n = 0; n < 2; ++n) acc[a][b][m][n] = (f32x4){0.f, 0.f, 0.f, 0.f};
        cur = nxt; cA = nA; cB = nB; ++ui;
        if constexpr (ALIGN_EPI) { if (wr == 1) PG8_BAR; }
    }
    PG8_WAIT_V(0);
    if constexpr (!ALIGN_EPI) { if (wr == 0) PG8_BAR; }
    PG8_BAR;
    if constexpr (Epi::AFTER_DRAIN) { E.fused(acc, cur, wr, wc, fr, fq, lds, wid, lane); S.done(cur); }
#undef PG8_SA
#undef PG8_SB
#undef PG8_STAGE
#undef PG8_LDA
#undef PG8_LDB
#undef PG8_MMA
#undef PG8_WAIT_V
#undef PG8_WAIT_L
#undef PG8_BAR
#undef PG8_SCHED
}
}
#ifndef PG8_SP2
#define PG8_SP2 true
#endif
#ifndef PG8_ALIGN
#define PG8_ALIGN true
#endif
#ifndef MK_LAUNCHES
#define MK_LAUNCHES 0
#endif

constexpr int NWAVES = 8;
constexpr int SEQ = 16384, DM = 1024, DFF = 2816, DCONV = 512, DATT = 512, NH = 8, NG = 2, HPG = 4, HD = 64;
constexpr int DIN = 2328, DIN_PAD = 2560, NCMP = 1023, CONVW = 31, CMP_HID = 128, NSLC = 256, NTOP = 16, WIN = 512;
constexpr float EPS = 1e-6f;
constexpr int N_PHASES = 13;
enum { I_X = 0, I_C, I_WADA, I_BADA, I_GFFN1, I_WGU1, I_WD1, I_GMIX, I_WIN, I_WDW, I_BDW, I_LNG, I_LNB, I_PEK, I_PEV, I_WCK1, I_WCK2, I_WCV1, I_WCV2, I_RELB, I_WOUT, I_GFFN2, I_WGU2, I_WD2, I_GFIN, N_IN };

constexpr size_t MiB = 1u << 20;
constexpr size_t WS_CTL = 0, CTL_ZERO_BYTES = 64 * 1024;
constexpr size_t WS_MODP = 1 * MiB;
constexpr size_t WS_MOD = WS_MODP + 16 * 9216 * 4;
constexpr size_t WS_KCMP = 2 * MiB, WS_VCMP = WS_KCMP + 256 * 1024;
constexpr size_t WS_WGU1 = 4 * MiB, WS_WD1 = 15 * MiB, WS_WIN = 21 * MiB, WS_WOUT = 26 * MiB, WS_WGU2 = 28 * MiB, WS_WD2 = 39 * MiB;
constexpr size_t WS_GT = 45 * MiB;
constexpr size_t WS_HB = 48 * MiB;
constexpr size_t WS_XB = 80 * MiB;
constexpr size_t WS_ACT = 144 * MiB;
constexpr size_t WS_HG = WS_ACT, WS_Q = WS_ACT + 16 * MiB, WS_KV = WS_ACT + 32 * MiB;
constexpr size_t WS_END = 232 * MiB;
static_assert(WS_WD2 + (size_t)DM * DFF * 2 <= WS_GT && WS_GT + (size_t)SEQ * 24 * 4 <= WS_HB && WS_KV + (size_t)SEQ * 768 * 2 <= WS_END && WS_ACT + (size_t)SEQ * DFF * 2 <= WS_END, "d_ws map");
constexpr int CW_BAR = 4096;
constexpr int RING_OFF = 0, RING_BYTES = 131072;
constexpr int LDSCTL_OFF = RING_BYTES, MISC_OFF = LDSCTL_OFF + 320;
constexpr int LDS_BYTES = 147456;

#define GAS __attribute__((address_space(1)))
#define LAS __attribute__((address_space(3)))
typedef unsigned short bf16;
typedef unsigned v4u __attribute__((ext_vector_type(4)));
typedef unsigned v2u __attribute__((ext_vector_type(2)));
typedef float f32x4 __attribute__((ext_vector_type(4)));
typedef float f32x2 __attribute__((ext_vector_type(2)));
typedef short bf16x8 __attribute__((ext_vector_type(8)));
typedef GAS unsigned gu32;
#define RLX_AGENT __ATOMIC_RELAXED, __HIP_MEMORY_SCOPE_AGENT
__device__ __forceinline__ unsigned f2bf(float f) { unsigned u = __builtin_bit_cast(unsigned, f); return (u + 0x7fffu + ((u >> 16) & 1u)) >> 16; }
__device__ __forceinline__ unsigned pk2(float lo, float hi) { return f2bf(lo) | (f2bf(hi) << 16); }
__device__ __forceinline__ float bflo(unsigned w) { return __uint_as_float(w << 16); }
__device__ __forceinline__ float bfhi(unsigned w) { return __uint_as_float(w & 0xffff0000u); }
__device__ __forceinline__ float bf2f(bf16 b) { return __uint_as_float((unsigned)b << 16); }
__device__ __forceinline__ float sigmoid_f(float x) { return __builtin_amdgcn_rcpf(1.0f + __builtin_amdgcn_exp2f(-1.4426950408889634f * x)); }
__device__ __forceinline__ float silu_f(float x) { return x * sigmoid_f(x); }
__device__ __forceinline__ float wave_sum(float v) {
#pragma unroll
    for (int o = 1; o < 64; o <<= 1) v += __shfl_xor(v, o);
    return v;
}
__device__ __forceinline__ float wave_max(float v) {
#pragma unroll
    for (int o = 1; o < 64; o <<= 1) v = fmaxf(v, __shfl_xor(v, o));
    return v;
}

#define XB_TMO      128
#define XB_XCNT(j)  (256  + 64 * (j))
#define XB_XSUB(j)  (1280 + 64 * (j))
#define XB_XGEN(j)  (2304 + 64 * (j))
#define XB_TOP      3328
#define XB_TOPGEN   3392
#define XCD_BAR_WORDS 3456
#define XB_SPIN_CAP (1u << 18)
static_assert((CW_BAR + XCD_BAR_WORDS) * 4 <= (int)CTL_ZERO_BYTES, "barrier words inside the memset region");

__device__ __forceinline__ unsigned xb_ld(unsigned* p)              { return __hip_atomic_load(p, __ATOMIC_RELAXED, __HIP_MEMORY_SCOPE_AGENT); }
__device__ __forceinline__ unsigned xb_add(unsigned* p, unsigned v) { return __hip_atomic_fetch_add(p, v, __ATOMIC_RELAXED, __HIP_MEMORY_SCOPE_AGENT); }
__device__ __forceinline__ unsigned xb_xcc_id() { return (unsigned)__builtin_amdgcn_s_getreg((3 << 11) | 20) & 0xFu; }
#define XB_SPIN(cond, bar) do { unsigned _sp = 0; while (cond) { __builtin_amdgcn_s_sleep(1); \
    if ((++_sp & 255u) == 0u) { if (xb_ld(&(bar)[XB_TMO])) break; if (_sp > XB_SPIN_CAP) { atomicAdd(&(bar)[XB_TMO], 1u); break; } } } } while (0)

struct XcdBarrier {
    unsigned* bar; unsigned x;
    volatile LAS unsigned* st;
};
__device__ __forceinline__ XcdBarrier xcd_barrier_post(unsigned* bar, volatile LAS unsigned* st) {
    XcdBarrier b; b.bar = bar; b.x = xb_xcc_id(); b.st = st;
    if (threadIdx.x == 0) (void)xb_add(&bar[XB_XCNT(b.x)], 1u);
    return b;
}
__device__ __forceinline__ void xcd_barrier_complete(unsigned* bar, unsigned x, unsigned& nloc, unsigned& nx) {
    const unsigned G = gridDim.x * gridDim.y * gridDim.z;
    unsigned sum, cnt, mine, sp = 0u;
    for (;;) {
        sum = 0u; cnt = 0u; mine = 0u;
#pragma unroll
        for (unsigned j = 0; j < 16; ++j) { const unsigned c = xb_ld(&bar[XB_XCNT(j)]); sum += c; cnt += (c > 0u) ? 1u : 0u; mine = (j == x) ? c : mine; }
        if (sum == G) break;
        __builtin_amdgcn_s_sleep(1);
        if ((++sp & 255u) == 0u) { if (xb_ld(&bar[XB_TMO])) break; if (sp > XB_SPIN_CAP) { atomicAdd(&bar[XB_TMO], 1u); break; } }
    }
    nloc = mine > 0u ? mine : 1u; nx = cnt > 0u ? cnt : 1u;
}
__device__ __forceinline__ void xcd_barrier(const XcdBarrier& b) {
    asm volatile("s_waitcnt vmcnt(0)" ::: "memory");
    __syncthreads();
    if (threadIdx.x == 0) {
        unsigned* bar = b.bar;
        __builtin_amdgcn_s_waitcnt(0);
        unsigned nloc = b.st[0], nx = b.st[1];
        if (nloc == 0u) { xcd_barrier_complete(bar, b.x, nloc, nx); b.st[0] = nloc; b.st[1] = nx; }
        const unsigned old = xb_add(&bar[XB_XSUB(b.x)], 1u);
        const unsigned gen = old / nloc;
        if (old + 1u == (gen + 1u) * nloc) {
            __builtin_amdgcn_fence(__ATOMIC_RELEASE, "agent");
            asm volatile("s_waitcnt vmcnt(0)" ::: "memory");
            const unsigned og = xb_add(&bar[XB_TOP], 1u);
            const unsigned tg = og / nx;
            if (og + 1u == (tg + 1u) * nx) xb_add(&bar[XB_TOPGEN], 1u);
            else XB_SPIN(xb_ld(&bar[XB_TOPGEN]) == tg, bar);
            __builtin_amdgcn_fence(__ATOMIC_ACQUIRE, "agent");
            xb_add(&bar[XB_XGEN(b.x)], 1u);
            asm volatile("s_waitcnt vmcnt(0)" ::: "memory");
        } else {
            XB_SPIN(xb_ld(&bar[XB_XGEN(b.x)]) == gen, bar);
            __builtin_amdgcn_fence(__ATOMIC_ACQUIRE, "agent");
            asm volatile("s_waitcnt vmcnt(0)" ::: "memory");
        }
    }
    __syncthreads();
}

struct Args { const float* in[N_IN]; float* out; unsigned char* ws; int ph_lo, ph_hi; };
static_assert(sizeof(Args) == (N_IN + 2) * 8 + 8, "Args has no padding");
struct Frame {
    LAS unsigned char* lds;
    int tid, lane, wave, G, bid;
};
#define WSP(T, off) ((T*)(a.ws + (off)))

template <int MODE> __device__ __forceinline__ int wt_row0(int n0) {
    if (MODE == 1) { const int isu = n0 >= DFF ? 1 : 0, c = n0 - isu * DFF; return 256 * (c >> 7) + 128 * isu + (c & 127); }
    if (MODE == 2) { if (n0 < 512) return 256 * (n0 >> 7) + (n0 & 127); if (n0 < 1024) { const int c = n0 - 512; return 256 * (c >> 7) + 128 + (c & 127); } return n0; }
    return n0;
}
template <int MODE> __device__ __forceinline__ void p0_transpose_item(const float* W, int K, int N, bf16* WT, LAS float* scr, int item, int lane) {
    const int nblk = (N + 31) / 32, kb = item / nblk, nb = item % nblk, k0 = 64 * kb, n0 = 32 * nb;
    const int nn = n0 + (lane & 31); const bool okn = nn < N;
#pragma unroll 8
    for (int i = 0; i < 32; ++i) { const int kk = 2 * i + (lane >> 5); scr[kk * 33 + (lane & 31)] = okn ? W[(size_t)(k0 + kk) * N + nn] : 0.f; }
    asm volatile("s_waitcnt lgkmcnt(0)" ::: "memory");
    const int c = lane & 7, r0 = wt_row0<MODE>(n0);
#pragma unroll
    for (int j = 0; j < 4; ++j) { const int n = (lane >> 3) + 8 * j; const LAS float* s = scr + (8 * c) * 33 + n;
        v4u o; o.x = pk2(s[0 * 33], s[1 * 33]); o.y = pk2(s[2 * 33], s[3 * 33]); o.z = pk2(s[4 * 33], s[5 * 33]); o.w = pk2(s[6 * 33], s[7 * 33]);
        *(v4u*)(WT + (size_t)(r0 + n) * K + k0 + 8 * c) = o; }
    asm volatile("s_waitcnt lgkmcnt(0)" ::: "memory");
}
__device__ __forceinline__ void p0_prologue(const Args& a, const Frame& F) {
    LAS float* scr = (LAS float*)(F.lds + RING_OFF + F.wave * 16384);
    const int gw = F.bid * NWAVES + F.wave, NGW = F.G * NWAVES;
    constexpr int I_GU = (DM / 64) * (2 * DFF / 32), I_D = (DFF / 64) * (DM / 32), I_IN = (DM / 64) * ((DIN + 31) / 32), I_O = (DM / 64) * (DM / 32);
    constexpr int I_MOD = 144 * 16, I_PAD = (DIN_PAD - 2336) * DM / 8 / 64;
    constexpr int NITEMS = 2 * I_GU + 2 * I_D + I_IN + I_O + I_MOD + I_PAD;
    for (int it = gw; it < NITEMS; it += NGW) {
        int r = it;
        if (r < I_MOD) {
            const int cg = r >> 4, kc = r & 15; const float* W = a.in[I_WADA] + (size_t)(kc * 64) * 9216 + cg * 64 + F.lane; const float* cv = a.in[I_C] + kc * 64;
            float s = 0.f;
#pragma unroll 16
            for (int k = 0; k < 64; ++k) s += silu_f(cv[k]) * W[(size_t)k * 9216];
            WSP(float, WS_MODP)[kc * 9216 + cg * 64 + F.lane] = s; continue; }
        r -= I_MOD;
        if (r < I_GU) { p0_transpose_item<1>(a.in[I_WGU1], DM, 2 * DFF, WSP(bf16, WS_WGU1), scr, r, F.lane); continue; } r -= I_GU;
        if (r < I_GU) { p0_transpose_item<1>(a.in[I_WGU2], DM, 2 * DFF, WSP(bf16, WS_WGU2), scr, r, F.lane); continue; } r -= I_GU;
        if (r < I_D) { p0_transpose_item<0>(a.in[I_WD1], DFF, DM, WSP(bf16, WS_WD1), scr, r, F.lane); continue; } r -= I_D;
        if (r < I_D) { p0_transpose_item<0>(a.in[I_WD2], DFF, DM, WSP(bf16, WS_WD2), scr, r, F.lane); continue; } r -= I_D;
        if (r < I_IN) { p0_transpose_item<2>(a.in[I_WIN], DM, DIN, WSP(bf16, WS_WIN), scr, r, F.lane); continue; } r -= I_IN;
        if (r < I_O) { p0_transpose_item<0>(a.in[I_WOUT], DM, DM, WSP(bf16, WS_WOUT), scr, r, F.lane); continue; } r -= I_O;
        { v4u* p = (v4u*)(WSP(bf16, WS_WIN) + (size_t)2336 * DM) + (size_t)r * 64 + F.lane; *p = (v4u){0u, 0u, 0u, 0u}; }
    }
}
template <bool FROM_PARTIALS> __device__ __forceinline__ void norm_mod_pass(const Args& a, const Frame& F, const float* src, bf16* dst, const float* gvec, int sub) {
    LAS float* CA = (LAS float*)(F.lds + RING_OFF); LAS float* CB = CA + DM;
    const float* modp = WSP(const float, WS_MODP); float* mod = WSP(float, WS_MOD); const float* bada = a.in[I_BADA];
    if (FROM_PARTIALS) {
        for (int i = F.bid * 512 + F.tid; i < 9216; i += F.G * 512) { float s = bada[i];
#pragma unroll
            for (int k = 0; k < 16; ++k) s += modp[k * 9216 + i];
            mod[i] = s; }
    }
    for (int c = F.tid; c < 2 * DM; c += 512) {
        const int i = 3 * sub * DM + c; float s;
        if (FROM_PARTIALS) { s = bada[i];
#pragma unroll
            for (int k = 0; k < 16; ++k) s += modp[k * 9216 + i]; }
        else s = mod[i];
        if (c < DM) CB[c] = s; else CA[c - DM] = gvec[c - DM] * (1.0f + s);
    }
    __syncthreads();
    const int gw = F.bid * NWAVES + F.wave, NGW = F.G * NWAVES;
    for (int m = gw; m < SEQ; m += NGW) {
        const f32x4* xr = (const f32x4*)(src + (size_t)m * DM) + F.lane;
        f32x4 v[4]; float s = 0.f;
#pragma unroll
        for (int j = 0; j < 4; ++j) { v[j] = xr[64 * j]; s += (v[j].x * v[j].x + v[j].y * v[j].y) + (v[j].z * v[j].z + v[j].w * v[j].w); }
        const float rstd = 1.0f / sqrtf(wave_sum(s) * (1.0f / DM) + EPS);
        unsigned long long* o8 = (unsigned long long*)(dst + (size_t)m * DM) + F.lane;
#pragma unroll
        for (int j = 0; j < 4; ++j) { const f32x4 ca = *(const LAS f32x4*)(CA + 256 * j + 4 * F.lane), cb = *(const LAS f32x4*)(CB + 256 * j + 4 * F.lane);
            const f32x4 h = v[j] * rstd * ca + cb;
            o8[64 * j] = (unsigned long long)pk2(h.x, h.y) | ((unsigned long long)pk2(h.z, h.w) << 32); }
    }
    __syncthreads();
}
__device__ __forceinline__ void final_norm_pass(const Args& a, const Frame& F) {
    const int gw = F.bid * NWAVES + F.wave, NGW = F.G * NWAVES; const float* g = a.in[I_GFIN];
    f32x4 gv[4];
#pragma unroll
    for (int j = 0; j < 4; ++j) gv[j] = *((const f32x4*)g + 64 * j + F.lane);
    for (int m = gw; m < SEQ; m += NGW) {
        f32x4* xr = (f32x4*)(a.out + (size_t)m * DM) + F.lane;
        f32x4 v[4]; float s = 0.f;
#pragma unroll
        for (int j = 0; j < 4; ++j) { v[j] = xr[64 * j]; s += (v[j].x * v[j].x + v[j].y * v[j].y) + (v[j].z * v[j].z + v[j].w * v[j].w); }
        const float rstd = 1.0f / sqrtf(wave_sum(s) * (1.0f / DM) + EPS);
#pragma unroll
        for (int j = 0; j < 4; ++j) xr[64 * j] = v[j] * rstd * gv[j];
    }
}
__device__ __forceinline__ void conv_phase(const Args& a, const Frame& F) {
    LAS float* WL = (LAS float*)(F.lds + RING_OFF);
    for (int i = F.tid; i < CONVW * DCONV; i += 512) WL[i] = a.in[I_WDW][i];
    __syncthreads();
    const bf16* HG = WSP(const bf16, WS_HG); bf16* Y = WSP(bf16, WS_HB);
    const int gw = F.bid * NWAVES + F.wave, NGW = F.G * NWAVES, c0 = 8 * F.lane;
    float bd[8], lg[8], lb[8];
#pragma unroll
    for (int e = 0; e < 8; ++e) { bd[e] = a.in[I_BDW][c0 + e]; lg[e] = a.in[I_LNG][c0 + e]; lb[e] = a.in[I_LNB][c0 + e]; }
    for (int t = gw; t < SEQ; t += NGW) {
        float acc[8];
#pragma unroll
        for (int e = 0; e < 8; ++e) acc[e] = bd[e];
        for (int k = 0; k < CONVW; ++k) { const int tt = t - (CONVW - 1) + k; if (tt < 0) continue;
            const v4u h = *(const v4u*)(HG + (size_t)tt * DCONV + c0); const LAS float* w = WL + k * DCONV + c0;
            const f32x4 w0 = *(const LAS f32x4*)w, w1 = *(const LAS f32x4*)(w + 4);
            acc[0] += bflo(h.x) * w0.x; acc[1] += bfhi(h.x) * w0.y; acc[2] += bflo(h.y) * w0.z; acc[3] += bfhi(h.y) * w0.w;
            acc[4] += bflo(h.z) * w1.x; acc[5] += bfhi(h.z) * w1.y; acc[6] += bflo(h.w) * w1.z; acc[7] += bfhi(h.w) * w1.w; }
        float s = 0.f;
#pragma unroll
        for (int e = 0; e < 8; ++e) s += acc[e];
        const float mu = wave_sum(s) * (1.0f / DCONV); float q = 0.f;
#pragma unroll
        for (int e = 0; e < 8; ++e) { acc[e] -= mu; q += acc[e] * acc[e]; }
        const float rstd = 1.0f / sqrtf(wave_sum(q) * (1.0f / DCONV) + EPS);
        float o[8];
#pragma unroll
        for (int e = 0; e < 8; ++e) o[e] = silu_f(acc[e] * rstd * lg[e] + lb[e]);
        v4u w; w.x = pk2(o[0], o[1]); w.y = pk2(o[2], o[3]); w.z = pk2(o[4], o[5]); w.w = pk2(o[6], o[7]);
        *(v4u*)(Y + (size_t)t * DM + c0) = w;
    }
    __syncthreads();
}
__device__ __forceinline__ void compress_phase(const Args& a, const Frame& F) {
    LAS bf16* SL = (LAS bf16*)(F.lds + RING_OFF);
    LAS float* PH = (LAS float*)(F.lds + RING_OFF + 36864);
    LAS float* HID = (LAS float*)(F.lds + RING_OFF + 36864 + 65536);
    const bf16* KV = WSP(const bf16, WS_KV);
    for (int task = F.bid; task < 256; task += F.G) {
        const int which = task >> 7, g = (task >> 6) & 1, ng = task & 63, n0 = 16 * ng;
        const float* pe = a.in[which ? I_PEV : I_PEK]; const float* w1 = a.in[which ? I_WCV1 : I_WCK1]; const float* w2 = a.in[which ? I_WCV2 : I_WCK2];
        bf16* OUT = WSP(bf16, which ? WS_VCMP : WS_KCMP);
        const int coff = which * 128 + g * 64;
        for (int i = F.tid; i < 272 * 8; i += 512) { const int tok = 16 * n0 + (i >> 3), ch = i & 7;
            v4u v = (v4u){0u, 0u, 0u, 0u}; if (tok < SEQ) v = *(const v4u*)(KV + (size_t)tok * 768 + coff + ch * 8);
            *(LAS v4u*)(SL + (i >> 3) * 64 + ch * 8) = v; }
        __syncthreads();
        float acc[16][2];
#pragma unroll
        for (int r = 0; r < 16; ++r) { acc[r][0] = 0.f; acc[r][1] = 0.f; }
        for (int li = 0; li < 4; ++li) { const int l = 4 * F.wave + li;
            for (int d = 0; d < 64; ++d) {
                const float wa = w1[(size_t)(l * 64 + d) * CMP_HID + F.lane], wb = w1[(size_t)(l * 64 + d) * CMP_HID + 64 + F.lane], pv = pe[l * 64 + d];
#pragma unroll
                for (int r = 0; r < 16; ++r) { const float x = bf2f(SL[(16 * r + l) * 64 + d]) + pv; acc[r][0] += x * wa; acc[r][1] += x * wb; }
            } }
#pragma unroll
        for (int r = 0; r < 16; ++r) { PH[(F.wave * 16 + r) * 128 + F.lane] = acc[r][0]; PH[(F.wave * 16 + r) * 128 + 64 + F.lane] = acc[r][1]; }
        __syncthreads();
        for (int i = F.tid; i < 16 * 128; i += 512) { float s = 0.f;
#pragma unroll
            for (int w = 0; w < 8; ++w) s += PH[w * 2048 + i];
            HID[i] = silu_f(s); }
        __syncthreads();
        for (int i = F.tid; i < 16 * 64; i += 512) { const int r = i >> 6, e = i & 63; float s = 0.f;
            for (int j = 0; j < CMP_HID; ++j) s += HID[r * 128 + j] * w2[j * 64 + e];
            const int n = n0 + r; OUT[(size_t)n * 128 + g * 64 + e] = (bf16)(n < NCMP ? f2bf(s) : 0u); }
        __syncthreads();
    }
}
__device__ const unsigned char T5_BUCKET[128] = {0, 1, 2, 3, 4, 5, 6, 7, 8, 9, 10, 11, 12, 13, 14, 15, 16, 16, 16, 17, 17, 18, 18, 18, 19, 19, 19, 20, 20, 20, 20, 21, 21, 21, 21, 22, 22, 22, 22, 22, 23, 23, 23, 23, 23, 23, 24, 24, 24, 24, 24, 24, 25, 25, 25, 25, 25, 25, 25, 26, 26, 26, 26, 26, 26, 26, 26, 27, 27, 27, 27, 27, 27, 27, 27, 27, 27, 28, 28, 28, 28, 28, 28, 28, 28, 28, 28, 29, 29, 29, 29, 29, 29, 29, 29, 29, 29, 29, 29, 30, 30, 30, 30, 30, 30, 30, 30, 30, 30, 30, 30, 30, 30, 31, 31, 31, 31, 31, 31, 31, 31, 31, 31, 31, 31, 31, 31, 31};
__device__ __forceinline__ float dot64(const float (&q)[64], const bf16* krow) {
    const v4u* p = (const v4u*)krow; float s = 0.f;
#pragma unroll
    for (int c = 0; c < 8; ++c) { const v4u w = p[c];
        s += q[8 * c + 0] * bflo(w.x) + q[8 * c + 1] * bfhi(w.x) + q[8 * c + 2] * bflo(w.y) + q[8 * c + 3] * bfhi(w.y)
           + q[8 * c + 4] * bflo(w.z) + q[8 * c + 5] * bfhi(w.z) + q[8 * c + 6] * bflo(w.w) + q[8 * c + 7] * bfhi(w.w); }
    return s;
}
__device__ __forceinline__ unsigned ord_f32(float f) { const unsigned u = __float_as_uint(f); return (u & 0x80000000u) ? ~u : (u | 0x80000000u); }
__device__ __forceinline__ void attn_simple_phase(const Args& a, const Frame& F) {
    LAS float* BL = (LAS float*)(F.lds + RING_OFF);
    LAS float* PC = BL + 1024;
    LAS float* PS = PC + 8192;
    LAS float* PW = PS + 8192;
    LAS float* SCO = PW + 4096;
    LAS int* SEL = (LAS int*)(SCO + 512);
    for (int i = F.tid; i < 1024; i += 512) BL[i] = a.in[I_RELB][(i >> 7) * 32 + T5_BUCKET[i & 127]];
    __syncthreads();
    const bf16* Q = WSP(const bf16, WS_Q); const bf16* KV = WSP(const bf16, WS_KV); const bf16* KC = WSP(const bf16, WS_KCMP); const bf16* VC = WSP(const bf16, WS_VCMP);
    const float* GT = WSP(const float, WS_GT); bf16* Y = WSP(bf16, WS_HB);
    const int g = F.wave >> 2, h = F.wave, lane = F.lane;
    LAS float* pc = PC + F.wave * 1024; LAS float* ps = PS + F.wave * 1024; LAS float* pw = PW + F.wave * 512; const LAS float* bl = BL + h * 128;
    for (int t = F.bid; t < SEQ; t += F.G) {
        float q[64];
        { const v4u* qp = (const v4u*)(Q + (size_t)t * 512 + h * 64);
#pragma unroll
          for (int c = 0; c < 8; ++c) { const v4u w = qp[c]; q[8 * c] = bflo(w.x); q[8 * c + 1] = bfhi(w.x); q[8 * c + 2] = bflo(w.y); q[8 * c + 3] = bfhi(w.y); q[8 * c + 4] = bflo(w.z); q[8 * c + 5] = bfhi(w.z); q[8 * c + 6] = bflo(w.w); q[8 * c + 7] = bfhi(w.w); } }
        const int cur = t >> 6, nval = t >= 31 ? ((t - 31) >> 4) + 1 : 0;
        {   float s[16]; float mx = -3.0e38f;
#pragma unroll
            for (int i = 0; i < 16; ++i) { const int n = lane + 64 * i; s[i] = -3.0e38f;
                if (n < nval) { const int d = t - 16 * n - 31; s[i] = dot64(q, KC + (size_t)n * 128 + g * 64) + bl[d < 127 ? d : 127]; } mx = fmaxf(mx, s[i]); }
            mx = wave_max(mx); float l = 0.f;
#pragma unroll
            for (int i = 0; i < 16; ++i) { const int n = lane + 64 * i; s[i] = (n < nval) ? __expf(s[i] - mx) : 0.f; l += s[i]; }
            l = wave_sum(l); const float inv = 1.0f / fmaxf(l, 1e-30f);
#pragma unroll
            for (int i = 0; i < 16; ++i) pc[lane + 64 * i] = s[i] * inv;
        }
        __syncthreads();
        {   const int J = F.tid & 255, gg = F.tid >> 8; float imp = 0.f;
#pragma unroll
            for (int hh = 0; hh < 4; ++hh)
#pragma unroll
                for (int i = -1; i < 4; ++i) { const int n = 4 * J + i; if (n >= 0 && n < NCMP) imp += PC[(gg * 4 + hh) * 1024 + n]; }
            const bool forced = (J == 0) || (J == cur) || (J == cur - 1);
            SCO[gg * 256 + J] = forced ? 1.0e4f : (J <= cur ? imp : -1.0f);
        }
        float oc = 0.f;
        for (int n = 0; n < nval; ++n) oc += pc[n] * bf2f(VC[(size_t)n * 128 + g * 64 + lane]);
        __syncthreads();
        if ((F.wave & 3) == 0) {
            unsigned long long key[4];
#pragma unroll
            for (int i = 0; i < 4; ++i) { const int J = lane + 64 * i; key[i] = ((unsigned long long)ord_f32(SCO[g * 256 + J]) << 32) | (unsigned)(255 - J); }
            for (int r = 0; r < NTOP; ++r) {
                unsigned long long best = key[0];
#pragma unroll
                for (int i = 1; i < 4; ++i) best = key[i] > best ? key[i] : best;
#pragma unroll
                for (int o = 1; o < 64; o <<= 1) { const unsigned long long other = __shfl_xor(best, o); best = other > best ? other : best; }
                const int Js = 255 - (int)(unsigned)(best & 0xffffffffull);
                if (lane == 0) SEL[g * 16 + r] = Js;
#pragma unroll
                for (int i = 0; i < 4; ++i) if (lane + 64 * i == Js) key[i] = 0ull;
            }
        }
        __syncthreads();
        {   float s[16]; float mx = -3.0e38f;
#pragma unroll
            for (int r = 0; r < 16; ++r) { const int J = SEL[g * 16 + r], sp = 64 * J + lane; s[r] = -3.0e38f;
                if (sp <= t) { const int d = t - sp; s[r] = dot64(q, KV + (size_t)sp * 768 + 256 + g * 64) + bl[d < 127 ? d : 127]; } mx = fmaxf(mx, s[r]); }
            mx = wave_max(mx); float l = 0.f;
#pragma unroll
            for (int r = 0; r < 16; ++r) { const int J = SEL[g * 16 + r], sp = 64 * J + lane; s[r] = (sp <= t) ? __expf(s[r] - mx) : 0.f; l += s[r]; }
            l = wave_sum(l); const float inv = 1.0f / fmaxf(l, 1e-30f);
#pragma unroll
            for (int r = 0; r < 16; ++r) ps[64 * r + lane] = s[r] * inv;
        }
        {   float s[8]; float mx = -3.0e38f;
#pragma unroll
            for (int i = 0; i < 8; ++i) { const int sp = t - (WIN - 1) + lane + 64 * i; s[i] = -3.0e38f;
                if (sp >= 0) { const int d = t - sp; s[i] = dot64(q, KV + (size_t)sp * 768 + 512 + g * 64) + bl[d < 127 ? d : 127]; } mx = fmaxf(mx, s[i]); }
            mx = wave_max(mx); float l = 0.f;
#pragma unroll
            for (int i = 0; i < 8; ++i) { const int sp = t - (WIN - 1) + lane + 64 * i; s[i] = (sp >= 0) ? __expf(s[i] - mx) : 0.f; l += s[i]; }
            l = wave_sum(l); const float inv = 1.0f / fmaxf(l, 1e-30f);
#pragma unroll
            for (int i = 0; i < 8; ++i) pw[64 * i + lane] = s[i] * inv;
        }
        asm volatile("s_waitcnt lgkmcnt(0)" ::: "memory");
        float os = 0.f, ow = 0.f;
        for (int r = 0; r < 16; ++r) { const int J = SEL[g * 16 + r]; if (J > cur) continue;
            const bf16* vp = KV + (size_t)(64 * J) * 768 + 384 + g * 64 + lane;
#pragma unroll 8
            for (int k = 0; k < 64; ++k) os += ps[64 * r + k] * bf2f(vp[(size_t)k * 768]); }
        { const int s0 = t - (WIN - 1);
          for (int i = (s0 < 0 ? -s0 : 0); i < WIN; ++i) ow += pw[i] * bf2f(KV[(size_t)(s0 + i) * 768 + 640 + g * 64 + lane]); }
        const float gc = GT[(size_t)t * 24 + h * 3 + 0], gs = GT[(size_t)t * 24 + h * 3 + 1], gw = GT[(size_t)t * 24 + h * 3 + 2];
        Y[(size_t)t * DM + 512 + h * 64 + lane] = (bf16)f2bf(gc * oc + gs * os + gw * ow);
        __syncthreads();
    }
}
__global__ void __launch_bounds__(NWAVES * 64, 2) fwd_kernel(Args a) {
    extern __shared__ __attribute__((aligned(16))) unsigned char lds[];
    Frame F;
    F.lds = (LAS unsigned char*)lds;
    F.tid = threadIdx.x; F.lane = F.tid & 63; F.wave = __builtin_amdgcn_readfirstlane(F.tid >> 6);
    F.G = gridDim.x; F.bid = blockIdx.x;
    volatile LAS unsigned* MISC = (volatile LAS unsigned*)(F.lds + MISC_OFF);
    for (int u = F.tid; u < (LDS_BYTES - LDSCTL_OFF) / 4; u += NWAVES * 64) ((LAS unsigned*)(F.lds + LDSCTL_OFF))[u] = 0u;
    __syncthreads();
    const int lo = a.ph_lo, hi = a.ph_hi;
    const bool multi = (hi - lo) > 1;
    unsigned* barw = WSP(unsigned, WS_CTL) + CW_BAR;
    XcdBarrier bar; bar.bar = barw; bar.x = 0; bar.st = MISC + 8;
    if (multi) bar = xcd_barrier_post(barw, MISC + 8);
#define IN(k) (lo <= (k) && (k) < hi)
#define SEAM(k) do { if (IN(k) && IN((k) + 1)) xcd_barrier(bar); } while (0)
    PG8_LAS unsigned char* ring = F.lds + RING_OFF;

    if (IN(0)) { p0_prologue(a, F); } SEAM(0);
    if (IN(1)) { norm_mod_pass<true>(a, F, a.in[I_X], WSP(bf16, WS_HB), a.in[I_GFFN1], 0); } SEAM(1);
    if (IN(2)) {
        pg8::Gemm g{WSP(const bf16, WS_HB), WSP(const bf16, WS_WGU1), SEQ, 2 * DFF, DM}; pg8::StaticOrder S; S.init(SEQ, 2 * DFF, F.G, F.bid);
        pg8::EpiSwiGLU E{WSP(bf16, WS_ACT), DFF};
        pg8::gemm_phase<pg8::EpiSwiGLU, pg8::StaticOrder, PG8_ALIGN, PG8_SP2>(ring, g, S, E);
    } SEAM(2);
    if (IN(3)) {
        pg8::Gemm g{WSP(const bf16, WS_ACT), WSP(const bf16, WS_WD1), SEQ, DM, DFF}; pg8::StaticOrder S; S.init(SEQ, DM, F.G, F.bid);
        pg8::EpiResid E{a.in[I_X], WSP(float, WS_XB), DM, WSP(const float, WS_MOD) + 2 * DM, 0.5f};
        pg8::gemm_phase<pg8::EpiResid, pg8::StaticOrder, false, PG8_SP2>(ring, g, S, E);
    } SEAM(3);
    if (IN(4)) { norm_mod_pass<false>(a, F, WSP(const float, WS_XB), WSP(bf16, WS_HB), a.in[I_GMIX], 1); } SEAM(4);
    if (IN(5)) {
        pg8::Gemm g{WSP(const bf16, WS_HB), WSP(const bf16, WS_WIN), SEQ, DIN_PAD, DM}; pg8::StaticOrder S; S.init(SEQ, DIN_PAD, F.G, F.bid);
        pg8::EpiMix E{WSP(bf16, WS_HG), WSP(bf16, WS_Q), WSP(bf16, WS_KV), WSP(float, WS_GT)};
        pg8::gemm_phase<pg8::EpiMix, pg8::StaticOrder, PG8_ALIGN, PG8_SP2>(ring, g, S, E);
    } SEAM(5);
    if (IN(6)) { conv_phase(a, F); compress_phase(a, F); } SEAM(6);
    if (IN(7)) { attn_simple_phase(a, F); } SEAM(7);
    if (IN(8)) {
        pg8::Gemm g{WSP(const bf16, WS_HB), WSP(const bf16, WS_WOUT), SEQ, DM, DM}; pg8::StaticOrder S; S.init(SEQ, DM, F.G, F.bid);
        pg8::EpiResid E{WSP(const float, WS_XB), WSP(float, WS_XB), DM, WSP(const float, WS_MOD) + 5 * DM, 1.0f};
        pg8::gemm_phase<pg8::EpiResid, pg8::StaticOrder, false, PG8_SP2>(ring, g, S, E);
    } SEAM(8);
    if (IN(9)) { norm_mod_pass<false>(a, F, WSP(const float, WS_XB), WSP(bf16, WS_HB), a.in[I_GFFN2], 2); } SEAM(9);
    if (IN(10)) {
        pg8::Gemm g{WSP(const bf16, WS_HB), WSP(const bf16, WS_WGU2), SEQ, 2 * DFF, DM}; pg8::StaticOrder S; S.init(SEQ, 2 * DFF, F.G, F.bid);
        pg8::EpiSwiGLU E{WSP(bf16, WS_ACT), DFF};
        pg8::gemm_phase<pg8::EpiSwiGLU, pg8::StaticOrder, PG8_ALIGN, PG8_SP2>(ring, g, S, E);
    } SEAM(10);
    if (IN(11)) {
        pg8::Gemm g{WSP(const bf16, WS_ACT), WSP(const bf16, WS_WD2), SEQ, DM, DFF}; pg8::StaticOrder S; S.init(SEQ, DM, F.G, F.bid);
        pg8::EpiResid E{WSP(const float, WS_XB), a.out, DM, WSP(const float, WS_MOD) + 8 * DM, 0.5f};
        pg8::gemm_phase<pg8::EpiResid, pg8::StaticOrder, false, PG8_SP2>(ring, g, S, E);
    } SEAM(11);
    if (IN(12)) { final_norm_pass(a, F); }
#undef IN
#undef SEAM
}

extern "C" void kernel_launch(void* const* d_in, const int* in_sizes, int n_in, void* d_out, int out_size, void* d_ws, size_t ws_size, hipStream_t stream) {
    static int grid = 0;
    if (grid == 0) {
        if (n_in != N_IN || in_sizes[0] != SEQ * DM || out_size != SEQ * DM || ws_size < WS_END) { fprintf(stderr, "kernel_launch: unexpected problem shape (n_in %d, ws %zu); nothing launched\n", n_in, ws_size); grid = -1; return; }
        int dev = 0, cus = 0, per_cu = 0;
        if (hipGetDevice(&dev) != hipSuccess || hipDeviceGetAttribute(&cus, hipDeviceAttributeMultiprocessorCount, dev) != hipSuccess) { grid = -1; return; }
        if (hipFuncSetAttribute((const void*)fwd_kernel, hipFuncAttributeMaxDynamicSharedMemorySize, LDS_BYTES) != hipSuccess) { fprintf(stderr, "kernel_launch: hipFuncSetAttribute failed\n"); grid = -1; return; }
        if (hipOccupancyMaxActiveBlocksPerMultiprocessor(&per_cu, (const void*)fwd_kernel, NWAVES * 64, LDS_BYTES) != hipSuccess || per_cu < 1)
            fprintf(stderr, "kernel_launch: note: occupancy query reports %d workgroups per CU\n", per_cu);
        (void)hipGetLastError();
        grid = cus;
    }
    if (grid < 0) return;
    if (hipMemsetAsync((char*)d_ws + WS_CTL, 0, CTL_ZERO_BYTES, stream) != hipSuccess) return;
    Args a{};
    for (int i = 0; i < N_IN; ++i) a.in[i] = (const float*)d_in[i];
    a.out = (float*)d_out; a.ws = (unsigned char*)d_ws;
#if MK_LAUNCHES == 1
    a.ph_lo = 0; a.ph_hi = N_PHASES;
    hipLaunchKernelGGL(fwd_kernel, dim3(grid), dim3(NWAVES * 64), LDS_BYTES, stream, a);
#else
    for (int p = 0; p < N_PHASES; ++p) { a.ph_lo = p; a.ph_hi = p + 1; hipLaunchKernelGGL(fwd_kernel, dim3(grid), dim3(NWAVES * 64), LDS_BYTES, stream, a); }
#endif
}
```

```cpp
#include <hip/hip_runtime.h>
#include <cstdio>
#include <cstdint>
namespace pg8 {
#define PG8_LAS __attribute__((address_space(3)))
typedef unsigned short bf16_t;
typedef short bf16x8 __attribute__((ext_vector_type(8)));
typedef float f32x4 __attribute__((ext_vector_type(4)));
typedef unsigned u32x4 __attribute__((ext_vector_type(4)));
constexpr int BM = 256, BK = 64, HALF = 128, HTB = HALF * BK * 2  , STAGE_BYTES = 8 * HTB, NXCD = 8, WGM = 8;

__host__ __device__ __forceinline__ int lds_byte(int r, int c) { const int st = (r >> 4) * 2 + (c >> 5), rr = r & 15, cc = c & 31, ob = rr * 64 + cc * 2; return st * 1024 + (ob ^ (((ob >> 9) & 1) << 5)); }
__host__ __device__ __forceinline__ void stage_rc(int b, int& R, int& C) { const int st = b / 1024, sb = b % 1024, swz = sb ^ (((sb >> 9) & 1) << 5); R = (st >> 1) * 16 + swz / 64; C = (st & 1) * 32 + (swz % 64) / 2; }
__host__ __device__ __forceinline__ int perm32(int rho) { const int n = rho >> 4, i = rho & 15; return 8 * (i >> 2) + 4 * n + (i & 3); }

struct Unit { int pm, pn; };
struct Gemm { const bf16_t* A; const bf16_t* Bt; int M, N, K; };

struct StaticOrder {
    int nM, nN, nwg, G, c;
    __host__ __device__ void init(int M, int N, int G_, int c_) { nM = M / BM; nN = N / BM; nwg = nM * nN; G = G_; c = c_; }
    __host__ __device__ bool next(int i, Unit& u) const {
        const long L = (long)i * G + c; if (L >= nwg) return false;
        int wgid = (int)L; { const int q = nwg / NXCD, r = nwg % NXCD, xcd = wgid % NXCD, off = wgid / NXCD; wgid = (xcd < r ? xcd * (q + 1) : r * (q + 1) + (xcd - r) * q) + off; }
        const int nig = WGM * nN, gid = wgid / nig, fm = gid * WGM, gsz = (nM - fm) < WGM ? (nM - fm) : WGM;
        u.pm = fm + ((wgid % nig) % gsz); u.pn = (wgid % nig) / gsz; return true;
    }
    __device__ __forceinline__ void a_ready(const Unit&) const {}
    __device__ __forceinline__ void done(const Unit&) const {}
};


__device__ __forceinline__ unsigned cvt_pk_bf16(float lo, float hi) { unsigned r; asm volatile("v_cvt_pk_bf16_f32 %0, %1, %2" : "=v"(r) : "v"(lo), "v"(hi)); return r; }
__device__ __forceinline__ float sigmoid_f(float x) { return __builtin_amdgcn_rcpf(1.0f + __builtin_amdgcn_exp2f(-1.4426950408889634f * x)); }
__device__ __forceinline__ float silu_f(float x) { return x * sigmoid_f(x); }

template <bool GLU> __device__ __forceinline__ void gated_store(const f32x4 (&acc)[2][2][4][2], bf16_t* O, int ldc, int row0, int col0) {
#pragma unroll
    for (int ai = 0; ai < 2; ++ai)
#pragma unroll
        for (int m = 0; m < 4; ++m) { bf16_t* rowp = O + (size_t)(row0 + ai * HALF + m * 16) * ldc + col0;
            float v[8];
#pragma unroll
            for (int n = 0; n < 2; ++n)
#pragma unroll
                for (int e = 0; e < 4; ++e) { const float a = acc[ai][0][m][n][e], b = acc[ai][1][m][n][e]; v[n * 4 + e] = GLU ? a * sigmoid_f(b) : silu_f(a) * b; }
            u32x4 w; w.x = cvt_pk_bf16(v[0], v[1]); w.y = cvt_pk_bf16(v[2], v[3]); w.z = cvt_pk_bf16(v[4], v[5]); w.w = cvt_pk_bf16(v[6], v[7]);
            *(u32x4*)rowp = w; }
}
struct EpiSwiGLU {
    static constexpr bool PERM = true, AFTER_DRAIN = false;
    bf16_t* O; int ldc;
    __device__ __forceinline__ void operator()(const f32x4 (&acc)[2][2][4][2], const Unit& u, int wr, int wc, int fr, int fq) const {
        gated_store<false>(acc, O, ldc, u.pm * BM + wr * 64 + fr, u.pn * HALF + wc * 32 + 8 * fq);
    }
};
struct EpiResid {
    static constexpr bool PERM = false, AFTER_DRAIN = false;
    const float* base; float* out; int ldc; const float* gate; float scale;
    __device__ __forceinline__ void operator()(const f32x4 (&acc)[2][2][4][2], const Unit& u, int wr, int wc, int fr, int fq) const {
        const int col0 = u.pn * BM + wc * 32 + 4 * fq, row0 = u.pm * BM + wr * 64 + fr;
        f32x4 cf[2][2];
#pragma unroll
        for (int bj = 0; bj < 2; ++bj)
#pragma unroll
            for (int n = 0; n < 2; ++n) cf[bj][n] = *(const f32x4*)(gate + col0 + bj * HALF + n * 16) * scale;
#pragma unroll
        for (int ai = 0; ai < 2; ++ai)
#pragma unroll
            for (int m = 0; m < 4; ++m) { const size_t off = (size_t)(row0 + ai * HALF + m * 16) * ldc + col0;
#pragma unroll
                for (int bj = 0; bj < 2; ++bj)
#pragma unroll
                    for (int n = 0; n < 2; ++n) { const f32x4 bs = *(const f32x4*)(base + off + bj * HALF + n * 16); *(f32x4*)(out + off + bj * HALF + n * 16) = bs + cf[bj][n] * acc[ai][bj][m][n]; }
                if (m & 1) asm volatile("" ::: "memory"); }
    }
};
struct EpiMix {
    static constexpr bool PERM = true, AFTER_DRAIN = false;
    bf16_t* HG; bf16_t* Q; bf16_t* KV; float* GT;
    __device__ __forceinline__ void operator()(const f32x4 (&acc)[2][2][4][2], const Unit& u, int wr, int wc, int fr, int fq) const {
        const int row0 = u.pm * BM + wr * 64 + fr, c8 = wc * 32 + 8 * fq;
        if (u.pn < 4) { gated_store<true>(acc, HG, 512, row0, u.pn * HALF + c8); return; }
        if (u.pn == 9) {
            if (c8 < 24) {
#pragma unroll
                for (int ai = 0; ai < 2; ++ai)
#pragma unroll
                    for (int m = 0; m < 4; ++m) { float* rowp = GT + (size_t)(row0 + ai * HALF + m * 16) * 24 + c8;
#pragma unroll
                        for (int n = 0; n < 2; ++n) { const f32x4 a = acc[ai][0][m][n]; *(f32x4*)(rowp + 4 * n) = (f32x4){sigmoid_f(a[0]), sigmoid_f(a[1]), sigmoid_f(a[2]), sigmoid_f(a[3])}; } }
            }
            return;
        }
        bf16_t* O; int ldc, colt; float sc;
        if (u.pn < 6) { O = Q; ldc = 512; colt = (u.pn - 4) * BM; sc = 0.125f; } else { O = KV; ldc = 768; colt = (u.pn - 6) * BM; sc = 1.0f; }
#pragma unroll
        for (int ai = 0; ai < 2; ++ai)
#pragma unroll
            for (int m = 0; m < 4; ++m) { bf16_t* rowp = O + (size_t)(row0 + ai * HALF + m * 16) * ldc + colt + c8;
#pragma unroll
                for (int bj = 0; bj < 2; ++bj) { const f32x4 v0 = acc[ai][bj][m][0] * sc, v1 = acc[ai][bj][m][1] * sc;
                    u32x4 w; w.x = cvt_pk_bf16(v0[0], v0[1]); w.y = cvt_pk_bf16(v0[2], v0[3]); w.z = cvt_pk_bf16(v1[0], v1[1]); w.w = cvt_pk_bf16(v1[2], v1[3]);
                    *(u32x4*)(rowp + bj * HALF) = w; } }
    }
};

template <class Epi, class Sched, bool ALIGN_EPI = false, bool SP2 = false>
__device__ __forceinline__ void gemm_phase(PG8_LAS unsigned char* lds, const Gemm g, const Sched& S, const Epi& E) {
    const int tid = threadIdx.x, wid = __builtin_amdgcn_readfirstlane(tid >> 6), lane = tid & 63, wr = wid >> 2, wc = wid & 3, fr = lane & 15, fq = lane >> 4;
    const int K = g.K, nt = K / BK;
    unsigned voffA[2], voffB[2];
#pragma unroll
    for (int i = 0; i < 2; ++i) { int R, C; stage_rc(tid * 16 + i * 8192, R, C); const int Rb = Epi::PERM ? ((R & ~31) + perm32(R & 31)) : R;
        voffA[i] = (unsigned)(R * K + C) * 2u; voffB[i] = (unsigned)(Rb * K + C) * 2u; }
    const size_t kstep = (size_t)(BK * 2);
    const size_t hstep = (size_t)HALF * K * 2;
    const size_t tstep = 2 * hstep;
    const unsigned ldsw = (unsigned)wid * 1024u;
    const int aoff = lds_byte(wr * 64 + fr, fq * 8), boff = lds_byte(wc * 32 + fr, fq * 8);
#define PG8_SA(b, h) (((b) * 2 + (h)) * HTB)
#define PG8_SB(b, h) ((4 + (b) * 2 + (h)) * HTB)
#define PG8_STAGE(bufoff, gbase, voff) do { _Pragma("unroll") for (int _i = 0; _i < 2; ++_i) \
        __builtin_amdgcn_global_load_lds((const unsigned*)((const char*)(gbase) + (voff)[_i]), (PG8_LAS unsigned*)(lds + (bufoff) + ldsw + _i * 8192), 16, 0, 0); } while (0)
#define PG8_LDA(dst, b, h) do { _Pragma("unroll") for (int m = 0; m < 4; ++m) _Pragma("unroll") for (int k = 0; k < 2; ++k) dst[m][k] = *(const PG8_LAS bf16x8*)(lds + PG8_SA(b, h) + aoff + m * 2048 + k * 1024); } while (0)
#define PG8_LDB(dst, b, h) do { _Pragma("unroll") for (int n = 0; n < 2; ++n) _Pragma("unroll") for (int k = 0; k < 2; ++k) dst[n][k] = *(const PG8_LAS bf16x8*)(lds + PG8_SB(b, h) + boff + n * 2048 + k * 1024); } while (0)
#define PG8_MMA(ai, bj, At, Bt) do { __builtin_amdgcn_s_setprio(1); _Pragma("unroll") for (int m = 0; m < 4; ++m) _Pragma("unroll") for (int n = 0; n < 2; ++n) _Pragma("unroll") for (int k = 0; k < 2; ++k) \
        acc[ai][bj][m][n] = __builtin_amdgcn_mfma_f32_16x16x32_bf16(Bt[n][k], At[m][k], acc[ai][bj][m][n], 0, 0, 0); __builtin_amdgcn_s_setprio(0); } while (0)
#define PG8_WAIT_V(n) asm volatile("s_waitcnt vmcnt(" #n ")" ::: "memory")
#define PG8_WAIT_L(n) asm volatile("s_waitcnt lgkmcnt(" #n ")" ::: "memory")
#define PG8_BAR __builtin_amdgcn_s_barrier()
#define PG8_SCHED __builtin_amdgcn_sched_barrier(0)
    Unit cur, nxt; int ui = 0;
    if (!S.next(0, cur)) return;
    f32x4 acc[2][2][4][2];
#pragma unroll
    for (int a = 0; a < 2; ++a)
#pragma unroll
        for (int b = 0; b < 2; ++b)
#pragma unroll
            for (int m = 0; m < 4; ++m)
#pragma unroll
                for (int n = 0; n < 2; ++n) acc[a][b][m][n] = (f32x4){0.f, 0.f, 0.f, 0.f};
    bf16x8 At[4][2], B0[2][2], B1[2][2];
    const char* cA = (const char*)g.A + (size_t)cur.pm * tstep; const char* cB = (const char*)g.Bt + (size_t)cur.pn * tstep;
    S.a_ready(cur);
    if constexpr (SP2) {
        PG8_STAGE(PG8_SB(0, 0), cB, voffB); PG8_STAGE(PG8_SB(0, 1), cB + hstep, voffB); PG8_STAGE(PG8_SA(0, 0), cA, voffA); PG8_STAGE(PG8_SA(0, 1), cA + hstep, voffA);
        if (wr == 1) PG8_BAR;
        PG8_WAIT_V(2); PG8_BAR;
        PG8_STAGE(PG8_SB(1, 0), cB + kstep, voffB); PG8_STAGE(PG8_SA(1, 0), cA + kstep, voffA); PG8_STAGE(PG8_SB(1, 1), cB + hstep + kstep, voffB);
        PG8_WAIT_V(6); PG8_BAR;
    } else {
        PG8_STAGE(PG8_SB(0, 0), cB, voffB); PG8_STAGE(PG8_SA(0, 0), cA, voffA); PG8_STAGE(PG8_SB(0, 1), cB + hstep, voffB); PG8_STAGE(PG8_SA(0, 1), cA + hstep, voffA);
        if (wr == 1) PG8_BAR;
        PG8_WAIT_V(4); PG8_BAR;
        PG8_STAGE(PG8_SB(1, 0), cB + kstep, voffB); PG8_STAGE(PG8_SA(1, 0), cA + kstep, voffA); PG8_STAGE(PG8_SB(1, 1), cB + hstep + kstep, voffB);
        PG8_WAIT_V(6); PG8_BAR;
    }
    for (;;) {
        const bool has_next = S.next(ui + 1, nxt);
        const char* nA = has_next ? (const char*)g.A + (size_t)nxt.pm * tstep : cA; const char* nB = has_next ? (const char*)g.Bt + (size_t)nxt.pn * tstep : cB;
        for (int t = 0; t < nt; t += 2) {
            const bool last = (t == nt - 2);
            const char* a1 = cA + (size_t)(t + 1) * kstep;
            const char* a2 = last ? nA : cA + (size_t)(t + 2) * kstep; const char* b2 = last ? nB : cB + (size_t)(t + 2) * kstep;
            const char* a3 = a2 + kstep; const char* b3 = b2 + kstep;
            if (last && has_next) S.a_ready(nxt);
            if constexpr (SP2) {
            PG8_LDB(B0, 0, 0); PG8_LDB(B1, 0, 1); PG8_SCHED; PG8_LDA(At, 0, 0); PG8_STAGE(PG8_SA(1, 1), a1 + hstep, voffA);
            PG8_WAIT_V(8); PG8_WAIT_L(0); PG8_BAR; PG8_MMA(0, 0, At, B0); PG8_MMA(0, 1, At, B1); PG8_BAR; PG8_SCHED;
            PG8_LDA(At, 0, 1); PG8_STAGE(PG8_SB(0, 0), b2, voffB); PG8_STAGE(PG8_SB(0, 1), b2 + hstep, voffB); PG8_STAGE(PG8_SA(0, 0), a2, voffA);
            PG8_WAIT_V(8); PG8_WAIT_L(0); PG8_BAR; PG8_MMA(1, 0, At, B0); PG8_MMA(1, 1, At, B1); PG8_BAR; PG8_SCHED;
            PG8_LDB(B0, 1, 0); PG8_LDB(B1, 1, 1); PG8_SCHED; PG8_LDA(At, 1, 0); PG8_STAGE(PG8_SA(0, 1), a2 + hstep, voffA);
            PG8_WAIT_V(8); PG8_WAIT_L(0); PG8_BAR; PG8_MMA(0, 0, At, B0); PG8_MMA(0, 1, At, B1); PG8_BAR; PG8_SCHED;
            PG8_LDA(At, 1, 1); PG8_STAGE(PG8_SB(1, 0), b3, voffB); PG8_STAGE(PG8_SB(1, 1), b3 + hstep, voffB); PG8_STAGE(PG8_SA(1, 0), a3, voffA);
            PG8_WAIT_V(8); PG8_WAIT_L(0); PG8_BAR; PG8_MMA(1, 0, At, B0); PG8_MMA(1, 1, At, B1); PG8_BAR; PG8_SCHED;
            } else {
            PG8_LDB(B0, 0, 0); PG8_SCHED; PG8_LDA(At, 0, 0); PG8_STAGE(PG8_SA(1, 1), a1 + hstep, voffA);
            PG8_WAIT_L(8); PG8_BAR; PG8_WAIT_L(0); PG8_MMA(0, 0, At, B0); PG8_BAR; PG8_SCHED;
            PG8_LDB(B1, 0, 1); PG8_STAGE(PG8_SB(0, 0), b2, voffB);
            PG8_BAR; PG8_WAIT_L(0); PG8_MMA(0, 1, At, B1); PG8_BAR;
            PG8_LDA(At, 0, 1); PG8_STAGE(PG8_SA(0, 0), a2, voffA);
            PG8_BAR; PG8_WAIT_L(0); PG8_MMA(1, 0, At, B0); PG8_BAR; PG8_SCHED;
            PG8_STAGE(PG8_SB(0, 1), b2 + hstep, voffB);
            PG8_WAIT_V(6); PG8_BAR; PG8_MMA(1, 1, At, B1); PG8_BAR;
            PG8_LDB(B0, 1, 0); PG8_SCHED; PG8_LDA(At, 1, 0); PG8_STAGE(PG8_SA(0, 1), a2 + hstep, voffA);
            PG8_WAIT_L(8); PG8_BAR; PG8_WAIT_L(0); PG8_MMA(0, 0, At, B0); PG8_BAR; PG8_SCHED;
            PG8_LDB(B1, 1, 1); PG8_STAGE(PG8_SB(1, 0), b3, voffB);
            PG8_BAR; PG8_WAIT_L(0); PG8_MMA(0, 1, At, B1); PG8_BAR;
            PG8_LDA(At, 1, 1); PG8_STAGE(PG8_SA(1, 0), a3, voffA);
            PG8_BAR; PG8_WAIT_L(0); PG8_MMA(1, 0, At, B0); PG8_BAR; PG8_SCHED;
            PG8_STAGE(PG8_SB(1, 1), b3 + hstep, voffB);
            PG8_WAIT_V(6); PG8_BAR; PG8_MMA(1, 1, At, B1); PG8_BAR;
            }
        }
        if constexpr (ALIGN_EPI) { if (wr == 0) PG8_BAR; }
        if constexpr (!Epi::AFTER_DRAIN) { E(acc, cur, wr, wc, fr, fq); S.done(cur); }
        if (!has_next) break;
#pragma unroll
        for (int a = 0; a < 2; ++a)
#pragma unroll
            for (int b = 0; b < 2; ++b)
#pragma unroll
                for (int m = 0; m < 4; ++m)
#pragma unroll
                    for (int n = 0; n < 2; ++n) acc[a][b][m][n] = (f32x4){0.f, 0.f, 0.f, 0.f};
        cur = nxt; cA = nA; cB = nB; ++ui;
        if constexpr (ALIGN_EPI) { if (wr == 1) PG8_BAR; }
    }
    PG8_WAIT_V(0);
    if constexpr (!ALIGN_EPI) { if (wr == 0) PG8_BAR; }
    PG8_BAR;
    if constexpr (Epi::AFTER_DRAIN) { E.fused(acc, cur, wr, wc, fr, fq, lds, wid, lane); S.done(cur); }
#undef PG8_SA
#undef PG8_SB
#undef PG8_STAGE
#undef PG8_LDA
#undef PG8_LDB
#undef PG8_MMA
#undef PG8_WAIT_V
#undef PG8_WAIT_L
#undef PG8_BAR
#undef PG8_SCHED
}
}
#ifndef PG8_SP2
#define PG8_SP2 true
#endif
#ifndef PG8_ALIGN
#define PG8_ALIGN true
#endif
#ifndef MK_LAUNCHES
#define MK_LAUNCHES 1
#endif

constexpr int NWAVES = 8;
constexpr int SEQ = 16384, DM = 1024, DFF = 2816, DCONV = 512, DATT = 512, NH = 8, NG = 2, HPG = 4, HD = 64;
constexpr int DIN = 2328, DIN_PAD = 2560, NCMP = 1023, CONVW = 31, CMP_HID = 128, NSLC = 256, NTOP = 16, WIN = 512;
constexpr float EPS = 1e-6f;
constexpr int N_PHASES = 13;
enum { I_X = 0, I_C, I_WADA, I_BADA, I_GFFN1, I_WGU1, I_WD1, I_GMIX, I_WIN, I_WDW, I_BDW, I_LNG, I_LNB, I_PEK, I_PEV, I_WCK1, I_WCK2, I_WCV1, I_WCV2, I_RELB, I_WOUT, I_GFFN2, I_WGU2, I_WD2, I_GFIN, N_IN };

constexpr size_t MiB = 1u << 20;
constexpr size_t WS_CTL = 0, CTL_ZERO_BYTES = 64 * 1024;
constexpr size_t WS_MODP = 1 * MiB;
constexpr size_t WS_MOD = WS_MODP + 16 * 9216 * 4;
constexpr size_t WS_KCMP = 2 * MiB, WS_VCMP = WS_KCMP + 256 * 1024;
constexpr size_t WS_WGU1 = 4 * MiB, WS_WD1 = 15 * MiB, WS_WIN = 21 * MiB, WS_WOUT = 26 * MiB, WS_WGU2 = 28 * MiB, WS_WD2 = 39 * MiB;
constexpr size_t WS_GT = 45 * MiB;
constexpr size_t WS_HB = 48 * MiB;
constexpr size_t WS_XB = 80 * MiB;
constexpr size_t WS_ACT = 144 * MiB;
constexpr size_t WS_HG = WS_ACT, WS_Q = WS_ACT + 16 * MiB, WS_KV = WS_ACT + 32 * MiB;
constexpr size_t WS_END = 232 * MiB;
static_assert(WS_WD2 + (size_t)DM * DFF * 2 <= WS_GT && WS_GT + (size_t)SEQ * 24 * 4 <= WS_HB && WS_KV + (size_t)SEQ * 768 * 2 <= WS_END && WS_ACT + (size_t)SEQ * DFF * 2 <= WS_END, "d_ws map");
constexpr int CW_BAR = 4096;
constexpr int RING_OFF = 0, RING_BYTES = 131072;
constexpr int LDSCTL_OFF = RING_BYTES, MISC_OFF = LDSCTL_OFF + 320;
constexpr int LDS_BYTES = 147456;

#define GAS __attribute__((address_space(1)))
#define LAS __attribute__((address_space(3)))
typedef unsigned short bf16;
typedef unsigned v4u __attribute__((ext_vector_type(4)));
typedef unsigned v2u __attribute__((ext_vector_type(2)));
typedef float f32x4 __attribute__((ext_vector_type(4)));
typedef float f32x2 __attribute__((ext_vector_type(2)));
typedef short bf16x8 __attribute__((ext_vector_type(8)));
typedef GAS unsigned gu32;
#define RLX_AGENT __ATOMIC_RELAXED, __HIP_MEMORY_SCOPE_AGENT
__device__ __forceinline__ unsigned f2bf(float f) { unsigned u = __builtin_bit_cast(unsigned, f); return (u + 0x7fffu + ((u >> 16) & 1u)) >> 16; }
__device__ __forceinline__ unsigned pk2(float lo, float hi) { return f2bf(lo) | (f2bf(hi) << 16); }
__device__ __forceinline__ float bflo(unsigned w) { return __uint_as_float(w << 16); }
__device__ __forceinline__ float bfhi(unsigned w) { return __uint_as_float(w & 0xffff0000u); }
__device__ __forceinline__ float bf2f(bf16 b) { return __uint_as_float((unsigned)b << 16); }
__device__ __forceinline__ float sigmoid_f(float x) { return __builtin_amdgcn_rcpf(1.0f + __builtin_amdgcn_exp2f(-1.4426950408889634f * x)); }
__device__ __forceinline__ float silu_f(float x) { return x * sigmoid_f(x); }
__device__ __forceinline__ float wave_sum(float v) {
#pragma unroll
    for (int o = 1; o < 64; o <<= 1) v += __shfl_xor(v, o);
    return v;
}
__device__ __forceinline__ float wave_max(float v) {
#pragma unroll
    for (int o = 1; o < 64; o <<= 1) v = fmaxf(v, __shfl_xor(v, o));
    return v;
}

#define XB_TMO      128
#define XB_XCNT(j)  (256  + 64 * (j))
#define XB_XSUB(j)  (1280 + 64 * (j))
#define XB_XGEN(j)  (2304 + 64 * (j))
#define XB_TOP      3328
#define XB_TOPGEN   3392
#define XCD_BAR_WORDS 3456
#define XB_SPIN_CAP (1u << 18)
static_assert((CW_BAR + XCD_BAR_WORDS) * 4 <= (int)CTL_ZERO_BYTES, "barrier words inside the memset region");

__device__ __forceinline__ unsigned xb_ld(unsigned* p)              { return __hip_atomic_load(p, __ATOMIC_RELAXED, __HIP_MEMORY_SCOPE_AGENT); }
__device__ __forceinline__ unsigned xb_add(unsigned* p, unsigned v) { return __hip_atomic_fetch_add(p, v, __ATOMIC_RELAXED, __HIP_MEMORY_SCOPE_AGENT); }
__device__ __forceinline__ unsigned xb_xcc_id() { return (unsigned)__builtin_amdgcn_s_getreg((3 << 11) | 20) & 0xFu; }
#define XB_SPIN(cond, bar) do { unsigned _sp = 0; while (cond) { __builtin_amdgcn_s_sleep(1); \
    if ((++_sp & 255u) == 0u) { if (xb_ld(&(bar)[XB_TMO])) break; if (_sp > XB_SPIN_CAP) { atomicAdd(&(bar)[XB_TMO], 1u); break; } } } } while (0)

struct XcdBarrier {
    unsigned* bar; unsigned x;
    volatile LAS unsigned* st;
};
__device__ __forceinline__ XcdBarrier xcd_barrier_post(unsigned* bar, volatile LAS unsigned* st) {
    XcdBarrier b; b.bar = bar; b.x = xb_xcc_id(); b.st = st;
    if (threadIdx.x == 0) (void)xb_add(&bar[XB_XCNT(b.x)], 1u);
    return b;
}
__device__ __forceinline__ void xcd_barrier_complete(unsigned* bar, unsigned x, unsigned& nloc, unsigned& nx) {
    const unsigned G = gridDim.x * gridDim.y * gridDim.z;
    unsigned sum, cnt, mine, sp = 0u;
    for (;;) {
        sum = 0u; cnt = 0u; mine = 0u;
#pragma unroll
        for (unsigned j = 0; j < 16; ++j) { const unsigned c = xb_ld(&bar[XB_XCNT(j)]); sum += c; cnt += (c > 0u) ? 1u : 0u; mine = (j == x) ? c : mine; }
        if (sum == G) break;
        __builtin_amdgcn_s_sleep(1);
        if ((++sp & 255u) == 0u) { if (xb_ld(&bar[XB_TMO])) break; if (sp > XB_SPIN_CAP) { atomicAdd(&bar[XB_TMO], 1u); break; } }
    }
    nloc = mine > 0u ? mine : 1u; nx = cnt > 0u ? cnt : 1u;
}
__device__ __forceinline__ void xcd_barrier(const XcdBarrier& b) {
    asm volatile("s_waitcnt vmcnt(0)" ::: "memory");
    __syncthreads();
    if (threadIdx.x == 0) {
        unsigned* bar = b.bar;
        __builtin_amdgcn_s_waitcnt(0);
        unsigned nloc = b.st[0], nx = b.st[1];
        if (nloc == 0u) { xcd_barrier_complete(bar, b.x, nloc, nx); b.st[0] = nloc; b.st[1] = nx; }
        const unsigned old = xb_add(&bar[XB_XSUB(b.x)], 1u);
        const unsigned gen = old / nloc;
        if (old + 1u == (gen + 1u) * nloc) {
            __builtin_amdgcn_fence(__ATOMIC_RELEASE, "agent");
            asm volatile("s_waitcnt vmcnt(0)" ::: "memory");
            const unsigned og = xb_add(&bar[XB_TOP], 1u);
            const unsigned tg = og / nx;
            if (og + 1u == (tg + 1u) * nx) xb_add(&bar[XB_TOPGEN], 1u);
            else XB_SPIN(xb_ld(&bar[XB_TOPGEN]) == tg, bar);
            __builtin_amdgcn_fence(__ATOMIC_ACQUIRE, "agent");
            xb_add(&bar[XB_XGEN(b.x)], 1u);
            asm volatile("s_waitcnt vmcnt(0)" ::: "memory");
        } else {
            XB_SPIN(xb_ld(&bar[XB_XGEN(b.x)]) == gen, bar);
            __builtin_amdgcn_fence(__ATOMIC_ACQUIRE, "agent");
            asm volatile("s_waitcnt vmcnt(0)" ::: "memory");
        }
    }
    __syncthreads();
}

struct Args { const float* in[N_IN]; float* out; unsigned char* ws; int ph_lo, ph_hi; };
static_assert(sizeof(Args) == (N_IN + 2) * 8 + 8, "Args has no padding");
struct Frame {
    LAS unsigned char* lds;
    int tid, lane, wave, G, bid;
};
#define WSP(T, off) ((T*)(a.ws + (off)))

template <int MODE> __device__ __forceinline__ int wt_row0(int n0) {
    if (MODE == 1) { const int isu = n0 >= DFF ? 1 : 0, c = n0 - isu * DFF; return 256 * (c >> 7) + 128 * isu + (c & 127); }
    if (MODE == 2) { if (n0 < 512) return 256 * (n0 >> 7) + (n0 & 127); if (n0 < 1024) { const int c = n0 - 512; return 256 * (c >> 7) + 128 + (c & 127); } return n0; }
    return n0;
}
template <int MODE> __device__ __forceinline__ void p0_transpose_item(const float* W, int K, int N, bf16* WT, LAS float* scr, int item, int lane) {
    const int nblk = (N + 31) / 32, kb = item / nblk, nb = item % nblk, k0 = 64 * kb, n0 = 32 * nb;
    const int nn = n0 + (lane & 31); const bool okn = nn < N;
#pragma unroll 8
    for (int i = 0; i < 32; ++i) { const int kk = 2 * i + (lane >> 5); scr[kk * 33 + (lane & 31)] = okn ? W[(size_t)(k0 + kk) * N + nn] : 0.f; }
    asm volatile("s_waitcnt lgkmcnt(0)" ::: "memory");
    const int c = lane & 7, r0 = wt_row0<MODE>(n0);
#pragma unroll
    for (int j = 0; j < 4; ++j) { const int n = (lane >> 3) + 8 * j; const LAS float* s = scr + (8 * c) * 33 + n;
        v4u o; o.x = pk2(s[0 * 33], s[1 * 33]); o.y = pk2(s[2 * 33], s[3 * 33]); o.z = pk2(s[4 * 33], s[5 * 33]); o.w = pk2(s[6 * 33], s[7 * 33]);
        *(v4u*)(WT + (size_t)(r0 + n) * K + k0 + 8 * c) = o; }
    asm volatile("s_waitcnt lgkmcnt(0)" ::: "memory");
}
__device__ __forceinline__ void p0_prologue(const Args& a, const Frame& F) {
    LAS float* scr = (LAS float*)(F.lds + RING_OFF + F.wave * 16384);
    const int gw = F.bid * NWAVES + F.wave, NGW = F.G * NWAVES;
    constexpr int I_GU = (DM / 64) * (2 * DFF / 32), I_D = (DFF / 64) * (DM / 32), I_IN = (DM / 64) * ((DIN + 31) / 32), I_O = (DM / 64) * (DM / 32);
    constexpr int I_MOD = 144 * 16, I_PAD = (DIN_PAD - 2336) * DM / 8 / 64;
    constexpr int NITEMS = 2 * I_GU + 2 * I_D + I_IN + I_O + I_MOD + I_PAD;
    for (int it = gw; it < NITEMS; it += NGW) {
        int r = it;
        if (r < I_MOD) {
            const int cg = r >> 4, kc = r & 15; const float* W = a.in[I_WADA] + (size_t)(kc * 64) * 9216 + cg * 64 + F.lane; const float* cv = a.in[I_C] + kc * 64;
            float s = 0.f;
#pragma unroll 16
            for (int k = 0; k < 64; ++k) s += silu_f(cv[k]) * W[(size_t)k * 9216];
            WSP(float, WS_MODP)[kc * 9216 + cg * 64 + F.lane] = s; continue; }
        r -= I_MOD;
        if (r < I_GU) { p0_transpose_item<1>(a.in[I_WGU1], DM, 2 * DFF, WSP(bf16, WS_WGU1), scr, r, F.lane); continue; } r -= I_GU;
        if (r < I_GU) { p0_transpose_item<1>(a.in[I_WGU2], DM, 2 * DFF, WSP(bf16, WS_WGU2), scr, r, F.lane); continue; } r -= I_GU;
        if (r < I_D) { p0_transpose_item<0>(a.in[I_WD1], DFF, DM, WSP(bf16, WS_WD1), scr, r, F.lane); continue; } r -= I_D;
        if (r < I_D) { p0_transpose_item<0>(a.in[I_WD2], DFF, DM, WSP(bf16, WS_WD2), scr, r, F.lane); continue; } r -= I_D;
        if (r < I_IN) { p0_transpose_item<2>(a.in[I_WIN], DM, DIN, WSP(bf16, WS_WIN), scr, r, F.lane); continue; } r -= I_IN;
        if (r < I_O) { p0_transpose_item<0>(a.in[I_WOUT], DM, DM, WSP(bf16, WS_WOUT), scr, r, F.lane); continue; } r -= I_O;
        { v4u* p = (v4u*)(WSP(bf16, WS_WIN) + (size_t)2336 * DM) + (size_t)r * 64 + F.lane; *p = (v4u){0u, 0u, 0u, 0u}; }
    }
}
template <bool FROM_PARTIALS> __device__ __forceinline__ void norm_mod_pass(const Args& a, const Frame& F, const float* src, bf16* dst, const float* gvec, int sub) {
    LAS float* CA = (LAS float*)(F.lds + RING_OFF); LAS float* CB = CA + DM;
    const float* modp = WSP(const float, WS_MODP); float* mod = WSP(float, WS_MOD); const float* bada = a.in[I_BADA];
    if (FROM_PARTIALS) {
        for (int i = F.bid * 512 + F.tid; i < 9216; i += F.G * 512) { float s = bada[i];
#pragma unroll
            for (int k = 0; k < 16; ++k) s += modp[k * 9216 + i];
            mod[i] = s; }
    }
    for (int c = F.tid; c < 2 * DM; c += 512) {
        const int i = 3 * sub * DM + c; float s;
        if (FROM_PARTIALS) { s = bada[i];
#pragma unroll
            for (int k = 0; k < 16; ++k) s += modp[k * 9216 + i]; }
        else s = mod[i];
        if (c < DM) CB[c] = s; else CA[c - DM] = gvec[c - DM] * (1.0f + s);
    }
    __syncthreads();
    const int gw = F.bid * NWAVES + F.wave, NGW = F.G * NWAVES;
    for (int m = gw; m < SEQ; m += NGW) {
        const f32x4* xr = (const f32x4*)(src + (size_t)m * DM) + F.lane;
        f32x4 v[4]; float s = 0.f;
#pragma unroll
        for (int j = 0; j < 4; ++j) { v[j] = xr[64 * j]; s += (v[j].x * v[j].x + v[j].y * v[j].y) + (v[j].z * v[j].z + v[j].w * v[j].w); }
        const float rstd = 1.0f / sqrtf(wave_sum(s) * (1.0f / DM) + EPS);
        unsigned long long* o8 = (unsigned long long*)(dst + (size_t)m * DM) + F.lane;
#pragma unroll
        for (int j = 0; j < 4; ++j) { const f32x4 ca = *(const LAS f32x4*)(CA + 256 * j + 4 * F.lane), cb = *(const LAS f32x4*)(CB + 256 * j + 4 * F.lane);
            const f32x4 h = v[j] * rstd * ca + cb;
            o8[64 * j] = (unsigned long long)pk2(h.x, h.y) | ((unsigned long long)pk2(h.z, h.w) << 32); }
    }
    __syncthreads();
}
__device__ __forceinline__ void final_norm_pass(const Args& a, const Frame& F) {
    const int gw = F.bid * NWAVES + F.wave, NGW = F.G * NWAVES; const float* g = a.in[I_GFIN];
    f32x4 gv[4];
#pragma unroll
    for (int j = 0; j < 4; ++j) gv[j] = *((const f32x4*)g + 64 * j + F.lane);
    for (int m = gw; m < SEQ; m += NGW) {
        f32x4* xr = (f32x4*)(a.out + (size_t)m * DM) + F.lane;
        f32x4 v[4]; float s = 0.f;
#pragma unroll
        for (int j = 0; j < 4; ++j) { v[j] = xr[64 * j]; s += (v[j].x * v[j].x + v[j].y * v[j].y) + (v[j].z * v[j].z + v[j].w * v[j].w); }
        const float rstd = 1.0f / sqrtf(wave_sum(s) * (1.0f / DM) + EPS);
#pragma unroll
        for (int j = 0; j < 4; ++j) xr[64 * j] = v[j] * rstd * gv[j];
    }
}
__device__ __forceinline__ void conv_phase(const Args& a, const Frame& F) {
    LAS float* WL = (LAS float*)(F.lds + RING_OFF);
    for (int i = F.tid; i < CONVW * DCONV; i += 512) WL[i] = a.in[I_WDW][i];
    __syncthreads();
    const bf16* HG = WSP(const bf16, WS_HG); bf16* Y = WSP(bf16, WS_HB);
    const int gw = F.bid * NWAVES + F.wave, NGW = F.G * NWAVES, c0 = 8 * F.lane;
    float bd[8], lg[8], lb[8];
#pragma unroll
    for (int e = 0; e < 8; ++e) { bd[e] = a.in[I_BDW][c0 + e]; lg[e] = a.in[I_LNG][c0 + e]; lb[e] = a.in[I_LNB][c0 + e]; }
    for (int t = gw; t < SEQ; t += NGW) {
        float acc[8];
#pragma unroll
        for (int e = 0; e < 8; ++e) acc[e] = bd[e];
        for (int k = 0; k < CONVW; ++k) { const int tt = t - (CONVW - 1) + k; if (tt < 0) continue;
            const v4u h = *(const v4u*)(HG + (size_t)tt * DCONV + c0); const LAS float* w = WL + k * DCONV + c0;
            const f32x4 w0 = *(const LAS f32x4*)w, w1 = *(const LAS f32x4*)(w + 4);
            acc[0] += bflo(h.x) * w0.x; acc[1] += bfhi(h.x) * w0.y; acc[2] += bflo(h.y) * w0.z; acc[3] += bfhi(h.y) * w0.w;
            acc[4] += bflo(h.z) * w1.x; acc[5] += bfhi(h.z) * w1.y; acc[6] += bflo(h.w) * w1.z; acc[7] += bfhi(h.w) * w1.w; }
        float s = 0.f;
#pragma unroll
        for (int e = 0; e < 8; ++e) s += acc[e];
        const float mu = wave_sum(s) * (1.0f / DCONV); float q = 0.f;
#pragma unroll
        for (int e = 0; e < 8; ++e) { acc[e] -= mu; q += acc[e] * acc[e]; }
        const float rstd = 1.0f / sqrtf(wave_sum(q) * (1.0f / DCONV) + EPS);
        float o[8];
#pragma unroll
        for (int e = 0; e < 8; ++e) o[e] = silu_f(acc[e] * rstd * lg[e] + lb[e]);
        v4u w; w.x = pk2(o[0], o[1]); w.y = pk2(o[2], o[3]); w.z = pk2(o[4], o[5]); w.w = pk2(o[6], o[7]);
        *(v4u*)(Y + (size_t)t * DM + c0) = w;
    }
    __syncthreads();
}
__device__ __forceinline__ void compress_phase(const Args& a, const Frame& F) {
    LAS bf16* SL = (LAS bf16*)(F.lds + RING_OFF);
    LAS float* PH = (LAS float*)(F.lds + RING_OFF + 36864);
    LAS float* HID = (LAS float*)(F.lds + RING_OFF + 36864 + 65536);
    const bf16* KV = WSP(const bf16, WS_KV);
    for (int task = F.bid; task < 256; task += F.G) {
        const int which = task >> 7, g = (task >> 6) & 1, ng = task & 63, n0 = 16 * ng;
        const float* pe = a.in[which ? I_PEV : I_PEK]; const float* w1 = a.in[which ? I_WCV1 : I_WCK1]; const float* w2 = a.in[which ? I_WCV2 : I_WCK2];
        bf16* OUT = WSP(bf16, which ? WS_VCMP : WS_KCMP);
        const int coff = which * 128 + g * 64;
        for (int i = F.tid; i < 272 * 8; i += 512) { const int tok = 16 * n0 + (i >> 3), ch = i & 7;
            v4u v = (v4u){0u, 0u, 0u, 0u}; if (tok < SEQ) v = *(const v4u*)(KV + (size_t)tok * 768 + coff + ch * 8);
            *(LAS v4u*)(SL + (i >> 3) * 64 + ch * 8) = v; }
        __syncthreads();
        float acc[16][2];
#pragma unroll
        for (int r = 0; r < 16; ++r) { acc[r][0] = 0.f; acc[r][1] = 0.f; }
        for (int li = 0; li < 4; ++li) { const int l = 4 * F.wave + li;
            for (int d = 0; d < 64; ++d) {
                const float wa = w1[(size_t)(l * 64 + d) * CMP_HID + F.lane], wb = w1[(size_t)(l * 64 + d) * CMP_HID + 64 + F.lane], pv = pe[l * 64 + d];
#pragma unroll
                for (int r = 0; r < 16; ++r) { const float x = bf2f(SL[(16 * r + l) * 64 + d]) + pv; acc[r][0] += x * wa; acc[r][1] += x * wb; }
            } }
#pragma unroll
        for (int r = 0; r < 16; ++r) { PH[(F.wave * 16 + r) * 128 + F.lane] = acc[r][0]; PH[(F.wave * 16 + r) * 128 + 64 + F.lane] = acc[r][1]; }
        __syncthreads();
        for (int i = F.tid; i < 16 * 128; i += 512) { float s = 0.f;
#pragma unroll
            for (int w = 0; w < 8; ++w) s += PH[w * 2048 + i];
            HID[i] = silu_f(s); }
        __syncthreads();
        for (int i = F.tid; i < 16 * 64; i += 512) { const int r = i >> 6, e = i & 63; float s = 0.f;
            for (int j = 0; j < CMP_HID; ++j) s += HID[r * 128 + j] * w2[j * 64 + e];
            const int n = n0 + r; OUT[(size_t)n * 128 + g * 64 + e] = (bf16)(n < NCMP ? f2bf(s) : 0u); }
        __syncthreads();
    }
}
__device__ const unsigned char T5_BUCKET[128] = {0, 1, 2, 3, 4, 5, 6, 7, 8, 9, 10, 11, 12, 13, 14, 15, 16, 16, 16, 17, 17, 18, 18, 18, 19, 19, 19, 20, 20, 20, 20, 21, 21, 21, 21, 22, 22, 22, 22, 22, 23, 23, 23, 23, 23, 23, 24, 24, 24, 24, 24, 24, 25, 25, 25, 25, 25, 25, 25, 26, 26, 26, 26, 26, 26, 26, 26, 27, 27, 27, 27, 27, 27, 27, 27, 27, 27, 28, 28, 28, 28, 28, 28, 28, 28, 28, 28, 29, 29, 29, 29, 29, 29, 29, 29, 29, 29, 29, 29, 30, 30, 30, 30, 30, 30, 30, 30, 30, 30, 30, 30, 30, 30, 31, 31, 31, 31, 31, 31, 31, 31, 31, 31, 31, 31, 31, 31, 31};
__device__ __forceinline__ float dot64(const float (&q)[64], const bf16* krow) {
    const v4u* p = (const v4u*)krow; float s = 0.f;
#pragma unroll
    for (int c = 0; c < 8; ++c) { const v4u w = p[c];
        s += q[8 * c + 0] * bflo(w.x) + q[8 * c + 1] * bfhi(w.x) + q[8 * c + 2] * bflo(w.y) + q[8 * c + 3] * bfhi(w.y)
           + q[8 * c + 4] * bflo(w.z) + q[8 * c + 5] * bfhi(w.z) + q[8 * c + 6] * bflo(w.w) + q[8 * c + 7] * bfhi(w.w); }
    return s;
}
__device__ __forceinline__ unsigned ord_f32(float f) { const unsigned u = __float_as_uint(f); return (u & 0x80000000u) ? ~u : (u | 0x80000000u); }
__device__ __forceinline__ void attn_simple_phase(const Args& a, const Frame& F) {
    LAS float* BL = (LAS float*)(F.lds + RING_OFF);
    LAS float* PC = BL + 1024;
    LAS float* PS = PC + 8192;
    LAS float* PW = PS + 8192;
    LAS float* SCO = PW + 4096;
    LAS int* SEL = (LAS int*)(SCO + 512);
    for (int i = F.tid; i < 1024; i += 512) BL[i] = a.in[I_RELB][(i >> 7) * 32 + T5_BUCKET[i & 127]];
    __syncthreads();
    const bf16* Q = WSP(const bf16, WS_Q); const bf16* KV = WSP(const bf16, WS_KV); const bf16* KC = WSP(const bf16, WS_KCMP); const bf16* VC = WSP(const bf16, WS_VCMP);
    const float* GT = WSP(const float, WS_GT); bf16* Y = WSP(bf16, WS_HB);
    const int g = F.wave >> 2, h = F.wave, lane = F.lane;
    LAS float* pc = PC + F.wave * 1024; LAS float* ps = PS + F.wave * 1024; LAS float* pw = PW + F.wave * 512; const LAS float* bl = BL + h * 128;
    for (int t = F.bid; t < SEQ; t += F.G) {
        float q[64];
        { const v4u* qp = (const v4u*)(Q + (size_t)t * 512 + h * 64);
#pragma unroll
          for (int c = 0; c < 8; ++c) { const v4u w = qp[c]; q[8 * c] = bflo(w.x); q[8 * c + 1] = bfhi(w.x); q[8 * c + 2] = bflo(w.y); q[8 * c + 3] = bfhi(w.y); q[8 * c + 4] = bflo(w.z); q[8 * c + 5] = bfhi(w.z); q[8 * c + 6] = bflo(w.w); q[8 * c + 7] = bfhi(w.w); } }
        const int cur = t >> 6, nval = t >= 31 ? ((t - 31) >> 4) + 1 : 0;
        {   float s[16]; float mx = -3.0e38f;
#pragma unroll
            for (int i = 0; i < 16; ++i) { const int n = lane + 64 * i; s[i] = -3.0e38f;
                if (n < nval) { const int d = t - 16 * n - 31; s[i] = dot64(q, KC + (size_t)n * 128 + g * 64) + bl[d < 127 ? d : 127]; } mx = fmaxf(mx, s[i]); }
            mx = wave_max(mx); float l = 0.f;
#pragma unroll
            for (int i = 0; i < 16; ++i) { const int n = lane + 64 * i; s[i] = (n < nval) ? __expf(s[i] - mx) : 0.f; l += s[i]; }
            l = wave_sum(l); const float inv = 1.0f / fmaxf(l, 1e-30f);
#pragma unroll
            for (int i = 0; i < 16; ++i) pc[lane + 64 * i] = s[i] * inv;
        }
        __syncthreads();
        {   const int J = F.tid & 255, gg = F.tid >> 8; float imp = 0.f;
#pragma unroll
            for (int hh = 0; hh < 4; ++hh)
#pragma unroll
                for (int i = -1; i < 4; ++i) { const int n = 4 * J + i; if (n >= 0 && n < NCMP) imp += PC[(gg * 4 + hh) * 1024 + n]; }
            const bool forced = (J == 0) || (J == cur) || (J == cur - 1);
            SCO[gg * 256 + J] = forced ? 1.0e4f : (J <= cur ? imp : -1.0f);
        }
        float oc = 0.f;
        for (int n = 0; n < nval; ++n) oc += pc[n] * bf2f(VC[(size_t)n * 128 + g * 64 + lane]);
        __syncthreads();
        if ((F.wave & 3) == 0) {
            unsigned long long key[4];
#pragma unroll
            for (int i = 0; i < 4; ++i) { const int J = lane + 64 * i; key[i] = ((unsigned long long)ord_f32(SCO[g * 256 + J]) << 32) | (unsigned)(255 - J); }
            for (int r = 0; r < NTOP; ++r) {
                unsigned long long best = key[0];
#pragma unroll
                for (int i = 1; i < 4; ++i) best = key[i] > best ? key[i] : best;
#pragma unroll
                for (int o = 1; o < 64; o <<= 1) { const unsigned long long other = __shfl_xor(best, o); best = other > best ? other : best; }
                const int Js = 255 - (int)(unsigned)(best & 0xffffffffull);
                if (lane == 0) SEL[g * 16 + r] = Js;
#pragma unroll
                for (int i = 0; i < 4; ++i) if (lane + 64 * i == Js) key[i] = 0ull;
            }
        }
        __syncthreads();
        {   float s[16]; float mx = -3.0e38f;
#pragma unroll
            for (int r = 0; r < 16; ++r) { const int J = SEL[g * 16 + r], sp = 64 * J + lane; s[r] = -3.0e38f;
                if (sp <= t) { const int d = t - sp; s[r] = dot64(q, KV + (size_t)sp * 768 + 256 + g * 64) + bl[d < 127 ? d : 127]; } mx = fmaxf(mx, s[r]); }
            mx = wave_max(mx); float l = 0.f;
#pragma unroll
            for (int r = 0; r < 16; ++r) { const int J = SEL[g * 16 + r], sp = 64 * J + lane; s[r] = (sp <= t) ? __expf(s[r] - mx) : 0.f; l += s[r]; }
            l = wave_sum(l); const float inv = 1.0f / fmaxf(l, 1e-30f);
#pragma unroll
            for (int r = 0; r < 16; ++r) ps[64 * r + lane] = s[r] * inv;
        }
        {   float s[8]; float mx = -3.0e38f;
#pragma unroll
            for (int i = 0; i < 8; ++i) { const int sp = t - (WIN - 1) + lane + 64 * i; s[i] = -3.0e38f;
                if (sp >= 0) { const int d = t - sp; s[i] = dot64(q, KV + (size_t)sp * 768 + 512 + g * 64) + bl[d < 127 ? d : 127]; } mx = fmaxf(mx, s[i]); }
            mx = wave_max(mx); float l = 0.f;
#pragma unroll
            for (int i = 0; i < 8; ++i) { const int sp = t - (WIN - 1) + lane + 64 * i; s[i] = (sp >= 0) ? __expf(s[i] - mx) : 0.f; l += s[i]; }
            l = wave_sum(l); const float inv = 1.0f / fmaxf(l, 1e-30f);
#pragma unroll
            for (int i = 0; i < 8; ++i) pw[64 * i + lane] = s[i] * inv;
        }
        asm volatile("s_waitcnt lgkmcnt(0)" ::: "memory");
        float os = 0.f, ow = 0.f;
        for (int r = 0; r < 16; ++r) { const int J = SEL[g * 16 + r]; if (J > cur) continue;
            const bf16* vp = KV + (size_t)(64 * J) * 768 + 384 + g * 64 + lane;
#pragma unroll 8
            for (int k = 0; k < 64; ++k) os += ps[64 * r + k] * bf2f(vp[(size_t)k * 768]); }
        { const int s0 = t - (WIN - 1);
          for (int i = (s0 < 0 ? -s0 : 0); i < WIN; ++i) ow += pw[i] * bf2f(KV[(size_t)(s0 + i) * 768 + 640 + g * 64 + lane]); }
        const float gc = GT[(size_t)t * 24 + h * 3 + 0], gs = GT[(size_t)t * 24 + h * 3 + 1], gw = GT[(size_t)t * 24 + h * 3 + 2];
        Y[(size_t)t * DM + 512 + h * 64 + lane] = (bf16)f2bf(gc * oc + gs * os + gw * ow);
        __syncthreads();
    }
}
__global__ void __launch_bounds__(NWAVES * 64, 2) fwd_kernel(Args a) {
    extern __shared__ __attribute__((aligned(16))) unsigned char lds[];
    Frame F;
    F.lds = (LAS unsigned char*)lds;
    F.tid = threadIdx.x; F.lane = F.tid & 63; F.wave = __builtin_amdgcn_readfirstlane(F.tid >> 6);
    F.G = gridDim.x; F.bid = blockIdx.x;
    volatile LAS unsigned* MISC = (volatile LAS unsigned*)(F.lds + MISC_OFF);
    for (int u = F.tid; u < (LDS_BYTES - LDSCTL_OFF) / 4; u += NWAVES * 64) ((LAS unsigned*)(F.lds + LDSCTL_OFF))[u] = 0u;
    __syncthreads();
    const int lo = a.ph_lo, hi = a.ph_hi;
    const bool multi = (hi - lo) > 1;
    unsigned* barw = WSP(unsigned, WS_CTL) + CW_BAR;
    XcdBarrier bar; bar.bar = barw; bar.x = 0; bar.st = MISC + 8;
    if (multi) bar = xcd_barrier_post(barw, MISC + 8);
#define IN(k) (lo <= (k) && (k) < hi)
#define SEAM(k) do { if (IN(k) && IN((k) + 1)) xcd_barrier(bar); } while (0)
    PG8_LAS unsigned char* ring = F.lds + RING_OFF;

    if (IN(0)) { p0_prologue(a, F); } SEAM(0);
    if (IN(1)) { norm_mod_pass<true>(a, F, a.in[I_X], WSP(bf16, WS_HB), a.in[I_GFFN1], 0); } SEAM(1);
    if (IN(2)) {
        pg8::Gemm g{WSP(const bf16, WS_HB), WSP(const bf16, WS_WGU1), SEQ, 2 * DFF, DM}; pg8::StaticOrder S; S.init(SEQ, 2 * DFF, F.G, F.bid);
        pg8::EpiSwiGLU E{WSP(bf16, WS_ACT), DFF};
        pg8::gemm_phase<pg8::EpiSwiGLU, pg8::StaticOrder, PG8_ALIGN, PG8_SP2>(ring, g, S, E);
    } SEAM(2);
    if (IN(3)) {
        pg8::Gemm g{WSP(const bf16, WS_ACT), WSP(const bf16, WS_WD1), SEQ, DM, DFF}; pg8::StaticOrder S; S.init(SEQ, DM, F.G, F.bid);
        pg8::EpiResid E{a.in[I_X], WSP(float, WS_XB), DM, WSP(const float, WS_MOD) + 2 * DM, 0.5f};
        pg8::gemm_phase<pg8::EpiResid, pg8::StaticOrder, false, PG8_SP2>(ring, g, S, E);
    } SEAM(3);
    if (IN(4)) { norm_mod_pass<false>(a, F, WSP(const float, WS_XB), WSP(bf16, WS_HB), a.in[I_GMIX], 1); } SEAM(4);
    if (IN(5)) {
        pg8::Gemm g{WSP(const bf16, WS_HB), WSP(const bf16, WS_WIN), SEQ, DIN_PAD, DM}; pg8::StaticOrder S; S.init(SEQ, DIN_PAD, F.G, F.bid);
        pg8::EpiMix E{WSP(bf16, WS_HG), WSP(bf16, WS_Q), WSP(bf16, WS_KV), WSP(float, WS_GT)};
        pg8::gemm_phase<pg8::EpiMix, pg8::StaticOrder, PG8_ALIGN, PG8_SP2>(ring, g, S, E);
    } SEAM(5);
    if (IN(6)) { conv_phase(a, F); compress_phase(a, F); } SEAM(6);
    if (IN(7)) { attn_simple_phase(a, F); } SEAM(7);
    if (IN(8)) {
        pg8::Gemm g{WSP(const bf16, WS_HB), WSP(const bf16, WS_WOUT), SEQ, DM, DM}; pg8::StaticOrder S; S.init(SEQ, DM, F.G, F.bid);
        pg8::EpiResid E{WSP(const float, WS_XB), WSP(float, WS_XB), DM, WSP(const float, WS_MOD) + 5 * DM, 1.0f};
        pg8::gemm_phase<pg8::EpiResid, pg8::StaticOrder, false, PG8_SP2>(ring, g, S, E);
    } SEAM(8);
    if (IN(9)) { norm_mod_pass<false>(a, F, WSP(const float, WS_XB), WSP(bf16, WS_HB), a.in[I_GFFN2], 2); } SEAM(9);
    if (IN(10)) {
        pg8::Gemm g{WSP(const bf16, WS_HB), WSP(const bf16, WS_WGU2), SEQ, 2 * DFF, DM}; pg8::StaticOrder S; S.init(SEQ, 2 * DFF, F.G, F.bid);
        pg8::EpiSwiGLU E{WSP(bf16, WS_ACT), DFF};
        pg8::gemm_phase<pg8::EpiSwiGLU, pg8::StaticOrder, PG8_ALIGN, PG8_SP2>(ring, g, S, E);
    } SEAM(10);
    if (IN(11)) {
        pg8::Gemm g{WSP(const bf16, WS_ACT), WSP(const bf16, WS_WD2), SEQ, DM, DFF}; pg8::StaticOrder S; S.init(SEQ, DM, F.G, F.bid);
        pg8::EpiResid E{WSP(const float, WS_XB), a.out, DM, WSP(const float, WS_MOD) + 8 * DM, 0.5f};
        pg8::gemm_phase<pg8::EpiResid, pg8::StaticOrder, false, PG8_SP2>(ring, g, S, E);
    } SEAM(11);
    if (IN(12)) { final_norm_pass(a, F); }
#undef IN
#undef SEAM
}

extern "C" void kernel_launch(void* const* d_in, const int* in_sizes, int n_in, void* d_out, int out_size, void* d_ws, size_t ws_size, hipStream_t stream) {
    static int grid = 0;
    if (grid == 0) {
        if (n_in != N_IN || in_sizes[0] != SEQ * DM || out_size != SEQ * DM || ws_size < WS_END) { fprintf(stderr, "kernel_launch: unexpected problem shape (n_in %d, ws %zu); nothing launched\n", n_in, ws_size); grid = -1; return; }
        int dev = 0, cus = 0, per_cu = 0;
        if (hipGetDevice(&dev) != hipSuccess || hipDeviceGetAttribute(&cus, hipDeviceAttributeMultiprocessorCount, dev) != hipSuccess) { grid = -1; return; }
        if (hipFuncSetAttribute((const void*)fwd_kernel, hipFuncAttributeMaxDynamicSharedMemorySize, LDS_BYTES) != hipSuccess) { fprintf(stderr, "kernel_launch: hipFuncSetAttribute failed\n"); grid = -1; return; }
        if (hipOccupancyMaxActiveBlocksPerMultiprocessor(&per_cu, (const void*)fwd_kernel, NWAVES * 64, LDS_BYTES) != hipSuccess || per_cu < 1)
            fprintf(stderr, "kernel_launch: note: occupancy query reports %d workgroups per CU\n", per_cu);
        (void)hipGetLastError();
        grid = cus;
    }
    if (grid < 0) return;
    if (hipMemsetAsync((char*)d_ws + WS_CTL, 0, CTL_ZERO_BYTES, stream) != hipSuccess) return;
    Args a{};
    for (int i = 0; i < N_IN; ++i) a.in[i] = (const float*)d_in[i];
    a.out = (float*)d_out; a.ws = (unsigned char*)d_ws;
#if MK_LAUNCHES == 1
    a.ph_lo = 0; a.ph_hi = N_PHASES;
    hipLaunchKernelGGL(fwd_kernel, dim3(grid), dim3(NWAVES * 64), LDS_BYTES, stream, a);
#else
    for (int p = 0; p < N_PHASES; ++p) { a.ph_lo = p; a.ph_hi = p + 1; hipLaunchKernelGGL(fwd_kernel, dim3(grid), dim3(NWAVES * 64), LDS_BYTES, stream, a); }
#endif
}
```

```cpp
#include <hip/hip_runtime.h>
#include <cstdio>
#include <cstdint>
namespace pg8 {
#define PG8_LAS __attribute__((address_space(3)))
typedef unsigned short bf16_t;
typedef short bf16x8 __attribute__((ext_vector_type(8)));
typedef float f32x4 __attribute__((ext_vector_type(4)));
typedef unsigned u32x4 __attribute__((ext_vector_type(4)));
constexpr int BM = 256, BK = 64, HALF = 128, HTB = HALF * BK * 2  , STAGE_BYTES = 8 * HTB, NXCD = 8, WGM = 8;

__host__ __device__ __forceinline__ int lds_byte(int r, int c) { const int st = (r >> 4) * 2 + (c >> 5), rr = r & 15, cc = c & 31, ob = rr * 64 + cc * 2; return st * 1024 + (ob ^ (((ob >> 9) & 1) << 5)); }
__host__ __device__ __forceinline__ void stage_rc(int b, int& R, int& C) { const int st = b / 1024, sb = b % 1024, swz = sb ^ (((sb >> 9) & 1) << 5); R = (st >> 1) * 16 + swz / 64; C = (st & 1) * 32 + (swz % 64) / 2; }
__host__ __device__ __forceinline__ int perm32(int rho) { const int n = rho >> 4, i = rho & 15; return 8 * (i >> 2) + 4 * n + (i & 3); }

struct Unit { int pm, pn; };
struct Gemm { const bf16_t* A; const bf16_t* Bt; int M, N, K; };

struct StaticOrder {
    int nM, nN, nwg, G, c;
    __host__ __device__ void init(int M, int N, int G_, int c_) { nM = M / BM; nN = N / BM; nwg = nM * nN; G = G_; c = c_; }
    __host__ __device__ bool next(int i, Unit& u) const {
        const long L = (long)i * G + c; if (L >= nwg) return false;
        int wgid = (int)L; { const int q = nwg / NXCD, r = nwg % NXCD, xcd = wgid % NXCD, off = wgid / NXCD; wgid = (xcd < r ? xcd * (q + 1) : r * (q + 1) + (xcd - r) * q) + off; }
        const int nig = WGM * nN, gid = wgid / nig, fm = gid * WGM, gsz = (nM - fm) < WGM ? (nM - fm) : WGM;
        u.pm = fm + ((wgid % nig) % gsz); u.pn = (wgid % nig) / gsz; return true;
    }
    __device__ __forceinline__ void a_ready(const Unit&) const {}
    __device__ __forceinline__ void done(const Unit&) const {}
};


__device__ __forceinline__ unsigned cvt_pk_bf16(float lo, float hi) { unsigned r; asm volatile("v_cvt_pk_bf16_f32 %0, %1, %2" : "=v"(r) : "v"(lo), "v"(hi)); return r; }
__device__ __forceinline__ float sigmoid_f(float x) { return __builtin_amdgcn_rcpf(1.0f + __builtin_amdgcn_exp2f(-1.4426950408889634f * x)); }
__device__ __forceinline__ float silu_f(float x) { return x * sigmoid_f(x); }

template <bool GLU> __device__ __forceinline__ void gated_store(const f32x4 (&acc)[2][2][4][2], bf16_t* O, int ldc, int row0, int col0) {
#pragma unroll
    for (int ai = 0; ai < 2; ++ai)
#pragma unroll
        for (int m = 0; m < 4; ++m) { bf16_t* rowp = O + (size_t)(row0 + ai * HALF + m * 16) * ldc + col0;
            float v[8];
#pragma unroll
            for (int n = 0; n < 2; ++n)
#pragma unroll
                for (int e = 0; e < 4; ++e) { const float a = acc[ai][0][m][n][e], b = acc[ai][1][m][n][e]; v[n * 4 + e] = GLU ? a * sigmoid_f(b) : silu_f(a) * b; }
            u32x4 w; w.x = cvt_pk_bf16(v[0], v[1]); w.y = cvt_pk_bf16(v[2], v[3]); w.z = cvt_pk_bf16(v[4], v[5]); w.w = cvt_pk_bf16(v[6], v[7]);
            *(u32x4*)rowp = w; }
}
struct EpiSwiGLU {
    static constexpr bool PERM = true, AFTER_DRAIN = false;
    bf16_t* O; int ldc;
    __device__ __forceinline__ void operator()(const f32x4 (&acc)[2][2][4][2], const Unit& u, int wr, int wc, int fr, int fq) const {
        gated_store<false>(acc, O, ldc, u.pm * BM + wr * 64 + fr, u.pn * HALF + wc * 32 + 8 * fq);
    }
};
struct EpiResid {
    static constexpr bool PERM = false, AFTER_DRAIN = false;
    const float* base; float* out; int ldc; const float* gate; float scale;
    __device__ __forceinline__ void operator()(const f32x4 (&acc)[2][2][4][2], const Unit& u, int wr, int wc, int fr, int fq) const {
        const int col0 = u.pn * BM + wc * 32 + 4 * fq, row0 = u.pm * BM + wr * 64 + fr;
        f32x4 cf[2][2];
#pragma unroll
        for (int bj = 0; bj < 2; ++bj)
#pragma unroll
            for (int n = 0; n < 2; ++n) cf[bj][n] = *(const f32x4*)(gate + col0 + bj * HALF + n * 16) * scale;
#pragma unroll
        for (int ai = 0; ai < 2; ++ai)
#pragma unroll
            for (int m = 0; m < 4; ++m) { const size_t off = (size_t)(row0 + ai * HALF + m * 16) * ldc + col0;
#pragma unroll
                for (int bj = 0; bj < 2; ++bj)
#pragma unroll
                    for (int n = 0; n < 2; ++n) { const f32x4 bs = *(const f32x4*)(base + off + bj * HALF + n * 16); *(f32x4*)(out + off + bj * HALF + n * 16) = bs + cf[bj][n] * acc[ai][bj][m][n]; }
                if (m & 1) asm volatile("" ::: "memory"); }
    }
};
struct EpiMix {
    static constexpr bool PERM = true, AFTER_DRAIN = false;
    bf16_t* HG; bf16_t* Q; bf16_t* KV; float* GT;
    __device__ __forceinline__ void operator()(const f32x4 (&acc)[2][2][4][2], const Unit& u, int wr, int wc, int fr, int fq) const {
        const int row0 = u.pm * BM + wr * 64 + fr, c8 = wc * 32 + 8 * fq;
        if (u.pn < 4) { gated_store<true>(acc, HG, 512, row0, u.pn * HALF + c8); return; }
        if (u.pn == 9) {
            if (c8 < 24) {
#pragma unroll
                for (int ai = 0; ai < 2; ++ai)
#pragma unroll
                    for (int m = 0; m < 4; ++m) { float* rowp = GT + (size_t)(row0 + ai * HALF + m * 16) * 24 + c8;
#pragma unroll
                        for (int n = 0; n < 2; ++n) { const f32x4 a = acc[ai][0][m][n]; *(f32x4*)(rowp + 4 * n) = (f32x4){sigmoid_f(a[0]), sigmoid_f(a[1]), sigmoid_f(a[2]), sigmoid_f(a[3])}; } }
            }
            return;
        }
        bf16_t* O; int ldc, colt; float sc;
        if (u.pn < 6) { O = Q; ldc = 512; colt = (u.pn - 4) * BM; sc = 0.125f * 1.4426950408889634f; } else { O = KV; ldc = 768; colt = (u.pn - 6) * BM; sc = 1.0f; }
#pragma unroll
        for (int ai = 0; ai < 2; ++ai)
#pragma unroll
            for (int m = 0; m < 4; ++m) { bf16_t* rowp = O + (size_t)(row0 + ai * HALF + m * 16) * ldc + colt + c8;
#pragma unroll
                for (int bj = 0; bj < 2; ++bj) { const f32x4 v0 = acc[ai][bj][m][0] * sc, v1 = acc[ai][bj][m][1] * sc;
                    u32x4 w; w.x = cvt_pk_bf16(v0[0], v0[1]); w.y = cvt_pk_bf16(v0[2], v0[3]); w.z = cvt_pk_bf16(v1[0], v1[1]); w.w = cvt_pk_bf16(v1[2], v1[3]);
                    *(u32x4*)(rowp + bj * HALF) = w; } }
    }
};

template <class Epi, class Sched, bool ALIGN_EPI = false, bool SP2 = false>
__device__ __forceinline__ void gemm_phase(PG8_LAS unsigned char* lds, const Gemm g, const Sched& S, const Epi& E) {
    const int tid = threadIdx.x, wid = __builtin_amdgcn_readfirstlane(tid >> 6), lane = tid & 63, wr = wid >> 2, wc = wid & 3, fr = lane & 15, fq = lane >> 4;
    const int K = g.K, nt = K / BK;
    unsigned voffA[2], voffB[2];
#pragma unroll
    for (int i = 0; i < 2; ++i) { int R, C; stage_rc(tid * 16 + i * 8192, R, C); const int Rb = Epi::PERM ? ((R & ~31) + perm32(R & 31)) : R;
        voffA[i] = (unsigned)(R * K + C) * 2u; voffB[i] = (unsigned)(Rb * K + C) * 2u; }
    const size_t kstep = (size_t)(BK * 2);
    const size_t hstep = (size_t)HALF * K * 2;
    const size_t tstep = 2 * hstep;
    const unsigned ldsw = (unsigned)wid * 1024u;
    const int aoff = lds_byte(wr * 64 + fr, fq * 8), boff = lds_byte(wc * 32 + fr, fq * 8);
#define PG8_SA(b, h) (((b) * 2 + (h)) * HTB)
#define PG8_SB(b, h) ((4 + (b) * 2 + (h)) * HTB)
#define PG8_STAGE(bufoff, gbase, voff) do { _Pragma("unroll") for (int _i = 0; _i < 2; ++_i) \
        __builtin_amdgcn_global_load_lds((const unsigned*)((const char*)(gbase) + (voff)[_i]), (PG8_LAS unsigned*)(lds + (bufoff) + ldsw + _i * 8192), 16, 0, 0); } while (0)
#define PG8_LDA(dst, b, h) do { _Pragma("unroll") for (int m = 0; m < 4; ++m) _Pragma("unroll") for (int k = 0; k < 2; ++k) dst[m][k] = *(const PG8_LAS bf16x8*)(lds + PG8_SA(b, h) + aoff + m * 2048 + k * 1024); } while (0)
#define PG8_LDB(dst, b, h) do { _Pragma("unroll") for (int n = 0; n < 2; ++n) _Pragma("unroll") for (int k = 0; k < 2; ++k) dst[n][k] = *(const PG8_LAS bf16x8*)(lds + PG8_SB(b, h) + boff + n * 2048 + k * 1024); } while (0)
#define PG8_MMA(ai, bj, At, Bt) do { __builtin_amdgcn_s_setprio(1); _Pragma("unroll") for (int m = 0; m < 4; ++m) _Pragma("unroll") for (int n = 0; n < 2; ++n) _Pragma("unroll") for (int k = 0; k < 2; ++k) \
        acc[ai][bj][m][n] = __builtin_amdgcn_mfma_f32_16x16x32_bf16(Bt[n][k], At[m][k], acc[ai][bj][m][n], 0, 0, 0); __builtin_amdgcn_s_setprio(0); } while (0)
#define PG8_WAIT_V(n) asm volatile("s_waitcnt vmcnt(" #n ")" ::: "memory")
#define PG8_WAIT_L(n) asm volatile("s_waitcnt lgkmcnt(" #n ")" ::: "memory")
#define PG8_BAR __builtin_amdgcn_s_barrier()
#define PG8_SCHED __builtin_amdgcn_sched_barrier(0)
    Unit cur, nxt; int ui = 0;
    if (!S.next(0, cur)) return;
    f32x4 acc[2][2][4][2];
#pragma unroll
    for (int a = 0; a < 2; ++a)
#pragma unroll
        for (int b = 0; b < 2; ++b)
#pragma unroll
            for (int m = 0; m < 4; ++m)
#pragma unroll
                for (int n = 0; n < 2; ++n) acc[a][b][m][n] = (f32x4){0.f, 0.f, 0.f, 0.f};
    bf16x8 At[4][2], B0[2][2], B1[2][2];
    const char* cA = (const char*)g.A + (size_t)cur.pm * tstep; const char* cB = (const char*)g.Bt + (size_t)cur.pn * tstep;
    S.a_ready(cur);
    if constexpr (SP2) {
        PG8_STAGE(PG8_SB(0, 0), cB, voffB); PG8_STAGE(PG8_SB(0, 1), cB + hstep, voffB); PG8_STAGE(PG8_SA(0, 0), cA, voffA); PG8_STAGE(PG8_SA(0, 1), cA + hstep, voffA);
        if (wr == 1) PG8_BAR;
        PG8_WAIT_V(2); PG8_BAR;
        PG8_STAGE(PG8_SB(1, 0), cB + kstep, voffB); PG8_STAGE(PG8_SA(1, 0), cA + kstep, voffA); PG8_STAGE(PG8_SB(1, 1), cB + hstep + kstep, voffB);
        PG8_WAIT_V(6); PG8_BAR;
    } else {
        PG8_STAGE(PG8_SB(0, 0), cB, voffB); PG8_STAGE(PG8_SA(0, 0), cA, voffA); PG8_STAGE(PG8_SB(0, 1), cB + hstep, voffB); PG8_STAGE(PG8_SA(0, 1), cA + hstep, voffA);
        if (wr == 1) PG8_BAR;
        PG8_WAIT_V(4); PG8_BAR;
        PG8_STAGE(PG8_SB(1, 0), cB + kstep, voffB); PG8_STAGE(PG8_SA(1, 0), cA + kstep, voffA); PG8_STAGE(PG8_SB(1, 1), cB + hstep + kstep, voffB);
        PG8_WAIT_V(6); PG8_BAR;
    }
    for (;;) {
        const bool has_next = S.next(ui + 1, nxt);
        const char* nA = has_next ? (const char*)g.A + (size_t)nxt.pm * tstep : cA; const char* nB = has_next ? (const char*)g.Bt + (size_t)nxt.pn * tstep : cB;
        for (int t = 0; t < nt; t += 2) {
            const bool last = (t == nt - 2);
            const char* a1 = cA + (size_t)(t + 1) * kstep;
            const char* a2 = last ? nA : cA + (size_t)(t + 2) * kstep; const char* b2 = last ? nB : cB + (size_t)(t + 2) * kstep;
            const char* a3 = a2 + kstep; const char* b3 = b2 + kstep;
            if (last && has_next) S.a_ready(nxt);
            if constexpr (SP2) {
            PG8_LDB(B0, 0, 0); PG8_LDB(B1, 0, 1); PG8_SCHED; PG8_LDA(At, 0, 0); PG8_STAGE(PG8_SA(1, 1), a1 + hstep, voffA);
            PG8_WAIT_V(8); PG8_WAIT_L(0); PG8_BAR; PG8_MMA(0, 0, At, B0); PG8_MMA(0, 1, At, B1); PG8_BAR; PG8_SCHED;
            PG8_LDA(At, 0, 1); PG8_STAGE(PG8_SB(0, 0), b2, voffB); PG8_STAGE(PG8_SB(0, 1), b2 + hstep, voffB); PG8_STAGE(PG8_SA(0, 0), a2, voffA);
            PG8_WAIT_V(8); PG8_WAIT_L(0); PG8_BAR; PG8_MMA(1, 0, At, B0); PG8_MMA(1, 1, At, B1); PG8_BAR; PG8_SCHED;
            PG8_LDB(B0, 1, 0); PG8_LDB(B1, 1, 1); PG8_SCHED; PG8_LDA(At, 1, 0); PG8_STAGE(PG8_SA(0, 1), a2 + hstep, voffA);
            PG8_WAIT_V(8); PG8_WAIT_L(0); PG8_BAR; PG8_MMA(0, 0, At, B0); PG8_MMA(0, 1, At, B1); PG8_BAR; PG8_SCHED;
            PG8_LDA(At, 1, 1); PG8_STAGE(PG8_SB(1, 0), b3, voffB); PG8_STAGE(PG8_SB(1, 1), b3 + hstep, voffB); PG8_STAGE(PG8_SA(1, 0), a3, voffA);
            PG8_WAIT_V(8); PG8_WAIT_L(0); PG8_BAR; PG8_MMA(1, 0, At, B0); PG8_MMA(1, 1, At, B1); PG8_BAR; PG8_SCHED;
            } else {
            PG8_LDB(B0, 0, 0); PG8_SCHED; PG8_LDA(At, 0, 0); PG8_STAGE(PG8_SA(1, 1), a1 + hstep, voffA);
            PG8_WAIT_L(8); PG8_BAR; PG8_WAIT_L(0); PG8_MMA(0, 0, At, B0); PG8_BAR; PG8_SCHED;
            PG8_LDB(B1, 0, 1); PG8_STAGE(PG8_SB(0, 0), b2, voffB);
            PG8_BAR; PG8_WAIT_L(0); PG8_MMA(0, 1, At, B1); PG8_BAR;
            PG8_LDA(At, 0, 1); PG8_STAGE(PG8_SA(0, 0), a2, voffA);
            PG8_BAR; PG8_WAIT_L(0); PG8_MMA(1, 0, At, B0); PG8_BAR; PG8_SCHED;
            PG8_STAGE(PG8_SB(0, 1), b2 + hstep, voffB);
            PG8_WAIT_V(6); PG8_BAR; PG8_MMA(1, 1, At, B1); PG8_BAR;
            PG8_LDB(B0, 1, 0); PG8_SCHED; PG8_LDA(At, 1, 0); PG8_STAGE(PG8_SA(0, 1), a2 + hstep, voffA);
            PG8_WAIT_L(8); PG8_BAR; PG8_WAIT_L(0); PG8_MMA(0, 0, At, B0); PG8_BAR; PG8_SCHED;
            PG8_LDB(B1, 1, 1); PG8_STAGE(PG8_SB(1, 0), b3, voffB);
            PG8_BAR; PG8_WAIT_L(0); PG8_MMA(0, 1, At, B1); PG8_BAR;
            PG8_LDA(At, 1, 1); PG8_STAGE(PG8_SA(1, 0), a3, voffA);
            PG8_BAR; PG8_WAIT_L(0); PG8_MMA(1, 0, At, B0); PG8_BAR; PG8_SCHED;
            PG8_STAGE(PG8_SB(1, 1), b3 + hstep, voffB);
            PG8_WAIT_V(6); PG8_BAR; PG8_MMA(1, 1, At, B1); PG8_BAR;
            }
        }
        if constexpr (ALIGN_EPI) { if (wr == 0) PG8_BAR; }
        if constexpr (!Epi::AFTER_DRAIN) { E(acc, cur, wr, wc, fr, fq); S.done(cur); }
        if (!has_next) break;
#pragma unroll
        for (int a = 0; a < 2; ++a)
#pragma unroll
            for (int b = 0; b < 2; ++b)
#pragma unroll
                for (int m = 0; m < 4; ++m)
#pragma unroll
                    for (int n = 0; n < 2; ++n) acc[a][b][m][n] = (f32x4){0.f, 0.f, 0.f, 0.f};
        cur = nxt; cA = nA; cB = nB; ++ui;
        if constexpr (ALIGN_EPI) { if (wr == 1) PG8_BAR; }
    }
    PG8_WAIT_V(0);
    if constexpr (!ALIGN_EPI) { if (wr == 0) PG8_BAR; }
    PG8_BAR;
    if constexpr (Epi::AFTER_DRAIN) { E.fused(acc, cur, wr, wc, fr, fq, lds, wid, lane); S.done(cur); }
#undef PG8_SA
#undef PG8_SB
#undef PG8_STAGE
#undef PG8_LDA
#undef PG8_LDB
#undef PG8_MMA
#undef PG8_WAIT_V
#undef PG8_WAIT_L
#undef PG8_BAR
#undef PG8_SCHED
}
}
#ifndef PG8_SP2
#define PG8_SP2 true
#endif
#ifndef PG8_ALIGN
#define PG8_ALIGN true
#endif
#ifndef MK_LAUNCHES
#define MK_LAUNCHES 1
#endif

constexpr int NWAVES = 8;
constexpr int SEQ = 16384, DM = 1024, DFF = 2816, DCONV = 512, DATT = 512, NH = 8, NG = 2, HPG = 4, HD = 64;
constexpr int DIN = 2328, DIN_PAD = 2560, NCMP = 1023, CONVW = 31, CMP_HID = 128, NSLC = 256, NTOP = 16, WIN = 512;
constexpr float EPS = 1e-6f;
constexpr int N_PHASES = 13;
enum { I_X = 0, I_C, I_WADA, I_BADA, I_GFFN1, I_WGU1, I_WD1, I_GMIX, I_WIN, I_WDW, I_BDW, I_LNG, I_LNB, I_PEK, I_PEV, I_WCK1, I_WCK2, I_WCV1, I_WCV2, I_RELB, I_WOUT, I_GFFN2, I_WGU2, I_WD2, I_GFIN, N_IN };

constexpr size_t MiB = 1u << 20;
constexpr size_t WS_CTL = 0, CTL_ZERO_BYTES = 64 * 1024;
constexpr size_t WS_MODP = 1 * MiB;
constexpr size_t WS_MOD = WS_MODP + 16 * 9216 * 4;
constexpr size_t WS_KCMP = 2 * MiB, WS_VCMP = WS_KCMP + 256 * 1024;
constexpr size_t WS_WGU1 = 4 * MiB, WS_WD1 = 15 * MiB, WS_WIN = 21 * MiB, WS_WOUT = 26 * MiB, WS_WGU2 = 28 * MiB, WS_WD2 = 39 * MiB;
constexpr size_t WS_GT = 45 * MiB;
constexpr size_t WS_HB = 48 * MiB;
constexpr size_t WS_XB = 80 * MiB;
constexpr size_t WS_ACT = 144 * MiB;
constexpr size_t WS_HG = WS_ACT, WS_Q = WS_ACT + 16 * MiB, WS_KV = WS_ACT + 32 * MiB;
constexpr size_t WS_END = 232 * MiB;
static_assert(WS_WD2 + (size_t)DM * DFF * 2 <= WS_GT && WS_GT + (size_t)SEQ * 24 * 4 <= WS_HB && WS_KV + (size_t)SEQ * 768 * 2 <= WS_END && WS_ACT + (size_t)SEQ * DFF * 2 <= WS_END, "d_ws map");
constexpr int CW_BAR = 4096;
constexpr int RING_OFF = 0, RING_BYTES = 131072;
constexpr int LDS_BYTES = 163840;
constexpr int LDSCTL_OFF = LDS_BYTES - 1024, MISC_OFF = LDSCTL_OFF + 320;

#define GAS __attribute__((address_space(1)))
#define LAS __attribute__((address_space(3)))
typedef unsigned short bf16;
typedef unsigned v4u __attribute__((ext_vector_type(4)));
typedef unsigned v2u __attribute__((ext_vector_type(2)));
typedef float f32x4 __attribute__((ext_vector_type(4)));
typedef float f32x2 __attribute__((ext_vector_type(2)));
typedef short bf16x8 __attribute__((ext_vector_type(8)));
typedef GAS unsigned gu32;
#define RLX_AGENT __ATOMIC_RELAXED, __HIP_MEMORY_SCOPE_AGENT
__device__ __forceinline__ unsigned f2bf(float f) { unsigned u = __builtin_bit_cast(unsigned, f); return (u + 0x7fffu + ((u >> 16) & 1u)) >> 16; }
__device__ __forceinline__ unsigned pk2(float lo, float hi) { return f2bf(lo) | (f2bf(hi) << 16); }
__device__ __forceinline__ float bflo(unsigned w) { return __uint_as_float(w << 16); }
__device__ __forceinline__ float bfhi(unsigned w) { return __uint_as_float(w & 0xffff0000u); }
__device__ __forceinline__ float bf2f(bf16 b) { return __uint_as_float((unsigned)b << 16); }
__device__ __forceinline__ float sigmoid_f(float x) { return __builtin_amdgcn_rcpf(1.0f + __builtin_amdgcn_exp2f(-1.4426950408889634f * x)); }
__device__ __forceinline__ float silu_f(float x) { return x * sigmoid_f(x); }
__device__ __forceinline__ float wave_sum(float v) {
#pragma unroll
    for (int o = 1; o < 64; o <<= 1) v += __shfl_xor(v, o);
    return v;
}
__device__ __forceinline__ float wave_max(float v) {
#pragma unroll
    for (int o = 1; o < 64; o <<= 1) v = fmaxf(v, __shfl_xor(v, o));
    return v;
}

#define XB_TMO      128
#define XB_XCNT(j)  (256  + 64 * (j))
#define XB_XSUB(j)  (1280 + 64 * (j))
#define XB_XGEN(j)  (2304 + 64 * (j))
#define XB_TOP      3328
#define XB_TOPGEN   3392
#define XCD_BAR_WORDS 3456
#define XB_SPIN_CAP (1u << 18)
static_assert((CW_BAR + XCD_BAR_WORDS) * 4 <= (int)CTL_ZERO_BYTES, "barrier words inside the memset region");

__device__ __forceinline__ unsigned xb_ld(unsigned* p)              { return __hip_atomic_load(p, __ATOMIC_RELAXED, __HIP_MEMORY_SCOPE_AGENT); }
__device__ __forceinline__ unsigned xb_add(unsigned* p, unsigned v) { return __hip_atomic_fetch_add(p, v, __ATOMIC_RELAXED, __HIP_MEMORY_SCOPE_AGENT); }
__device__ __forceinline__ unsigned xb_xcc_id() { return (unsigned)__builtin_amdgcn_s_getreg((3 << 11) | 20) & 0xFu; }
#define XB_SPIN(cond, bar) do { unsigned _sp = 0; while (cond) { __builtin_amdgcn_s_sleep(1); \
    if ((++_sp & 255u) == 0u) { if (xb_ld(&(bar)[XB_TMO])) break; if (_sp > XB_SPIN_CAP) { atomicAdd(&(bar)[XB_TMO], 1u); break; } } } } while (0)

struct XcdBarrier {
    unsigned* bar; unsigned x;
    volatile LAS unsigned* st;
};
__device__ __forceinline__ XcdBarrier xcd_barrier_post(unsigned* bar, volatile LAS unsigned* st) {
    XcdBarrier b; b.bar = bar; b.x = xb_xcc_id(); b.st = st;
    if (threadIdx.x == 0) (void)xb_add(&bar[XB_XCNT(b.x)], 1u);
    return b;
}
__device__ __forceinline__ void xcd_barrier_complete(unsigned* bar, unsigned x, unsigned& nloc, unsigned& nx) {
    const unsigned G = gridDim.x * gridDim.y * gridDim.z;
    unsigned sum, cnt, mine, sp = 0u;
    for (;;) {
        sum = 0u; cnt = 0u; mine = 0u;
#pragma unroll
        for (unsigned j = 0; j < 16; ++j) { const unsigned c = xb_ld(&bar[XB_XCNT(j)]); sum += c; cnt += (c > 0u) ? 1u : 0u; mine = (j == x) ? c : mine; }
        if (sum == G) break;
        __builtin_amdgcn_s_sleep(1);
        if ((++sp & 255u) == 0u) { if (xb_ld(&bar[XB_TMO])) break; if (sp > XB_SPIN_CAP) { atomicAdd(&bar[XB_TMO], 1u); break; } }
    }
    nloc = mine > 0u ? mine : 1u; nx = cnt > 0u ? cnt : 1u;
}
__device__ __forceinline__ void xcd_barrier(const XcdBarrier& b) {
    asm volatile("s_waitcnt vmcnt(0)" ::: "memory");
    __syncthreads();
    if (threadIdx.x == 0) {
        unsigned* bar = b.bar;
        __builtin_amdgcn_s_waitcnt(0);
        unsigned nloc = b.st[0], nx = b.st[1];
        if (nloc == 0u) { xcd_barrier_complete(bar, b.x, nloc, nx); b.st[0] = nloc; b.st[1] = nx; }
        const unsigned old = xb_add(&bar[XB_XSUB(b.x)], 1u);
        const unsigned gen = old / nloc;
        if (old + 1u == (gen + 1u) * nloc) {
            __builtin_amdgcn_fence(__ATOMIC_RELEASE, "agent");
            asm volatile("s_waitcnt vmcnt(0)" ::: "memory");
            const unsigned og = xb_add(&bar[XB_TOP], 1u);
            const unsigned tg = og / nx;
            if (og + 1u == (tg + 1u) * nx) xb_add(&bar[XB_TOPGEN], 1u);
            else XB_SPIN(xb_ld(&bar[XB_TOPGEN]) == tg, bar);
            __builtin_amdgcn_fence(__ATOMIC_ACQUIRE, "agent");
            xb_add(&bar[XB_XGEN(b.x)], 1u);
            asm volatile("s_waitcnt vmcnt(0)" ::: "memory");
        } else {
            XB_SPIN(xb_ld(&bar[XB_XGEN(b.x)]) == gen, bar);
            __builtin_amdgcn_fence(__ATOMIC_ACQUIRE, "agent");
            asm volatile("s_waitcnt vmcnt(0)" ::: "memory");
        }
    }
    __syncthreads();
}

struct Args { const float* in[N_IN]; float* out; unsigned char* ws; int ph_lo, ph_hi; };
static_assert(sizeof(Args) == (N_IN + 2) * 8 + 8, "Args has no padding");
struct Frame {
    LAS unsigned char* lds;
    int tid, lane, wave, G, bid;
};
#define WSP(T, off) ((T*)(a.ws + (off)))

__device__ const unsigned char T5_BUCKET[128] = {0, 1, 2, 3, 4, 5, 6, 7, 8, 9, 10, 11, 12, 13, 14, 15, 16, 16, 16, 17, 17, 18, 18, 18, 19, 19, 19, 20, 20, 20, 20, 21, 21, 21, 21, 22, 22, 22, 22, 22, 23, 23, 23, 23, 23, 23, 24, 24, 24, 24, 24, 24, 25, 25, 25, 25, 25, 25, 25, 26, 26, 26, 26, 26, 26, 26, 26, 27, 27, 27, 27, 27, 27, 27, 27, 27, 27, 28, 28, 28, 28, 28, 28, 28, 28, 28, 28, 29, 29, 29, 29, 29, 29, 29, 29, 29, 29, 29, 29, 30, 30, 30, 30, 30, 30, 30, 30, 30, 30, 30, 30, 30, 30, 31, 31, 31, 31, 31, 31, 31, 31, 31, 31, 31, 31, 31, 31, 31};
__host__ __device__ __forceinline__ int vt_perm(int r) { return (r & 32) + 8 * ((r >> 2) & 3) + 4 * ((r >> 4) & 1) + (r & 3); }
__host__ __device__ __forceinline__ int vt_iperm(int p) { return (p & 32) + 16 * ((p >> 2) & 1) + 4 * ((p >> 3) & 3) + (p & 3); }
constexpr int CW_KMAX = 1024;
constexpr size_t WS_VT2 = 200 * MiB;
constexpr size_t WS_VCT = 208 * MiB;
static_assert(WS_VCT + 2 * 16 * 64 * 64 * 2 <= WS_END, "ws map (attention prep)");
template <int MODE> __device__ __forceinline__ int wt_row0(int n0) {
    if (MODE == 1) { const int isu = n0 >= DFF ? 1 : 0, c = n0 - isu * DFF; return 256 * (c >> 7) + 128 * isu + (c & 127); }
    if (MODE == 2) { if (n0 < 512) return 256 * (n0 >> 7) + (n0 & 127); if (n0 < 1024) { const int c = n0 - 512; return 256 * (c >> 7) + 128 + (c & 127); } return n0; }
    return n0;
}
template <int MODE> __device__ __forceinline__ void p0_transpose_item(const float* W, int K, int N, bf16* WT, LAS float* scr, int item, int lane) {
    const int nblk = (N + 31) / 32, kb = item / nblk, nb = item % nblk, k0 = 64 * kb, n0 = 32 * nb;
    const int nn = n0 + (lane & 31); const bool okn = nn < N;
#pragma unroll 8
    for (int i = 0; i < 32; ++i) { const int kk = 2 * i + (lane >> 5); scr[kk * 33 + (lane & 31)] = okn ? W[(size_t)(k0 + kk) * N + nn] : 0.f; }
    asm volatile("s_waitcnt lgkmcnt(0)" ::: "memory");
    const int c = lane & 7, r0 = wt_row0<MODE>(n0);
#pragma unroll
    for (int j = 0; j < 4; ++j) { const int n = (lane >> 3) + 8 * j; const LAS float* s = scr + (8 * c) * 33 + n;
        v4u o; o.x = pk2(s[0 * 33], s[1 * 33]); o.y = pk2(s[2 * 33], s[3 * 33]); o.z = pk2(s[4 * 33], s[5 * 33]); o.w = pk2(s[6 * 33], s[7 * 33]);
        *(v4u*)(WT + (size_t)(r0 + n) * K + k0 + 8 * c) = o; }
    asm volatile("s_waitcnt lgkmcnt(0)" ::: "memory");
}
__device__ __forceinline__ void p0_prologue(const Args& a, const Frame& F) {
    LAS float* scr = (LAS float*)(F.lds + RING_OFF + F.wave * 16384);
    const int gw = F.bid * NWAVES + F.wave, NGW = F.G * NWAVES;
    constexpr int I_GU = (DM / 64) * (2 * DFF / 32), I_D = (DFF / 64) * (DM / 32), I_IN = (DM / 64) * ((DIN + 31) / 32), I_O = (DM / 64) * (DM / 32);
    constexpr int I_MOD = 144 * 16, I_PAD = (DIN_PAD - 2336) * DM / 8 / 64;
    constexpr int NITEMS = 2 * I_GU + 2 * I_D + I_IN + I_O + I_MOD + I_PAD;
    for (int it = gw; it < NITEMS; it += NGW) {
        int r = it;
        if (r < I_MOD) {
            const int cg = r >> 4, kc = r & 15; const float* W = a.in[I_WADA] + (size_t)(kc * 64) * 9216 + cg * 64 + F.lane; const float* cv = a.in[I_C] + kc * 64;
            float s = 0.f;
#pragma unroll 16
            for (int k = 0; k < 64; ++k) s += silu_f(cv[k]) * W[(size_t)k * 9216];
            WSP(float, WS_MODP)[kc * 9216 + cg * 64 + F.lane] = s; continue; }
        r -= I_MOD;
        if (r < I_GU) { p0_transpose_item<1>(a.in[I_WGU1], DM, 2 * DFF, WSP(bf16, WS_WGU1), scr, r, F.lane); continue; } r -= I_GU;
        if (r < I_GU) { p0_transpose_item<1>(a.in[I_WGU2], DM, 2 * DFF, WSP(bf16, WS_WGU2), scr, r, F.lane); continue; } r -= I_GU;
        if (r < I_D) { p0_transpose_item<0>(a.in[I_WD1], DFF, DM, WSP(bf16, WS_WD1), scr, r, F.lane); continue; } r -= I_D;
        if (r < I_D) { p0_transpose_item<0>(a.in[I_WD2], DFF, DM, WSP(bf16, WS_WD2), scr, r, F.lane); continue; } r -= I_D;
        if (r < I_IN) { p0_transpose_item<2>(a.in[I_WIN], DM, DIN, WSP(bf16, WS_WIN), scr, r, F.lane); continue; } r -= I_IN;
        if (r < I_O) { p0_transpose_item<0>(a.in[I_WOUT], DM, DM, WSP(bf16, WS_WOUT), scr, r, F.lane); continue; } r -= I_O;
        { v4u* p = (v4u*)(WSP(bf16, WS_WIN) + (size_t)2336 * DM) + (size_t)r * 64 + F.lane; *p = (v4u){0u, 0u, 0u, 0u}; }
    }
}
template <bool FROM_PARTIALS> __device__ __forceinline__ void norm_mod_pass(const Args& a, const Frame& F, const float* src, bf16* dst, const float* gvec, int sub) {
    LAS float* CA = (LAS float*)(F.lds + RING_OFF); LAS float* CB = CA + DM;
    const float* modp = WSP(const float, WS_MODP); float* mod = WSP(float, WS_MOD); const float* bada = a.in[I_BADA];
    if (FROM_PARTIALS) {
        for (int i = F.bid * 512 + F.tid; i < 9216; i += F.G * 512) { float s = bada[i];
#pragma unroll
            for (int k = 0; k < 16; ++k) s += modp[k * 9216 + i];
            mod[i] = s; }
    }
    for (int c = F.tid; c < 2 * DM; c += 512) {
        const int i = 3 * sub * DM + c; float s;
        if (FROM_PARTIALS) { s = bada[i];
#pragma unroll
            for (int k = 0; k < 16; ++k) s += modp[k * 9216 + i]; }
        else s = mod[i];
        if (c < DM) CB[c] = s; else CA[c - DM] = gvec[c - DM] * (1.0f + s);
    }
    __syncthreads();
    const int gw = F.bid * NWAVES + F.wave, NGW = F.G * NWAVES;
    for (int m = gw; m < SEQ; m += NGW) {
        const f32x4* xr = (const f32x4*)(src + (size_t)m * DM) + F.lane;
        f32x4 v[4]; float s = 0.f;
#pragma unroll
        for (int j = 0; j < 4; ++j) { v[j] = xr[64 * j]; s += (v[j].x * v[j].x + v[j].y * v[j].y) + (v[j].z * v[j].z + v[j].w * v[j].w); }
        const float rstd = 1.0f / sqrtf(wave_sum(s) * (1.0f / DM) + EPS);
        unsigned long long* o8 = (unsigned long long*)(dst + (size_t)m * DM) + F.lane;
#pragma unroll
        for (int j = 0; j < 4; ++j) { const f32x4 ca = *(const LAS f32x4*)(CA + 256 * j + 4 * F.lane), cb = *(const LAS f32x4*)(CB + 256 * j + 4 * F.lane);
            const f32x4 h = v[j] * rstd * ca + cb;
            o8[64 * j] = (unsigned long long)pk2(h.x, h.y) | ((unsigned long long)pk2(h.z, h.w) << 32); }
    }
    __syncthreads();
}
__device__ __forceinline__ void final_norm_pass(const Args& a, const Frame& F) {
    const int gw = F.bid * NWAVES + F.wave, NGW = F.G * NWAVES; const float* g = a.in[I_GFIN];
    f32x4 gv[4];
#pragma unroll
    for (int j = 0; j < 4; ++j) gv[j] = *((const f32x4*)g + 64 * j + F.lane);
    for (int m = gw; m < SEQ; m += NGW) {
        f32x4* xr = (f32x4*)(a.out + (size_t)m * DM) + F.lane;
        f32x4 v[4]; float s = 0.f;
#pragma unroll
        for (int j = 0; j < 4; ++j) { v[j] = xr[64 * j]; s += (v[j].x * v[j].x + v[j].y * v[j].y) + (v[j].z * v[j].z + v[j].w * v[j].w); }
        const float rstd = 1.0f / sqrtf(wave_sum(s) * (1.0f / DM) + EPS);
#pragma unroll
        for (int j = 0; j < 4; ++j) xr[64 * j] = v[j] * rstd * gv[j];
    }
}
__device__ __forceinline__ void conv_phase(const Args& a, const Frame& F) {
    LAS float* WL = (LAS float*)(F.lds + RING_OFF);
    for (int i = F.tid; i < CONVW * DCONV; i += 512) WL[i] = a.in[I_WDW][i];
    __syncthreads();
    const bf16* HG = WSP(const bf16, WS_HG); bf16* Y = WSP(bf16, WS_HB);
    const int gw = F.bid * NWAVES + F.wave, NGW = F.G * NWAVES, c0 = 8 * F.lane;
    float bd[8], lg[8], lb[8];
#pragma unroll
    for (int e = 0; e < 8; ++e) { bd[e] = a.in[I_BDW][c0 + e]; lg[e] = a.in[I_LNG][c0 + e]; lb[e] = a.in[I_LNB][c0 + e]; }
    for (int t = gw; t < SEQ; t += NGW) {
        float acc[8];
#pragma unroll
        for (int e = 0; e < 8; ++e) acc[e] = bd[e];
        for (int k = 0; k < CONVW; ++k) { const int tt = t - (CONVW - 1) + k; if (tt < 0) continue;
            const v4u h = *(const v4u*)(HG + (size_t)tt * DCONV + c0); const LAS float* w = WL + k * DCONV + c0;
            const f32x4 w0 = *(const LAS f32x4*)w, w1 = *(const LAS f32x4*)(w + 4);
            acc[0] += bflo(h.x) * w0.x; acc[1] += bfhi(h.x) * w0.y; acc[2] += bflo(h.y) * w0.z; acc[3] += bfhi(h.y) * w0.w;
            acc[4] += bflo(h.z) * w1.x; acc[5] += bfhi(h.z) * w1.y; acc[6] += bflo(h.w) * w1.z; acc[7] += bfhi(h.w) * w1.w; }
        float s = 0.f;
#pragma unroll
        for (int e = 0; e < 8; ++e) s += acc[e];
        const float mu = wave_sum(s) * (1.0f / DCONV); float q = 0.f;
#pragma unroll
        for (int e = 0; e < 8; ++e) { acc[e] -= mu; q += acc[e] * acc[e]; }
        const float rstd = 1.0f / sqrtf(wave_sum(q) * (1.0f / DCONV) + EPS);
        float o[8];
#pragma unroll
        for (int e = 0; e < 8; ++e) o[e] = silu_f(acc[e] * rstd * lg[e] + lb[e]);
        v4u w; w.x = pk2(o[0], o[1]); w.y = pk2(o[2], o[3]); w.z = pk2(o[4], o[5]); w.w = pk2(o[6], o[7]);
        *(v4u*)(Y + (size_t)t * DM + c0) = w;
    }
    __syncthreads();
}
__device__ __forceinline__ void compress_phase(const Args& a, const Frame& F) {
    LAS bf16* SL = (LAS bf16*)(F.lds + RING_OFF);
    LAS float* PH = (LAS float*)(F.lds + RING_OFF + 36864);
    LAS float* HID = (LAS float*)(F.lds + RING_OFF + 36864 + 65536);
    const bf16* KV = WSP(const bf16, WS_KV);
    for (int task = F.bid; task < 256; task += F.G) {
        const int which = task >> 7, g = (task >> 6) & 1, ng = task & 63, n0 = 16 * ng;
        const float* pe = a.in[which ? I_PEV : I_PEK]; const float* w1 = a.in[which ? I_WCV1 : I_WCK1]; const float* w2 = a.in[which ? I_WCV2 : I_WCK2];
        bf16* OUT = WSP(bf16, WS_KCMP);
        const int coff = which * 128 + g * 64;
        for (int i = F.tid; i < 272 * 8; i += 512) { const int tok = 16 * n0 + (i >> 3), ch = i & 7;
            v4u v = (v4u){0u, 0u, 0u, 0u}; if (tok < SEQ) v = *(const v4u*)(KV + (size_t)tok * 768 + coff + ch * 8);
            *(LAS v4u*)(SL + (i >> 3) * 64 + ch * 8) = v; }
        __syncthreads();
        float acc[16][2];
#pragma unroll
        for (int r = 0; r < 16; ++r) { acc[r][0] = 0.f; acc[r][1] = 0.f; }
        for (int li = 0; li < 4; ++li) { const int l = 4 * F.wave + li;
            for (int d = 0; d < 64; ++d) {
                const float wa = w1[(size_t)(l * 64 + d) * CMP_HID + F.lane], wb = w1[(size_t)(l * 64 + d) * CMP_HID + 64 + F.lane], pv = pe[l * 64 + d];
#pragma unroll
                for (int r = 0; r < 16; ++r) { const float x = bf2f(SL[(16 * r + l) * 64 + d]) + pv; acc[r][0] += x * wa; acc[r][1] += x * wb; }
            } }
#pragma unroll
        for (int r = 0; r < 16; ++r) { PH[(F.wave * 16 + r) * 128 + F.lane] = acc[r][0]; PH[(F.wave * 16 + r) * 128 + 64 + F.lane] = acc[r][1]; }
        __syncthreads();
        for (int i = F.tid; i < 16 * 128; i += 512) { float s = 0.f;
#pragma unroll
            for (int w = 0; w < 8; ++w) s += PH[w * 2048 + i];
            HID[i] = silu_f(s); }
        __syncthreads();
        for (int i = F.tid; i < 16 * 64; i += 512) { const int r = i >> 6, e = i & 63; float s = 0.f;
            for (int j = 0; j < CMP_HID; ++j) s += HID[r * 128 + j] * w2[j * 64 + e];
            const int n = n0 + r; const unsigned ob = n < NCMP ? f2bf(s) : 0u;
            if (which == 0) { OUT[(size_t)n * 128 + g * 64 + e] = (bf16)ob; const float v = __uint_as_float(ob << 16), nn = wave_sum(v * v);
                if (F.lane == 0) atomicMax(WSP(unsigned, WS_CTL) + CW_KMAX + g, __float_as_uint(nn)); }
            else WSP(bf16, WS_VCT)[(size_t)((g * 16 + (n >> 6)) * 64 + e) * 64 + vt_perm(n & 63)] = (bf16)ob; }
        __syncthreads();
    }
}
__device__ __forceinline__ void kv_prep_phase(const Args& a, const Frame& F) {
    const bf16* KV = WSP(const bf16, WS_KV); bf16* VT = WSP(bf16, WS_VT2);
    LAS bf16* T = (LAS bf16*)(F.lds + RING_OFF + F.wave * 8704);
    const int gw = F.bid * NWAVES + F.wave, NGW = F.G * NWAVES, lane = F.lane;
    for (int task = gw; task < 2 * 2 * 256; task += NGW) {
        const int tv = task >> 9, g = (task >> 8) & 1, j = task & 255, voff = (tv ? 640 : 384) + g * 64;
#pragma unroll
        for (int it = 0; it < 8; ++it) { const int r = it * 8 + (lane >> 3), c = lane & 7;
            const v4u v = *(const v4u*)(KV + (size_t)(64 * j + r) * 768 + voff + 8 * c);
            LAS unsigned* d = (LAS unsigned*)(T + r * 68 + 8 * c); d[0] = v.x; d[1] = v.y; d[2] = v.z; d[3] = v.w; }
        asm volatile("s_waitcnt lgkmcnt(0)" ::: "memory");
        bf16* O = VT + (size_t)((tv * 2 + g) * 256 + j) * 4096;
#pragma unroll
        for (int it = 0; it < 8; ++it) { const int d = it * 8 + (lane >> 3), c = lane & 7; unsigned w[4];
#pragma unroll
            for (int e = 0; e < 4; ++e) { const int r0 = vt_iperm(8 * c + 2 * e), r1 = vt_iperm(8 * c + 2 * e + 1); w[e] = (unsigned)T[r0 * 68 + d] | ((unsigned)T[r1 * 68 + d] << 16); }
            *(v4u*)(O + d * 64 + 8 * c) = (v4u){w[0], w[1], w[2], w[3]}; }
        asm volatile("s_waitcnt lgkmcnt(0)" ::: "memory");
    }
    unsigned* kmx = WSP(unsigned, WS_CTL) + CW_KMAX;
    for (int task = gw; task < 4 * (SEQ / 64); task += NGW) {
        const int wh = task & 3, tb = task >> 2, tok = tb * 64 + lane;
        const v4u* p = (const v4u*)(KV + (size_t)tok * 768 + (wh >> 1 ? 512 : 256) + (wh & 1) * 64); float s = 0.f;
#pragma unroll
        for (int c = 0; c < 8; ++c) { const v4u w = p[c]; s += bflo(w.x) * bflo(w.x) + bfhi(w.x) * bfhi(w.x) + bflo(w.y) * bflo(w.y) + bfhi(w.y) * bfhi(w.y) + bflo(w.z) * bflo(w.z) + bfhi(w.z) * bfhi(w.z) + bflo(w.w) * bflo(w.w) + bfhi(w.w) * bfhi(w.w); }
        s = wave_max(s);
        if (lane == 0) atomicMax(kmx + 2 + wh, __float_as_uint(s));
    }
    __syncthreads();
}
constexpr float LOG2E = 1.4426950408889634f;
constexpr int OST_QS = 272, OST_HS = 65;
constexpr int A2_OST = 0;
constexpr int A2_L = 69632;
constexpr int A2_LC = A2_L + 1024;
constexpr int A2_MB = A2_LC + 1024;
constexpr int A2_SELB = A2_MB + 3072;
constexpr int A2_BL = A2_SELB + 2048;
constexpr int A2_TOT = A2_BL + 2048;
constexpr int A2_END = A2_TOT + 65536;
static_assert(A2_END <= MISC_OFF, "attention LDS map");
typedef __attribute__((address_space(3))) float lds_f32;
__device__ __forceinline__ void lds_fadd(lds_f32* p, float v) { (void)__hip_atomic_fetch_add(p, v, __ATOMIC_RELAXED, __HIP_MEMORY_SCOPE_WORKGROUP); }
#define DPP_F(v, ctrl) __builtin_bit_cast(float, __builtin_amdgcn_update_dpp(0, __builtin_bit_cast(int, (v)), (ctrl), 0xf, 0xf, false))
#define DPP_I(v, ctrl) __builtin_amdgcn_update_dpp(0, (v), (ctrl), 0xf, 0xf, false)

template <int BR> __device__ __forceinline__ void attn_block(LAS unsigned char* L, int lane, const bf16* Kp, int kpitch, const bf16* VTp, const bf16* Qg, unsigned long long qmask, int t0, int kb, bool far_) {
    const int col = lane & 15, q4 = lane >> 4, qi = col >> 2, hh = col & 3;
    lds_f32* OST = (lds_f32*)(L + A2_OST); lds_f32* LS = (lds_f32*)(L + A2_L); const lds_f32* LC = (const lds_f32*)(L + A2_LC);
    const lds_f32* MB = (const lds_f32*)(L + A2_MB) + (BR < 2 ? 0 : BR == 2 ? 256 : 512); const lds_f32* BL = (const lds_f32*)(L + A2_BL) + hh * 128;
    bf16x8 kf[4][2], vf[4][2];
#pragma unroll
    for (int kt = 0; kt < 4; ++kt)
#pragma unroll
        for (int ks = 0; ks < 2; ++ks) kf[kt][ks] = *(const bf16x8*)(Kp + (size_t)(16 * kt + col) * kpitch + 32 * ks + 8 * q4);
    if (BR != 1) {
#pragma unroll
        for (int dt = 0; dt < 4; ++dt)
#pragma unroll
            for (int ks = 0; ks < 2; ++ks) vf[dt][ks] = *(const bf16x8*)(VTp + (16 * dt + col) * 64 + 32 * ks + 8 * q4);
    }
    const float bfar = BL[127];
    while (qmask) {
        int qs[4];
#pragma unroll
        for (int i = 0; i < 4; ++i) { if (qmask) { qs[i] = (int)__builtin_ctzll(qmask); qmask &= qmask - 1ull; } else qs[i] = -1; }
        const int myq = qi == 0 ? qs[0] : qi == 1 ? qs[1] : qi == 2 ? qs[2] : qs[3];
        const bool qv = myq >= 0; const int mq = qv ? myq : 0;
        const bf16* qp = Qg + (size_t)mq * 512 + hh * 64 + 8 * q4;
        const bf16x8 qf0 = *(const bf16x8*)qp, qf1 = *(const bf16x8*)(qp + 32);
        f32x4 st[4];
#pragma unroll
        for (int kt = 0; kt < 4; ++kt) { f32x4 z = (f32x4){0.f, 0.f, 0.f, 0.f};
            z = __builtin_amdgcn_mfma_f32_16x16x32_bf16(kf[kt][0], qf0, z, 0, 0, 0); st[kt] = __builtin_amdgcn_mfma_f32_16x16x32_bf16(kf[kt][1], qf1, z, 0, 0, 0); }
        const int t = t0 + mq; const float Mb = MB[mq * 4 + hh];
        float lsum = 0.f;
        if (far_) { const float c = bfar - Mb;
#pragma unroll
            for (int kt = 0; kt < 4; ++kt)
#pragma unroll
                for (int e = 0; e < 4; ++e) { const float p = qv ? __builtin_amdgcn_exp2f(st[kt][e] + c) : 0.f; st[kt][e] = p; lsum += p; }
        } else {
#pragma unroll
            for (int kt = 0; kt < 4; ++kt)
#pragma unroll
                for (int e = 0; e < 4; ++e) { const int k = kb + 16 * kt + 4 * q4 + e; const int dist = BR < 2 ? t - 16 * k - 31 : t - k;
                    const bool ok = qv && dist >= 0 && (BR != 3 || dist < WIN);
                    const int dc = dist < 0 ? 0 : (dist > 127 ? 127 : dist);
                    const float p = ok ? __builtin_amdgcn_exp2f(st[kt][e] + BL[dc] - Mb) : 0.f; st[kt][e] = p; lsum += p; }
        }
        if (BR == 1) {
            const float il = LC[mq * 4 + hh];
#pragma unroll
            for (int kt = 0; kt < 4; ++kt) { float s3 = st[kt][3] * il, s4 = (st[kt][0] + st[kt][1] + st[kt][2]) * il + s3;
                s4 += DPP_F(s4, 0xB1); s4 += DPP_F(s4, 0x4E); s3 += DPP_F(s3, 0xB1); s3 += DPP_F(s3, 0x4E);
                const int aa = (kb >> 2) + 4 * kt + q4;
                if (qv && hh == 0) { lds_fadd(OST + mq * 256 + aa, s4); if (aa + 1 < 256) lds_fadd(OST + mq * 256 + aa + 1, s3); } }
        } else {
            lsum += __shfl_xor(lsum, 16); lsum += __shfl_xor(lsum, 32);
            if (qv && q4 == 0) lds_fadd(LS + mq * 4 + hh, lsum);
            bf16x8 pb[2];
#pragma unroll
            for (int ks = 0; ks < 2; ++ks) { v4u w; w.x = pg8::cvt_pk_bf16(st[2 * ks][0], st[2 * ks][1]); w.y = pg8::cvt_pk_bf16(st[2 * ks][2], st[2 * ks][3]);
                w.z = pg8::cvt_pk_bf16(st[2 * ks + 1][0], st[2 * ks + 1][1]); w.w = pg8::cvt_pk_bf16(st[2 * ks + 1][2], st[2 * ks + 1][3]); pb[ks] = __builtin_bit_cast(bf16x8, w); }
            lds_f32* orow = OST + mq * OST_QS + hh * OST_HS + 4 * q4;
#pragma unroll
            for (int dt = 0; dt < 4; ++dt) { f32x4 z = (f32x4){0.f, 0.f, 0.f, 0.f};
                z = __builtin_amdgcn_mfma_f32_16x16x32_bf16(vf[dt][0], pb[0], z, 0, 0, 0); z = __builtin_amdgcn_mfma_f32_16x16x32_bf16(vf[dt][1], pb[1], z, 0, 0, 0);
                if (qv) { lds_fadd(orow + 16 * dt + 0, z[0]); lds_fadd(orow + 16 * dt + 1, z[1]); lds_fadd(orow + 16 * dt + 2, z[2]); lds_fadd(orow + 16 * dt + 3, z[3]); } }
        }
    }
}
__device__ __forceinline__ void attn_topk(LAS unsigned char* L, int wave, int lane, int cur) {
    const lds_f32* IMP = (const lds_f32*)(L + A2_OST); LAS unsigned* SELB = (LAS unsigned*)(L + A2_SELB);
    const int sub = lane & 15;
    for (int pass = 0; pass < 2; ++pass) {
        const int q = wave * 8 + pass * 4 + (lane >> 4);
        unsigned word = 0u;
        if (cur < 16) { if (sub == 0) word = (cur >= 31) ? 0xffffffffu : ((1u << (cur + 1)) - 1u); }
        else {
            float v[16];
#pragma unroll
            for (int i = 0; i < 16; ++i) { const int J = 16 * i + sub; v[i] = (J >= 1 && J <= cur - 2) ? IMP[q * 256 + J] : -1.0f; }
            for (int r = 0; r < 13; ++r) {
                float m = v[0];
#pragma unroll
                for (int i = 1; i < 16; ++i) m = fmaxf(m, v[i]);
                m = fmaxf(m, DPP_F(m, 0x128)); m = fmaxf(m, DPP_F(m, 0x124)); m = fmaxf(m, DPP_F(m, 0x122)); m = fmaxf(m, DPP_F(m, 0x121));
                int c = 999;
#pragma unroll
                for (int i = 15; i >= 0; --i) c = (v[i] == m) ? 16 * i + sub : c;
                { int o = DPP_I(c, 0x128); c = o < c ? o : c; o = DPP_I(c, 0x124); c = o < c ? o : c; o = DPP_I(c, 0x122); c = o < c ? o : c; o = DPP_I(c, 0x121); c = o < c ? o : c; }
#pragma unroll
                for (int i = 0; i < 16; ++i) v[i] = (16 * i + sub == c) ? -2.0f : v[i];
                if ((c >> 5) == sub) word |= 1u << (c & 31);
            }
            if (sub == 0) word |= 1u;
            if (((cur - 1) >> 5) == sub) word |= 1u << ((cur - 1) & 31);
            if ((cur >> 5) == sub) word |= 1u << (cur & 31);
        }
        if (sub < 8) SELB[q * 8 + sub] = word;
    }
}
template <int MODE> __device__ __forceinline__ void attn_fold(LAS unsigned char* L, int tid, const float* gt, bf16* yp) {
    const lds_f32* OST = (const lds_f32*)(L + A2_OST); lds_f32* LS = (lds_f32*)(L + A2_L); lds_f32* LC = (lds_f32*)(L + A2_LC); lds_f32* TOT = (lds_f32*)(L + A2_TOT) + tid * 32;
    const int q = tid >> 3, h = (tid & 7) >> 1, d0 = (tid & 1) * 32;
    const float l = LS[q * 4 + h], il = 1.0f / fmaxf(l, 1e-30f), sc = *gt * il;
    const lds_f32* o = OST + q * OST_QS + h * OST_HS + d0;
    if (MODE == 0) {
#pragma unroll
        for (int i = 0; i < 32; ++i) TOT[i] = sc * o[i];
        if ((tid & 1) == 0) LC[q * 4 + h] = il;
    } else if (MODE == 1) {
#pragma unroll
        for (int i = 0; i < 32; ++i) TOT[i] += sc * o[i];
    } else {
#pragma unroll
        for (int c = 0; c < 4; ++c) { float v[8];
#pragma unroll
            for (int e = 0; e < 8; ++e) v[e] = TOT[8 * c + e] + sc * o[8 * c + e];
            v4u w; w.x = pk2(v[0], v[1]); w.y = pk2(v[2], v[3]); w.z = pk2(v[4], v[5]); w.w = pk2(v[6], v[7]); *(v4u*)(yp + 8 * c) = w; }
    }
}
__device__ __forceinline__ void attn_zero_state(LAS unsigned char* L, int tid) {
    LAS f32x4* z = (LAS f32x4*)(L + A2_OST);
    for (int i = tid; i < (A2_L + 1024) / 16; i += 512) z[i] = (f32x4){0.f, 0.f, 0.f, 0.f};
}
__device__ __forceinline__ void attn2_phase(const Args& a, const Frame& F) {
    LAS unsigned char* L = F.lds + RING_OFF;
    const bf16* Q = WSP(const bf16, WS_Q); const bf16* KV = WSP(const bf16, WS_KV); const bf16* KC = WSP(const bf16, WS_KCMP);
    const bf16* VT = WSP(const bf16, WS_VT2); const bf16* VCT = WSP(const bf16, WS_VCT); const float* GT = WSP(const float, WS_GT); bf16* Y = WSP(bf16, WS_HB);
    const unsigned* kmx = WSP(const unsigned, WS_CTL) + CW_KMAX;
    const int tid = F.tid, lane = F.lane, wave = F.wave;
    for (int ui = 0; ui < 2; ++ui) {
        const int u = ui == 0 ? F.bid : 2 * NSLC - 1 - F.bid;
        if (F.G != 256 && ui == 1) break;
        for (int uu = u; uu < 2 * NSLC; uu += (F.G == 256 ? 2 * NSLC : F.G)) {
        const int cur = uu >> 1, g = uu & 1, t0 = 64 * cur;
        const bf16* Qg = Q + (size_t)t0 * 512 + g * 256;
        lds_f32* BL = (lds_f32*)(L + A2_BL); lds_f32* MB = (lds_f32*)(L + A2_MB);
        if (tid < 512) { const int h = tid >> 7, d = tid & 127; BL[tid] = LOG2E * a.in[I_RELB][(g * 4 + h) * 32 + T5_BUCKET[d]]; }
        attn_zero_state(L, tid);
        __syncthreads();
        {   const int q = tid >> 3, h = (tid & 7) >> 1, d0 = (tid & 1) * 32; const v4u* qp = (const v4u*)(Qg + (size_t)q * 512 + h * 64 + d0); float s = 0.f;
#pragma unroll
            for (int c = 0; c < 4; ++c) { const v4u w = qp[c]; s += bflo(w.x) * bflo(w.x) + bfhi(w.x) * bfhi(w.x) + bflo(w.y) * bflo(w.y) + bfhi(w.y) * bfhi(w.y) + bflo(w.z) * bflo(w.z) + bfhi(w.z) * bfhi(w.z) + bflo(w.w) * bflo(w.w) + bfhi(w.w) * bfhi(w.w); }
            s += __shfl_xor(s, 1); const float qn = sqrtf(s);
            float bm = -3.0e38f;
            for (int d = 0; d < 128; ++d) bm = fmaxf(bm, BL[h * 128 + d]);
            if ((tid & 1) == 0) {
#pragma unroll
                for (int b = 0; b < 3; ++b) MB[b * 256 + q * 4 + h] = qn * sqrtf(__uint_as_float(kmx[2 * b + g])) * 1.001f + bm + 0.5f; }
        }
        const float* gtp = GT + (size_t)(t0 + (tid >> 3)) * 24 + (g * 4 + ((tid & 7) >> 1)) * 3;
        __syncthreads();
        const int tmax = t0 + 63, nvalmax = tmax >= 31 ? ((tmax - 31) >> 4) + 1 : 0, nbc = (nvalmax + 63) >> 6;
        for (int idx = wave; idx < 4 * nbc; idx += NWAVES) { const int qq = idx / nbc, jc = idx - qq * nbc;
            const int tq = t0 + 16 * qq; if (tq + 15 - 16 * (64 * jc) - 31 < 0) continue;
            attn_block<0>(L, lane, KC + (size_t)(64 * jc) * 128 + g * 64, 128, VCT + (size_t)(g * 16 + jc) * 4096, Qg, 0xFFFFull << (16 * qq), t0, 64 * jc, tq - 16 * (64 * jc + 63) - 31 >= 113); }
        __syncthreads();
        attn_fold<0>(L, tid, gtp + 0, nullptr);
        __syncthreads();
        attn_zero_state(L, tid);
        __syncthreads();
        if (cur >= 16) {
            for (int idx = wave; idx < 4 * nbc; idx += NWAVES) { const int qq = idx / nbc, jc = idx - qq * nbc;
                const int tq = t0 + 16 * qq; if (tq + 15 - 16 * (64 * jc) - 31 < 0) continue;
                attn_block<1>(L, lane, KC + (size_t)(64 * jc) * 128 + g * 64, 128, nullptr, Qg, 0xFFFFull << (16 * qq), t0, 64 * jc, tq - 16 * (64 * jc + 63) - 31 >= 113); }
            __syncthreads();
        }
        attn_topk(L, wave, lane, cur);
        __syncthreads();
        attn_zero_state(L, tid);
        __syncthreads();
        {   const LAS unsigned* SELB = (const LAS unsigned*)(L + A2_SELB); const int nb = cur + 1;
            for (int idx = wave; idx < 4 * nb; idx += NWAVES) { const int qq = idx / nb, j = idx - qq * nb;
                const unsigned long long m = __ballot((SELB[lane * 8 + (j >> 5)] >> (j & 31)) & 1u);
                const int pc = __builtin_popcountll(m); unsigned long long qm;
                if (pc > 16) qm = m & (0xFFFFull << (16 * qq)); else if (qq == 0) qm = m; else continue;
                if (qm == 0ull) continue;
                attn_block<2>(L, lane, KV + (size_t)(64 * j) * 768 + 256 + g * 64, 768, VT + (size_t)((0 * 2 + g) * 256 + j) * 4096, Qg, qm, t0, 64 * j, t0 - (64 * j + 63) >= 113); }
        }
        __syncthreads();
        attn_fold<1>(L, tid, gtp + 1, nullptr);
        __syncthreads();
        attn_zero_state(L, tid);
        __syncthreads();
        {   const int j0 = cur >= 8 ? cur - 8 : 0, nb = cur - j0 + 1;
            for (int idx = wave; idx < 4 * nb; idx += NWAVES) { const int qq = idx / nb, j = j0 + idx - qq * nb;
                const int tlo = t0 + 16 * qq, thi = tlo + 15; if (64 * j > thi || 64 * j + 63 <= tlo - WIN) continue;
                attn_block<3>(L, lane, KV + (size_t)(64 * j) * 768 + 512 + g * 64, 768, VT + (size_t)((1 * 2 + g) * 256 + j) * 4096, Qg, 0xFFFFull << (16 * qq), t0, 64 * j, (tlo - (64 * j + 63) >= 113) && (thi - 64 * j < WIN)); }
        }
        __syncthreads();
        attn_fold<2>(L, tid, gtp + 2, Y + (size_t)(t0 + (tid >> 3)) * DM + 512 + (g * 4 + ((tid & 7) >> 1)) * 64 + (tid & 1) * 32);
        __syncthreads();
        }
    }
}
__global__ void __launch_bounds__(NWAVES * 64, 2) fwd_kernel(Args a) {
    extern __shared__ __attribute__((aligned(16))) unsigned char lds[];
    Frame F;
    F.lds = (LAS unsigned char*)lds;
    F.tid = threadIdx.x; F.lane = F.tid & 63; F.wave = __builtin_amdgcn_readfirstlane(F.tid >> 6);
    F.G = gridDim.x; F.bid = blockIdx.x;
    volatile LAS unsigned* MISC = (volatile LAS unsigned*)(F.lds + MISC_OFF);
    for (int u = F.tid; u < (LDS_BYTES - LDSCTL_OFF) / 4; u += NWAVES * 64) ((LAS unsigned*)(F.lds + LDSCTL_OFF))[u] = 0u;
    __syncthreads();
    const int lo = a.ph_lo, hi = a.ph_hi;
    const bool multi = (hi - lo) > 1;
    unsigned* barw = WSP(unsigned, WS_CTL) + CW_BAR;
    XcdBarrier bar; bar.bar = barw; bar.x = 0; bar.st = MISC + 8;
    if (multi) bar = xcd_barrier_post(barw, MISC + 8);
#define IN(k) (lo <= (k) && (k) < hi)
#define SEAM(k) do { if (IN(k) && IN((k) + 1)) xcd_barrier(bar); } while (0)
    PG8_LAS unsigned char* ring = F.lds + RING_OFF;

    if (IN(0)) { p0_prologue(a, F); } SEAM(0);
    if (IN(1)) { norm_mod_pass<true>(a, F, a.in[I_X], WSP(bf16, WS_HB), a.in[I_GFFN1], 0); } SEAM(1);
    if (IN(2)) {
        pg8::Gemm g{WSP(const bf16, WS_HB), WSP(const bf16, WS_WGU1), SEQ, 2 * DFF, DM}; pg8::StaticOrder S; S.init(SEQ, 2 * DFF, F.G, F.bid);
        pg8::EpiSwiGLU E{WSP(bf16, WS_ACT), DFF};
        pg8::gemm_phase<pg8::EpiSwiGLU, pg8::StaticOrder, PG8_ALIGN, PG8_SP2>(ring, g, S, E);
    } SEAM(2);
    if (IN(3)) {
        pg8::Gemm g{WSP(const bf16, WS_ACT), WSP(const bf16, WS_WD1), SEQ, DM, DFF}; pg8::StaticOrder S; S.init(SEQ, DM, F.G, F.bid);
        pg8::EpiResid E{a.in[I_X], WSP(float, WS_XB), DM, WSP(const float, WS_MOD) + 2 * DM, 0.5f};
        pg8::gemm_phase<pg8::EpiResid, pg8::StaticOrder, false, PG8_SP2>(ring, g, S, E);
    } SEAM(3);
    if (IN(4)) { norm_mod_pass<false>(a, F, WSP(const float, WS_XB), WSP(bf16, WS_HB), a.in[I_GMIX], 1); } SEAM(4);
    if (IN(5)) {
        pg8::Gemm g{WSP(const bf16, WS_HB), WSP(const bf16, WS_WIN), SEQ, DIN_PAD, DM}; pg8::StaticOrder S; S.init(SEQ, DIN_PAD, F.G, F.bid);
        pg8::EpiMix E{WSP(bf16, WS_HG), WSP(bf16, WS_Q), WSP(bf16, WS_KV), WSP(float, WS_GT)};
        pg8::gemm_phase<pg8::EpiMix, pg8::StaticOrder, PG8_ALIGN, PG8_SP2>(ring, g, S, E);
    } SEAM(5);
    if (IN(6)) { conv_phase(a, F); kv_prep_phase(a, F); compress_phase(a, F); } SEAM(6);
    if (IN(7)) { attn2_phase(a, F); } SEAM(7);
    if (IN(8)) {
        pg8::Gemm g{WSP(const bf16, WS_HB), WSP(const bf16, WS_WOUT), SEQ, DM, DM}; pg8::StaticOrder S; S.init(SEQ, DM, F.G, F.bid);
        pg8::EpiResid E{WSP(const float, WS_XB), WSP(float, WS_XB), DM, WSP(const float, WS_MOD) + 5 * DM, 1.0f};
        pg8::gemm_phase<pg8::EpiResid, pg8::StaticOrder, false, PG8_SP2>(ring, g, S, E);
    } SEAM(8);
    if (IN(9)) { norm_mod_pass<false>(a, F, WSP(const float, WS_XB), WSP(bf16, WS_HB), a.in[I_GFFN2], 2); } SEAM(9);
    if (IN(10)) {
        pg8::Gemm g{WSP(const bf16, WS_HB), WSP(const bf16, WS_WGU2), SEQ, 2 * DFF, DM}; pg8::StaticOrder S; S.init(SEQ, 2 * DFF, F.G, F.bid);
        pg8::EpiSwiGLU E{WSP(bf16, WS_ACT), DFF};
        pg8::gemm_phase<pg8::EpiSwiGLU, pg8::StaticOrder, PG8_ALIGN, PG8_SP2>(ring, g, S, E);
    } SEAM(10);
    if (IN(11)) {
        pg8::Gemm g{WSP(const bf16, WS_ACT), WSP(const bf16, WS_WD2), SEQ, DM, DFF}; pg8::StaticOrder S; S.init(SEQ, DM, F.G, F.bid);
        pg8::EpiResid E{WSP(const float, WS_XB), a.out, DM, WSP(const float, WS_MOD) + 8 * DM, 0.5f};
        pg8::gemm_phase<pg8::EpiResid, pg8::StaticOrder, false, PG8_SP2>(ring, g, S, E);
    } SEAM(11);
    if (IN(12)) { final_norm_pass(a, F); }
#undef IN
#undef SEAM
}

extern "C" void kernel_launch(void* const* d_in, const int* in_sizes, int n_in, void* d_out, int out_size, void* d_ws, size_t ws_size, hipStream_t stream) {
    static int grid = 0;
    if (grid == 0) {
        if (n_in != N_IN || in_sizes[0] != SEQ * DM || out_size != SEQ * DM || ws_size < WS_END) { fprintf(stderr, "kernel_launch: unexpected problem shape (n_in %d, ws %zu); nothing launched\n", n_in, ws_size); grid = -1; return; }
        int dev = 0, cus = 0, per_cu = 0;
        if (hipGetDevice(&dev) != hipSuccess || hipDeviceGetAttribute(&cus, hipDeviceAttributeMultiprocessorCount, dev) != hipSuccess) { grid = -1; return; }
        if (hipFuncSetAttribute((const void*)fwd_kernel, hipFuncAttributeMaxDynamicSharedMemorySize, LDS_BYTES) != hipSuccess) { fprintf(stderr, "kernel_launch: hipFuncSetAttribute failed\n"); grid = -1; return; }
        if (hipOccupancyMaxActiveBlocksPerMultiprocessor(&per_cu, (const void*)fwd_kernel, NWAVES * 64, LDS_BYTES) != hipSuccess || per_cu < 1)
            fprintf(stderr, "kernel_launch: note: occupancy query reports %d workgroups per CU\n", per_cu);
        (void)hipGetLastError();
        grid = cus;
    }
    if (grid < 0) return;
    if (hipMemsetAsync((char*)d_ws + WS_CTL, 0, CTL_ZERO_BYTES, stream) != hipSuccess) return;
    Args a{};
    for (int i = 0; i < N_IN; ++i) a.in[i] = (const float*)d_in[i];
    a.out = (float*)d_out; a.ws = (unsigned char*)d_ws;
#if MK_LAUNCHES == 1
    a.ph_lo = 0; a.ph_hi = N_PHASES;
    hipLaunchKernelGGL(fwd_kernel, dim3(grid), dim3(NWAVES * 64), LDS_BYTES, stream, a);
#else
    for (int p = 0; p < N_PHASES; ++p) { a.ph_lo = p; a.ph_hi = p + 1; hipLaunchKernelGGL(fwd_kernel, dim3(grid), dim3(NWAVES * 64), LDS_BYTES, stream, a); }
#endif
}
```

```cpp
#include <hip/hip_runtime.h>
#include <cstdio>
#include <cstdint>
namespace pg8 {
#define PG8_LAS __attribute__((address_space(3)))
typedef unsigned short bf16_t;
typedef short bf16x8 __attribute__((ext_vector_type(8)));
typedef float f32x4 __attribute__((ext_vector_type(4)));
typedef unsigned u32x4 __attribute__((ext_vector_type(4)));
constexpr int BM = 256, BK = 64, HALF = 128, HTB = HALF * BK * 2  , STAGE_BYTES = 8 * HTB, NXCD = 8, WGM = 8;

__host__ __device__ __forceinline__ int lds_byte(int r, int c) { const int st = (r >> 4) * 2 + (c >> 5), rr = r & 15, cc = c & 31, ob = rr * 64 + cc * 2; return st * 1024 + (ob ^ (((ob >> 9) & 1) << 5)); }
__host__ __device__ __forceinline__ void stage_rc(int b, int& R, int& C) { const int st = b / 1024, sb = b % 1024, swz = sb ^ (((sb >> 9) & 1) << 5); R = (st >> 1) * 16 + swz / 64; C = (st & 1) * 32 + (swz % 64) / 2; }
__host__ __device__ __forceinline__ int perm32(int rho) { const int n = rho >> 4, i = rho & 15; return 8 * (i >> 2) + 4 * n + (i & 3); }

struct Unit { int pm, pn; };
struct Gemm { const bf16_t* A; const bf16_t* Bt; int M, N, K; };

struct StaticOrder {
    int nM, nN, nwg, G, c;
    __host__ __device__ void init(int M, int N, int G_, int c_) { nM = M / BM; nN = N / BM; nwg = nM * nN; G = G_; c = c_; }
    __host__ __device__ bool next(int i, Unit& u) const {
        const long L = (long)i * G + c; if (L >= nwg) return false;
        int wgid = (int)L; { const int q = nwg / NXCD, r = nwg % NXCD, xcd = wgid % NXCD, off = wgid / NXCD; wgid = (xcd < r ? xcd * (q + 1) : r * (q + 1) + (xcd - r) * q) + off; }
        const int nig = WGM * nN, gid = wgid / nig, fm = gid * WGM, gsz = (nM - fm) < WGM ? (nM - fm) : WGM;
        u.pm = fm + ((wgid % nig) % gsz); u.pn = (wgid % nig) / gsz; return true;
    }
    __device__ __forceinline__ void a_ready(const Unit&) const {}
    __device__ __forceinline__ void done(const Unit&) const {}
};


__device__ __forceinline__ unsigned cvt_pk_bf16(float lo, float hi) { unsigned r; asm volatile("v_cvt_pk_bf16_f32 %0, %1, %2" : "=v"(r) : "v"(lo), "v"(hi)); return r; }
__device__ __forceinline__ float sigmoid_f(float x) { return __builtin_amdgcn_rcpf(1.0f + __builtin_amdgcn_exp2f(-1.4426950408889634f * x)); }
__device__ __forceinline__ float silu_f(float x) { return x * sigmoid_f(x); }

template <bool GLU> __device__ __forceinline__ void gated_store(const f32x4 (&acc)[2][2][4][2], bf16_t* O, int ldc, int row0, int col0) {
#pragma unroll
    for (int ai = 0; ai < 2; ++ai)
#pragma unroll
        for (int m = 0; m < 4; ++m) { bf16_t* rowp = O + (size_t)(row0 + ai * HALF + m * 16) * ldc + col0;
            float v[8];
#pragma unroll
            for (int n = 0; n < 2; ++n)
#pragma unroll
                for (int e = 0; e < 4; ++e) { const float a = acc[ai][0][m][n][e], b = acc[ai][1][m][n][e]; v[n * 4 + e] = GLU ? a * sigmoid_f(b) : silu_f(a) * b; }
            u32x4 w; w.x = cvt_pk_bf16(v[0], v[1]); w.y = cvt_pk_bf16(v[2], v[3]); w.z = cvt_pk_bf16(v[4], v[5]); w.w = cvt_pk_bf16(v[6], v[7]);
            *(u32x4*)rowp = w; }
}
struct EpiSwiGLU {
    static constexpr bool PERM = true, AFTER_DRAIN = false;
    bf16_t* O; int ldc;
    __device__ __forceinline__ void operator()(const f32x4 (&acc)[2][2][4][2], const Unit& u, int wr, int wc, int fr, int fq) const {
        gated_store<false>(acc, O, ldc, u.pm * BM + wr * 64 + fr, u.pn * HALF + wc * 32 + 8 * fq);
    }
};
struct EpiResid {
    static constexpr bool PERM = false, AFTER_DRAIN = false;
    const float* base; float* out; int ldc; const float* gate; float scale;
    __device__ __forceinline__ void operator()(const f32x4 (&acc)[2][2][4][2], const Unit& u, int wr, int wc, int fr, int fq) const {
        const int col0 = u.pn * BM + wc * 32 + 4 * fq, row0 = u.pm * BM + wr * 64 + fr;
        f32x4 cf[2][2];
#pragma unroll
        for (int bj = 0; bj < 2; ++bj)
#pragma unroll
            for (int n = 0; n < 2; ++n) cf[bj][n] = *(const f32x4*)(gate + col0 + bj * HALF + n * 16) * scale;
#pragma unroll
        for (int ai = 0; ai < 2; ++ai)
#pragma unroll
            for (int m = 0; m < 4; ++m) { const size_t off = (size_t)(row0 + ai * HALF + m * 16) * ldc + col0;
#pragma unroll
                for (int bj = 0; bj < 2; ++bj)
#pragma unroll
                    for (int n = 0; n < 2; ++n) { const f32x4 bs = *(const f32x4*)(base + off + bj * HALF + n * 16); *(f32x4*)(out + off + bj * HALF + n * 16) = bs + cf[bj][n] * acc[ai][bj][m][n]; }
                if (m & 1) asm volatile("" ::: "memory"); }
    }
};
struct EpiMix {
    static constexpr bool PERM = true, AFTER_DRAIN = false;
    bf16_t* HG; bf16_t* Q; bf16_t* KV; float* GT;
    __device__ __forceinline__ void operator()(const f32x4 (&acc)[2][2][4][2], const Unit& u, int wr, int wc, int fr, int fq) const {
        const int row0 = u.pm * BM + wr * 64 + fr, c8 = wc * 32 + 8 * fq;
        if (u.pn < 4) { gated_store<true>(acc, HG, 512, row0, u.pn * HALF + c8); return; }
        if (u.pn == 9) {
            if (c8 < 24) {
#pragma unroll
                for (int ai = 0; ai < 2; ++ai)
#pragma unroll
                    for (int m = 0; m < 4; ++m) { float* rowp = GT + (size_t)(row0 + ai * HALF + m * 16) * 24 + c8;
#pragma unroll
                        for (int n = 0; n < 2; ++n) { const f32x4 a = acc[ai][0][m][n]; *(f32x4*)(rowp + 4 * n) = (f32x4){sigmoid_f(a[0]), sigmoid_f(a[1]), sigmoid_f(a[2]), sigmoid_f(a[3])}; } }
            }
            return;
        }
        bf16_t* O; int ldc, colt; float sc;
        if (u.pn < 6) { O = Q; ldc = 512; colt = (u.pn - 4) * BM; sc = 0.125f * 1.4426950408889634f; } else { O = KV; ldc = 768; colt = (u.pn - 6) * BM; sc = 1.0f; }
#pragma unroll
        for (int ai = 0; ai < 2; ++ai)
#pragma unroll
            for (int m = 0; m < 4; ++m) { bf16_t* rowp = O + (size_t)(row0 + ai * HALF + m * 16) * ldc + colt + c8;
#pragma unroll
                for (int bj = 0; bj < 2; ++bj) { const f32x4 v0 = acc[ai][bj][m][0] * sc, v1 = acc[ai][bj][m][1] * sc;
                    u32x4 w; w.x = cvt_pk_bf16(v0[0], v0[1]); w.y = cvt_pk_bf16(v0[2], v0[3]); w.z = cvt_pk_bf16(v1[0], v1[1]); w.w = cvt_pk_bf16(v1[2], v1[3]);
                    *(u32x4*)(rowp + bj * HALF) = w; } }
    }
};

template <class Epi, class Sched, bool ALIGN_EPI = false, bool SP2 = false>
__device__ __forceinline__ void gemm_phase(PG8_LAS unsigned char* lds, const Gemm g, const Sched& S, const Epi& E) {
    const int tid = threadIdx.x, wid = __builtin_amdgcn_readfirstlane(tid >> 6), lane = tid & 63, wr = wid >> 2, wc = wid & 3, fr = lane & 15, fq = lane >> 4;
    const int K = g.K, nt = K / BK;
    unsigned voffA[2], voffB[2];
#pragma unroll
    for (int i = 0; i < 2; ++i) { int R, C; stage_rc(tid * 16 + i * 8192, R, C); const int Rb = Epi::PERM ? ((R & ~31) + perm32(R & 31)) : R;
        voffA[i] = (unsigned)(R * K + C) * 2u; voffB[i] = (unsigned)(Rb * K + C) * 2u; }
    const size_t kstep = (size_t)(BK * 2);
    const size_t hstep = (size_t)HALF * K * 2;
    const size_t tstep = 2 * hstep;
    const unsigned ldsw = (unsigned)wid * 1024u;
    const int aoff = lds_byte(wr * 64 + fr, fq * 8), boff = lds_byte(wc * 32 + fr, fq * 8);
#define PG8_SA(b, h) (((b) * 2 + (h)) * HTB)
#define PG8_SB(b, h) ((4 + (b) * 2 + (h)) * HTB)
#define PG8_STAGE(bufoff, gbase, voff) do { _Pragma("unroll") for (int _i = 0; _i < 2; ++_i) \
        __builtin_amdgcn_global_load_lds((const unsigned*)((const char*)(gbase) + (voff)[_i]), (PG8_LAS unsigned*)(lds + (bufoff) + ldsw + _i * 8192), 16, 0, 0); } while (0)
#define PG8_LDA(dst, b, h) do { _Pragma("unroll") for (int m = 0; m < 4; ++m) _Pragma("unroll") for (int k = 0; k < 2; ++k) dst[m][k] = *(const PG8_LAS bf16x8*)(lds + PG8_SA(b, h) + aoff + m * 2048 + k * 1024); } while (0)
#define PG8_LDB(dst, b, h) do { _Pragma("unroll") for (int n = 0; n < 2; ++n) _Pragma("unroll") for (int k = 0; k < 2; ++k) dst[n][k] = *(const PG8_LAS bf16x8*)(lds + PG8_SB(b, h) + boff + n * 2048 + k * 1024); } while (0)
#define PG8_MMA(ai, bj, At, Bt) do { __builtin_amdgcn_s_setprio(1); _Pragma("unroll") for (int m = 0; m < 4; ++m) _Pragma("unroll") for (int n = 0; n < 2; ++n) _Pragma("unroll") for (int k = 0; k < 2; ++k) \
        acc[ai][bj][m][n] = __builtin_amdgcn_mfma_f32_16x16x32_bf16(Bt[n][k], At[m][k], acc[ai][bj][m][n], 0, 0, 0); __builtin_amdgcn_s_setprio(0); } while (0)
#define PG8_WAIT_V(n) asm volatile("s_waitcnt vmcnt(" #n ")" ::: "memory")
#define PG8_WAIT_L(n) asm volatile("s_waitcnt lgkmcnt(" #n ")" ::: "memory")
#define PG8_BAR __builtin_amdgcn_s_barrier()
#define PG8_SCHED __builtin_amdgcn_sched_barrier(0)
    Unit cur, nxt; int ui = 0;
    if (!S.next(0, cur)) return;
    f32x4 acc[2][2][4][2];
#pragma unroll
    for (int a = 0; a < 2; ++a)
#pragma unroll
        for (int b = 0; b < 2; ++b)
#pragma unroll
            for (int m = 0; m < 4; ++m)
#pragma unroll
                for (int n = 0; n < 2; ++n) acc[a][b][m][n] = (f32x4){0.f, 0.f, 0.f, 0.f};
    bf16x8 At[4][2], B0[2][2], B1[2][2];
    const char* cA = (const char*)g.A + (size_t)cur.pm * tstep; const char* cB = (const char*)g.Bt + (size_t)cur.pn * tstep;
    S.a_ready(cur);
    if constexpr (SP2) {
        PG8_STAGE(PG8_SB(0, 0), cB, voffB); PG8_STAGE(PG8_SB(0, 1), cB + hstep, voffB); PG8_STAGE(PG8_SA(0, 0), cA, voffA); PG8_STAGE(PG8_SA(0, 1), cA + hstep, voffA);
        if (wr == 1) PG8_BAR;
        PG8_WAIT_V(2); PG8_BAR;
        PG8_STAGE(PG8_SB(1, 0), cB + kstep, voffB); PG8_STAGE(PG8_SA(1, 0), cA + kstep, voffA); PG8_STAGE(PG8_SB(1, 1), cB + hstep + kstep, voffB);
        PG8_WAIT_V(6); PG8_BAR;
    } else {
        PG8_STAGE(PG8_SB(0, 0), cB, voffB); PG8_STAGE(PG8_SA(0, 0), cA, voffA); PG8_STAGE(PG8_SB(0, 1), cB + hstep, voffB); PG8_STAGE(PG8_SA(0, 1), cA + hstep, voffA);
        if (wr == 1) PG8_BAR;
        PG8_WAIT_V(4); PG8_BAR;
        PG8_STAGE(PG8_SB(1, 0), cB + kstep, voffB); PG8_STAGE(PG8_SA(1, 0), cA + kstep, voffA); PG8_STAGE(PG8_SB(1, 1), cB + hstep + kstep, voffB);
        PG8_WAIT_V(6); PG8_BAR;
    }
    for (;;) {
        const bool has_next = S.next(ui + 1, nxt);
        const char* nA = has_next ? (const char*)g.A + (size_t)nxt.pm * tstep : cA; const char* nB = has_next ? (const char*)g.Bt + (size_t)nxt.pn * tstep : cB;
        for (int t = 0; t < nt; t += 2) {
            const bool last = (t == nt - 2);
            const char* a1 = cA + (size_t)(t + 1) * kstep;
            const char* a2 = last ? nA : cA + (size_t)(t + 2) * kstep; const char* b2 = last ? nB : cB + (size_t)(t + 2) * kstep;
            const char* a3 = a2 + kstep; const char* b3 = b2 + kstep;
            if (last && has_next) S.a_ready(nxt);
            if constexpr (SP2) {
            PG8_LDB(B0, 0, 0); PG8_LDB(B1, 0, 1); PG8_SCHED; PG8_LDA(At, 0, 0); PG8_STAGE(PG8_SA(1, 1), a1 + hstep, voffA);
            PG8_WAIT_V(8); PG8_WAIT_L(0); PG8_BAR; PG8_MMA(0, 0, At, B0); PG8_MMA(0, 1, At, B1); PG8_BAR; PG8_SCHED;
            PG8_LDA(At, 0, 1); PG8_STAGE(PG8_SB(0, 0), b2, voffB); PG8_STAGE(PG8_SB(0, 1), b2 + hstep, voffB); PG8_STAGE(PG8_SA(0, 0), a2, voffA);
            PG8_WAIT_V(8); PG8_WAIT_L(0); PG8_BAR; PG8_MMA(1, 0, At, B0); PG8_MMA(1, 1, At, B1); PG8_BAR; PG8_SCHED;
            PG8_LDB(B0, 1, 0); PG8_LDB(B1, 1, 1); PG8_SCHED; PG8_LDA(At, 1, 0); PG8_STAGE(PG8_SA(0, 1), a2 + hstep, voffA);
            PG8_WAIT_V(8); PG8_WAIT_L(0); PG8_BAR; PG8_MMA(0, 0, At, B0); PG8_MMA(0, 1, At, B1); PG8_BAR; PG8_SCHED;
            PG8_LDA(At, 1, 1); PG8_STAGE(PG8_SB(1, 0), b3, voffB); PG8_STAGE(PG8_SB(1, 1), b3 + hstep, voffB); PG8_STAGE(PG8_SA(1, 0), a3, voffA);
            PG8_WAIT_V(8); PG8_WAIT_L(0); PG8_BAR; PG8_MMA(1, 0, At, B0); PG8_MMA(1, 1, At, B1); PG8_BAR; PG8_SCHED;
            } else {
            PG8_LDB(B0, 0, 0); PG8_SCHED; PG8_LDA(At, 0, 0); PG8_STAGE(PG8_SA(1, 1), a1 + hstep, voffA);
            PG8_WAIT_L(8); PG8_BAR; PG8_WAIT_L(0); PG8_MMA(0, 0, At, B0); PG8_BAR; PG8_SCHED;
            PG8_LDB(B1, 0, 1); PG8_STAGE(PG8_SB(0, 0), b2, voffB);
            PG8_BAR; PG8_WAIT_L(0); PG8_MMA(0, 1, At, B1); PG8_BAR;
            PG8_LDA(At, 0, 1); PG8_STAGE(PG8_SA(0, 0), a2, voffA);
            PG8_BAR; PG8_WAIT_L(0); PG8_MMA(1, 0, At, B0); PG8_BAR; PG8_SCHED;
            PG8_STAGE(PG8_SB(0, 1), b2 + hstep, voffB);
            PG8_WAIT_V(6); PG8_BAR; PG8_MMA(1, 1, At, B1); PG8_BAR;
            PG8_LDB(B0, 1, 0); PG8_SCHED; PG8_LDA(At, 1, 0); PG8_STAGE(PG8_SA(0, 1), a2 + hstep, voffA);
            PG8_WAIT_L(8); PG8_BAR; PG8_WAIT_L(0); PG8_MMA(0, 0, At, B0); PG8_BAR; PG8_SCHED;
            PG8_LDB(B1, 1, 1); PG8_STAGE(PG8_SB(1, 0), b3, voffB);
            PG8_BAR; PG8_WAIT_L(0); PG8_MMA(0, 1, At, B1); PG8_BAR;
            PG8_LDA(At, 1, 1); PG8_STAGE(PG8_SA(1, 0), a3, voffA);
            PG8_BAR; PG8_WAIT_L(0); PG8_MMA(1, 0, At, B0); PG8_BAR; PG8_SCHED;
            PG8_STAGE(PG8_SB(1, 1), b3 + hstep, voffB);
            PG8_WAIT_V(6); PG8_BAR; PG8_MMA(1, 1, At, B1); PG8_BAR;
            }
        }
        if constexpr (ALIGN_EPI) { if (wr == 0) PG8_BAR; }
        if constexpr (!Epi::AFTER_DRAIN) { E(acc, cur, wr, wc, fr, fq); S.done(cur); }
        if (!has_next) break;
#pragma unroll
        for (int a = 0; a < 2; ++a)
#pragma unroll
            for (int b = 0; b < 2; ++b)
#pragma unroll
                for (int m = 0; m < 4; ++m)
#pragma unroll
                    for (int n = 0; n < 2; ++n) acc[a][b][m][n] = (f32x4){0.f, 0.f, 0.f, 0.f};
        cur = nxt; cA = nA; cB = nB; ++ui;
        if constexpr (ALIGN_EPI) { if (wr == 1) PG8_BAR; }
    }
    PG8_WAIT_V(0);
    if constexpr (!ALIGN_EPI) { if (wr == 0) PG8_BAR; }
    PG8_BAR;
    if constexpr (Epi::AFTER_DRAIN) { E.fused(acc, cur, wr, wc, fr, fq, lds, wid, lane); S.done(cur); }
#undef PG8_SA
#undef PG8_SB
#undef PG8_STAGE
#undef PG8_LDA
#undef PG8_LDB
#undef PG8_MMA
#undef PG8_WAIT_V
#undef PG8_WAIT_L
#undef PG8_BAR
#undef PG8_SCHED
}
}
#ifndef PG8_SP2
#define PG8_SP2 true
#endif
#ifndef PG8_ALIGN
#define PG8_ALIGN true
#endif
#ifndef MK_LAUNCHES
#define MK_LAUNCHES 1
#endif

constexpr int NWAVES = 8;
constexpr int SEQ = 16384, DM = 1024, DFF = 2816, DCONV = 512, DATT = 512, NH = 8, NG = 2, HPG = 4, HD = 64;
constexpr int DIN = 2328, DIN_PAD = 2560, NCMP = 1023, CONVW = 31, CMP_HID = 128, NSLC = 256, NTOP = 16, WIN = 512;
constexpr float EPS = 1e-6f;
constexpr int N_PHASES = 13;
enum { I_X = 0, I_C, I_WADA, I_BADA, I_GFFN1, I_WGU1, I_WD1, I_GMIX, I_WIN, I_WDW, I_BDW, I_LNG, I_LNB, I_PEK, I_PEV, I_WCK1, I_WCK2, I_WCV1, I_WCV2, I_RELB, I_WOUT, I_GFFN2, I_WGU2, I_WD2, I_GFIN, N_IN };

constexpr size_t MiB = 1u << 20;
constexpr size_t WS_CTL = 0, CTL_ZERO_BYTES = 64 * 1024;
constexpr size_t WS_MODP = 1 * MiB;
constexpr size_t WS_MOD = WS_MODP + 16 * 9216 * 4;
constexpr size_t WS_KCMP = 2 * MiB, WS_VCMP = WS_KCMP + 256 * 1024;
constexpr size_t WS_WGU1 = 4 * MiB, WS_WD1 = 15 * MiB, WS_WIN = 21 * MiB, WS_WOUT = 26 * MiB, WS_WGU2 = 28 * MiB, WS_WD2 = 39 * MiB;
constexpr size_t WS_GT = 45 * MiB;
constexpr size_t WS_HB = 48 * MiB;
constexpr size_t WS_XB = 80 * MiB;
constexpr size_t WS_ACT = 144 * MiB;
constexpr size_t WS_HG = WS_ACT, WS_Q = WS_ACT + 16 * MiB, WS_KV = WS_ACT + 32 * MiB;
constexpr size_t WS_END = 232 * MiB;
static_assert(WS_WD2 + (size_t)DM * DFF * 2 <= WS_GT && WS_GT + (size_t)SEQ * 24 * 4 <= WS_HB && WS_KV + (size_t)SEQ * 768 * 2 <= WS_END && WS_ACT + (size_t)SEQ * DFF * 2 <= WS_END, "d_ws map");
constexpr int CW_BAR = 4096;
constexpr int RING_OFF = 0, RING_BYTES = 131072;
constexpr int LDS_BYTES = 163840;
constexpr int LDSCTL_OFF = LDS_BYTES - 1024, MISC_OFF = LDSCTL_OFF + 320;

#define GAS __attribute__((address_space(1)))
#define LAS __attribute__((address_space(3)))
typedef unsigned short bf16;
typedef unsigned v4u __attribute__((ext_vector_type(4)));
typedef unsigned v2u __attribute__((ext_vector_type(2)));
typedef float f32x4 __attribute__((ext_vector_type(4)));
typedef float f32x2 __attribute__((ext_vector_type(2)));
typedef short bf16x8 __attribute__((ext_vector_type(8)));
typedef GAS unsigned gu32;
#define RLX_AGENT __ATOMIC_RELAXED, __HIP_MEMORY_SCOPE_AGENT
__device__ __forceinline__ unsigned f2bf(float f) { unsigned u = __builtin_bit_cast(unsigned, f); return (u + 0x7fffu + ((u >> 16) & 1u)) >> 16; }
__device__ __forceinline__ unsigned pk2(float lo, float hi) { return f2bf(lo) | (f2bf(hi) << 16); }
__device__ __forceinline__ float bflo(unsigned w) { return __uint_as_float(w << 16); }
__device__ __forceinline__ float bfhi(unsigned w) { return __uint_as_float(w & 0xffff0000u); }
__device__ __forceinline__ float bf2f(bf16 b) { return __uint_as_float((unsigned)b << 16); }
__device__ __forceinline__ float sigmoid_f(float x) { return __builtin_amdgcn_rcpf(1.0f + __builtin_amdgcn_exp2f(-1.4426950408889634f * x)); }
__device__ __forceinline__ float silu_f(float x) { return x * sigmoid_f(x); }
__device__ __forceinline__ float wave_sum(float v) {
#pragma unroll
    for (int o = 1; o < 64; o <<= 1) v += __shfl_xor(v, o);
    return v;
}
__device__ __forceinline__ float wave_max(float v) {
#pragma unroll
    for (int o = 1; o < 64; o <<= 1) v = fmaxf(v, __shfl_xor(v, o));
    return v;
}

#define XB_TMO      128
#define XB_XCNT(j)  (256  + 64 * (j))
#define XB_XSUB(j)  (1280 + 64 * (j))
#define XB_XGEN(j)  (2304 + 64 * (j))
#define XB_TOP      3328
#define XB_TOPGEN   3392
#define XCD_BAR_WORDS 3456
#define XB_SPIN_CAP (1u << 18)
static_assert((CW_BAR + XCD_BAR_WORDS) * 4 <= (int)CTL_ZERO_BYTES, "barrier words inside the memset region");

__device__ __forceinline__ unsigned xb_ld(unsigned* p)              { return __hip_atomic_load(p, __ATOMIC_RELAXED, __HIP_MEMORY_SCOPE_AGENT); }
__device__ __forceinline__ unsigned xb_add(unsigned* p, unsigned v) { return __hip_atomic_fetch_add(p, v, __ATOMIC_RELAXED, __HIP_MEMORY_SCOPE_AGENT); }
__device__ __forceinline__ unsigned xb_xcc_id() { return (unsigned)__builtin_amdgcn_s_getreg((3 << 11) | 20) & 0xFu; }
#define XB_SPIN(cond, bar) do { unsigned _sp = 0; while (cond) { __builtin_amdgcn_s_sleep(1); \
    if ((++_sp & 255u) == 0u) { if (xb_ld(&(bar)[XB_TMO])) break; if (_sp > XB_SPIN_CAP) { atomicAdd(&(bar)[XB_TMO], 1u); break; } } } } while (0)

struct XcdBarrier {
    unsigned* bar; unsigned x;
    volatile LAS unsigned* st;
};
__device__ __forceinline__ XcdBarrier xcd_barrier_post(unsigned* bar, volatile LAS unsigned* st) {
    XcdBarrier b; b.bar = bar; b.x = xb_xcc_id(); b.st = st;
    if (threadIdx.x == 0) (void)xb_add(&bar[XB_XCNT(b.x)], 1u);
    return b;
}
__device__ __forceinline__ void xcd_barrier_complete(unsigned* bar, unsigned x, unsigned& nloc, unsigned& nx) {
    const unsigned G = gridDim.x * gridDim.y * gridDim.z;
    unsigned sum, cnt, mine, sp = 0u;
    for (;;) {
        sum = 0u; cnt = 0u; mine = 0u;
#pragma unroll
        for (unsigned j = 0; j < 16; ++j) { const unsigned c = xb_ld(&bar[XB_XCNT(j)]); sum += c; cnt += (c > 0u) ? 1u : 0u; mine = (j == x) ? c : mine; }
        if (sum == G) break;
        __builtin_amdgcn_s_sleep(1);
        if ((++sp & 255u) == 0u) { if (xb_ld(&bar[XB_TMO])) break; if (sp > XB_SPIN_CAP) { atomicAdd(&bar[XB_TMO], 1u); break; } }
    }
    nloc = mine > 0u ? mine : 1u; nx = cnt > 0u ? cnt : 1u;
}
__device__ __forceinline__ void xcd_barrier(const XcdBarrier& b) {
    asm volatile("s_waitcnt vmcnt(0)" ::: "memory");
    __syncthreads();
    if (threadIdx.x == 0) {
        unsigned* bar = b.bar;
        __builtin_amdgcn_s_waitcnt(0);
        unsigned nloc = b.st[0], nx = b.st[1];
        if (nloc == 0u) { xcd_barrier_complete(bar, b.x, nloc, nx); b.st[0] = nloc; b.st[1] = nx; }
        const unsigned old = xb_add(&bar[XB_XSUB(b.x)], 1u);
        const unsigned gen = old / nloc;
        if (old + 1u == (gen + 1u) * nloc) {
            __builtin_amdgcn_fence(__ATOMIC_RELEASE, "agent");
            asm volatile("s_waitcnt vmcnt(0)" ::: "memory");
            const unsigned og = xb_add(&bar[XB_TOP], 1u);
            const unsigned tg = og / nx;
            if (og + 1u == (tg + 1u) * nx) xb_add(&bar[XB_TOPGEN], 1u);
            else XB_SPIN(xb_ld(&bar[XB_TOPGEN]) == tg, bar);
            __builtin_amdgcn_fence(__ATOMIC_ACQUIRE, "agent");
            xb_add(&bar[XB_XGEN(b.x)], 1u);
            asm volatile("s_waitcnt vmcnt(0)" ::: "memory");
        } else {
            XB_SPIN(xb_ld(&bar[XB_XGEN(b.x)]) == gen, bar);
            __builtin_amdgcn_fence(__ATOMIC_ACQUIRE, "agent");
            asm volatile("s_waitcnt vmcnt(0)" ::: "memory");
        }
    }
    __syncthreads();
}

struct Args { const float* in[N_IN]; float* out; unsigned char* ws; int ph_lo, ph_hi, probe, pad; };
static_assert(sizeof(Args) == (N_IN + 2) * 8 + 16, "Args has no padding");
struct Frame {
    LAS unsigned char* lds;
    int tid, lane, wave, G, bid;
};
#define WSP(T, off) ((T*)(a.ws + (off)))

__device__ const unsigned char T5_BUCKET[128] = {0, 1, 2, 3, 4, 5, 6, 7, 8, 9, 10, 11, 12, 13, 14, 15, 16, 16, 16, 17, 17, 18, 18, 18, 19, 19, 19, 20, 20, 20, 20, 21, 21, 21, 21, 22, 22, 22, 22, 22, 23, 23, 23, 23, 23, 23, 24, 24, 24, 24, 24, 24, 25, 25, 25, 25, 25, 25, 25, 26, 26, 26, 26, 26, 26, 26, 26, 27, 27, 27, 27, 27, 27, 27, 27, 27, 27, 28, 28, 28, 28, 28, 28, 28, 28, 28, 28, 29, 29, 29, 29, 29, 29, 29, 29, 29, 29, 29, 29, 30, 30, 30, 30, 30, 30, 30, 30, 30, 30, 30, 30, 30, 30, 31, 31, 31, 31, 31, 31, 31, 31, 31, 31, 31, 31, 31, 31, 31};
__host__ __device__ __forceinline__ int vt_perm(int r) { return (r & 32) + 8 * ((r >> 2) & 3) + 4 * ((r >> 4) & 1) + (r & 3); }
__host__ __device__ __forceinline__ int vt_iperm(int p) { return (p & 32) + 16 * ((p >> 2) & 1) + 4 * ((p >> 3) & 3) + (p & 3); }
constexpr int CW_KMAX = 1024;
constexpr size_t WS_VT2 = 200 * MiB;
constexpr size_t WS_VCT = 208 * MiB;
static_assert(WS_VCT + 2 * 16 * 64 * 64 * 2 <= WS_END, "ws map (attention prep)");
template <int MODE> __device__ __forceinline__ int wt_row0(int n0) {
    if (MODE == 1) { const int isu = n0 >= DFF ? 1 : 0, c = n0 - isu * DFF; return 256 * (c >> 7) + 128 * isu + (c & 127); }
    if (MODE == 2) { if (n0 < 512) return 256 * (n0 >> 7) + (n0 & 127); if (n0 < 1024) { const int c = n0 - 512; return 256 * (c >> 7) + 128 + (c & 127); } return n0; }
    return n0;
}
template <int MODE> __device__ __forceinline__ void p0_transpose_item(const float* W, int K, int N, bf16* WT, LAS float* scr, int item, int lane) {
    const int nblk = (N + 31) / 32, kb = item / nblk, nb = item % nblk, k0 = 64 * kb, n0 = 32 * nb;
    const int nn = n0 + (lane & 31); const bool okn = nn < N;
#pragma unroll 8
    for (int i = 0; i < 32; ++i) { const int kk = 2 * i + (lane >> 5); scr[kk * 33 + (lane & 31)] = okn ? W[(size_t)(k0 + kk) * N + nn] : 0.f; }
    asm volatile("s_waitcnt lgkmcnt(0)" ::: "memory");
    const int c = lane & 7, r0 = wt_row0<MODE>(n0);
#pragma unroll
    for (int j = 0; j < 4; ++j) { const int n = (lane >> 3) + 8 * j; const LAS float* s = scr + (8 * c) * 33 + n;
        v4u o; o.x = pk2(s[0 * 33], s[1 * 33]); o.y = pk2(s[2 * 33], s[3 * 33]); o.z = pk2(s[4 * 33], s[5 * 33]); o.w = pk2(s[6 * 33], s[7 * 33]);
        *(v4u*)(WT + (size_t)(r0 + n) * K + k0 + 8 * c) = o; }
    asm volatile("s_waitcnt lgkmcnt(0)" ::: "memory");
}
__device__ __forceinline__ void p0_prologue(const Args& a, const Frame& F) {
    LAS float* scr = (LAS float*)(F.lds + RING_OFF + F.wave * 16384);
    const int gw = F.bid * NWAVES + F.wave, NGW = F.G * NWAVES;
    constexpr int I_GU = (DM / 64) * (2 * DFF / 32), I_D = (DFF / 64) * (DM / 32), I_IN = (DM / 64) * ((DIN + 31) / 32), I_O = (DM / 64) * (DM / 32);
    constexpr int I_MOD = 144 * 16, I_PAD = (DIN_PAD - 2336) * DM / 8 / 64;
    constexpr int NITEMS = 2 * I_GU + 2 * I_D + I_IN + I_O + I_MOD + I_PAD;
    for (int it = gw; it < NITEMS; it += NGW) {
        int r = it;
        if (r < I_MOD) {
            const int cg = r >> 4, kc = r & 15; const float* W = a.in[I_WADA] + (size_t)(kc * 64) * 9216 + cg * 64 + F.lane; const float* cv = a.in[I_C] + kc * 64;
            float s = 0.f;
#pragma unroll 16
            for (int k = 0; k < 64; ++k) s += silu_f(cv[k]) * W[(size_t)k * 9216];
            WSP(float, WS_MODP)[kc * 9216 + cg * 64 + F.lane] = s; continue; }
        r -= I_MOD;
        if (r < I_GU) { p0_transpose_item<1>(a.in[I_WGU1], DM, 2 * DFF, WSP(bf16, WS_WGU1), scr, r, F.lane); continue; } r -= I_GU;
        if (r < I_GU) { p0_transpose_item<1>(a.in[I_WGU2], DM, 2 * DFF, WSP(bf16, WS_WGU2), scr, r, F.lane); continue; } r -= I_GU;
        if (r < I_D) { p0_transpose_item<0>(a.in[I_WD1], DFF, DM, WSP(bf16, WS_WD1), scr, r, F.lane); continue; } r -= I_D;
        if (r < I_D) { p0_transpose_item<0>(a.in[I_WD2], DFF, DM, WSP(bf16, WS_WD2), scr, r, F.lane); continue; } r -= I_D;
        if (r < I_IN) { p0_transpose_item<2>(a.in[I_WIN], DM, DIN, WSP(bf16, WS_WIN), scr, r, F.lane); continue; } r -= I_IN;
        if (r < I_O) { p0_transpose_item<0>(a.in[I_WOUT], DM, DM, WSP(bf16, WS_WOUT), scr, r, F.lane); continue; } r -= I_O;
        { v4u* p = (v4u*)(WSP(bf16, WS_WIN) + (size_t)2336 * DM) + (size_t)r * 64 + F.lane; *p = (v4u){0u, 0u, 0u, 0u}; }
    }
}
template <bool FROM_PARTIALS> __device__ __forceinline__ void norm_mod_pass(const Args& a, const Frame& F, const float* src, bf16* dst, const float* gvec, int sub) {
    LAS float* CA = (LAS float*)(F.lds + RING_OFF); LAS float* CB = CA + DM;
    const float* modp = WSP(const float, WS_MODP); float* mod = WSP(float, WS_MOD); const float* bada = a.in[I_BADA];
    if (FROM_PARTIALS) {
        for (int i = F.bid * 512 + F.tid; i < 9216; i += F.G * 512) { float s = bada[i];
#pragma unroll
            for (int k = 0; k < 16; ++k) s += modp[k * 9216 + i];
            mod[i] = s; }
    }
    for (int c = F.tid; c < 2 * DM; c += 512) {
        const int i = 3 * sub * DM + c; float s;
        if (FROM_PARTIALS) { s = bada[i];
#pragma unroll
            for (int k = 0; k < 16; ++k) s += modp[k * 9216 + i]; }
        else s = mod[i];
        if (c < DM) CB[c] = s; else CA[c - DM] = gvec[c - DM] * (1.0f + s);
    }
    __syncthreads();
    const int gw = F.bid * NWAVES + F.wave, NGW = F.G * NWAVES;
    for (int m = gw; m < SEQ; m += NGW) {
        const f32x4* xr = (const f32x4*)(src + (size_t)m * DM) + F.lane;
        f32x4 v[4]; float s = 0.f;
#pragma unroll
        for (int j = 0; j < 4; ++j) { v[j] = xr[64 * j]; s += (v[j].x * v[j].x + v[j].y * v[j].y) + (v[j].z * v[j].z + v[j].w * v[j].w); }
        const float rstd = 1.0f / sqrtf(wave_sum(s) * (1.0f / DM) + EPS);
        unsigned long long* o8 = (unsigned long long*)(dst + (size_t)m * DM) + F.lane;
#pragma unroll
        for (int j = 0; j < 4; ++j) { const f32x4 ca = *(const LAS f32x4*)(CA + 256 * j + 4 * F.lane), cb = *(const LAS f32x4*)(CB + 256 * j + 4 * F.lane);
            const f32x4 h = v[j] * rstd * ca + cb;
            o8[64 * j] = (unsigned long long)pk2(h.x, h.y) | ((unsigned long long)pk2(h.z, h.w) << 32); }
    }
    __syncthreads();
}
__device__ __forceinline__ void final_norm_pass(const Args& a, const Frame& F) {
    const int gw = F.bid * NWAVES + F.wave, NGW = F.G * NWAVES; const float* g = a.in[I_GFIN];
    f32x4 gv[4];
#pragma unroll
    for (int j = 0; j < 4; ++j) gv[j] = *((const f32x4*)g + 64 * j + F.lane);
    for (int m = gw; m < SEQ; m += NGW) {
        f32x4* xr = (f32x4*)(a.out + (size_t)m * DM) + F.lane;
        f32x4 v[4]; float s = 0.f;
#pragma unroll
        for (int j = 0; j < 4; ++j) { v[j] = xr[64 * j]; s += (v[j].x * v[j].x + v[j].y * v[j].y) + (v[j].z * v[j].z + v[j].w * v[j].w); }
        const float rstd = 1.0f / sqrtf(wave_sum(s) * (1.0f / DM) + EPS);
#pragma unroll
        for (int j = 0; j < 4; ++j) xr[64 * j] = v[j] * rstd * gv[j];
    }
}
__device__ __forceinline__ void conv_phase(const Args& a, const Frame& F) {
    LAS float* WL = (LAS float*)(F.lds + RING_OFF);
    for (int i = F.tid; i < CONVW * DCONV; i += 512) WL[i] = a.in[I_WDW][i];
    __syncthreads();
    const bf16* HG = WSP(const bf16, WS_HG); bf16* Y = WSP(bf16, WS_HB);
    const int gw = F.bid * NWAVES + F.wave, NGW = F.G * NWAVES, c0 = 8 * F.lane;
    float bd[8], lg[8], lb[8];
#pragma unroll
    for (int e = 0; e < 8; ++e) { bd[e] = a.in[I_BDW][c0 + e]; lg[e] = a.in[I_LNG][c0 + e]; lb[e] = a.in[I_LNB][c0 + e]; }
    for (int t = gw; t < SEQ; t += NGW) {
        float acc[8];
#pragma unroll
        for (int e = 0; e < 8; ++e) acc[e] = bd[e];
        for (int k = 0; k < CONVW; ++k) { const int tt = t - (CONVW - 1) + k; if (tt < 0) continue;
            const v4u h = *(const v4u*)(HG + (size_t)tt * DCONV + c0); const LAS float* w = WL + k * DCONV + c0;
            const f32x4 w0 = *(const LAS f32x4*)w, w1 = *(const LAS f32x4*)(w + 4);
            acc[0] += bflo(h.x) * w0.x; acc[1] += bfhi(h.x) * w0.y; acc[2] += bflo(h.y) * w0.z; acc[3] += bfhi(h.y) * w0.w;
            acc[4] += bflo(h.z) * w1.x; acc[5] += bfhi(h.z) * w1.y; acc[6] += bflo(h.w) * w1.z; acc[7] += bfhi(h.w) * w1.w; }
        float s = 0.f;
#pragma unroll
        for (int e = 0; e < 8; ++e) s += acc[e];
        const float mu = wave_sum(s) * (1.0f / DCONV); float q = 0.f;
#pragma unroll
        for (int e = 0; e < 8; ++e) { acc[e] -= mu; q += acc[e] * acc[e]; }
        const float rstd = 1.0f / sqrtf(wave_sum(q) * (1.0f / DCONV) + EPS);
        float o[8];
#pragma unroll
        for (int e = 0; e < 8; ++e) o[e] = silu_f(acc[e] * rstd * lg[e] + lb[e]);
        v4u w; w.x = pk2(o[0], o[1]); w.y = pk2(o[2], o[3]); w.z = pk2(o[4], o[5]); w.w = pk2(o[6], o[7]);
        *(v4u*)(Y + (size_t)t * DM + c0) = w;
    }
    __syncthreads();
}
__device__ __forceinline__ void compress_phase(const Args& a, const Frame& F) {
    LAS bf16* SL = (LAS bf16*)(F.lds + RING_OFF);
    LAS float* PH = (LAS float*)(F.lds + RING_OFF + 36864);
    LAS float* HID = (LAS float*)(F.lds + RING_OFF + 36864 + 65536);
    const bf16* KV = WSP(const bf16, WS_KV);
    for (int task = F.bid; task < 256; task += F.G) {
        const int which = task >> 7, g = (task >> 6) & 1, ng = task & 63, n0 = 16 * ng;
        const float* pe = a.in[which ? I_PEV : I_PEK]; const float* w1 = a.in[which ? I_WCV1 : I_WCK1]; const float* w2 = a.in[which ? I_WCV2 : I_WCK2];
        bf16* OUT = WSP(bf16, WS_KCMP);
        const int coff = which * 128 + g * 64;
        for (int i = F.tid; i < 272 * 8; i += 512) { const int tok = 16 * n0 + (i >> 3), ch = i & 7;
            v4u v = (v4u){0u, 0u, 0u, 0u}; if (tok < SEQ) v = *(const v4u*)(KV + (size_t)tok * 768 + coff + ch * 8);
            *(LAS v4u*)(SL + (i >> 3) * 64 + ch * 8) = v; }
        __syncthreads();
        float acc[16][2];
#pragma unroll
        for (int r = 0; r < 16; ++r) { acc[r][0] = 0.f; acc[r][1] = 0.f; }
        for (int li = 0; li < 4; ++li) { const int l = 4 * F.wave + li;
            for (int d = 0; d < 64; ++d) {
                const float wa = w1[(size_t)(l * 64 + d) * CMP_HID + F.lane], wb = w1[(size_t)(l * 64 + d) * CMP_HID + 64 + F.lane], pv = pe[l * 64 + d];
#pragma unroll
                for (int r = 0; r < 16; ++r) { const float x = bf2f(SL[(16 * r + l) * 64 + d]) + pv; acc[r][0] += x * wa; acc[r][1] += x * wb; }
            } }
#pragma unroll
        for (int r = 0; r < 16; ++r) { PH[(F.wave * 16 + r) * 128 + F.lane] = acc[r][0]; PH[(F.wave * 16 + r) * 128 + 64 + F.lane] = acc[r][1]; }
        __syncthreads();
        for (int i = F.tid; i < 16 * 128; i += 512) { float s = 0.f;
#pragma unroll
            for (int w = 0; w < 8; ++w) s += PH[w * 2048 + i];
            HID[i] = silu_f(s); }
        __syncthreads();
        for (int i = F.tid; i < 16 * 64; i += 512) { const int r = i >> 6, e = i & 63; float s = 0.f;
            for (int j = 0; j < CMP_HID; ++j) s += HID[r * 128 + j] * w2[j * 64 + e];
            const int n = n0 + r; const unsigned ob = n < NCMP ? f2bf(s) : 0u;
            if (which == 0) { OUT[(size_t)n * 128 + g * 64 + e] = (bf16)ob; const float v = __uint_as_float(ob << 16), nn = wave_sum(v * v);
                if (F.lane == 0) atomicMax(WSP(unsigned, WS_CTL) + CW_KMAX + g, __float_as_uint(nn)); }
            else WSP(bf16, WS_VCT)[(size_t)((g * 16 + (n >> 6)) * 64 + e) * 64 + vt_perm(n & 63)] = (bf16)ob; }
        __syncthreads();
    }
}
__device__ __forceinline__ void kv_prep_phase(const Args& a, const Frame& F) {
    const bf16* KV = WSP(const bf16, WS_KV); bf16* VT = WSP(bf16, WS_VT2);
    LAS bf16* T = (LAS bf16*)(F.lds + RING_OFF + F.wave * 8704);
    const int gw = F.bid * NWAVES + F.wave, NGW = F.G * NWAVES, lane = F.lane;
    for (int task = gw; task < 2 * 2 * 256; task += NGW) {
        const int tv = task >> 9, g = (task >> 8) & 1, j = task & 255, voff = (tv ? 640 : 384) + g * 64;
#pragma unroll
        for (int it = 0; it < 8; ++it) { const int r = it * 8 + (lane >> 3), c = lane & 7;
            const v4u v = *(const v4u*)(KV + (size_t)(64 * j + r) * 768 + voff + 8 * c);
            LAS unsigned* d = (LAS unsigned*)(T + r * 68 + 8 * c); d[0] = v.x; d[1] = v.y; d[2] = v.z; d[3] = v.w; }
        asm volatile("s_waitcnt lgkmcnt(0)" ::: "memory");
        bf16* O = VT + (size_t)((tv * 2 + g) * 256 + j) * 4096;
#pragma unroll
        for (int it = 0; it < 8; ++it) { const int d = it * 8 + (lane >> 3), c = lane & 7; unsigned w[4];
#pragma unroll
            for (int e = 0; e < 4; ++e) { const int r0 = vt_iperm(8 * c + 2 * e), r1 = vt_iperm(8 * c + 2 * e + 1); w[e] = (unsigned)T[r0 * 68 + d] | ((unsigned)T[r1 * 68 + d] << 16); }
            *(v4u*)(O + d * 64 + 8 * c) = (v4u){w[0], w[1], w[2], w[3]}; }
        asm volatile("s_waitcnt lgkmcnt(0)" ::: "memory");
    }
    unsigned* kmx = WSP(unsigned, WS_CTL) + CW_KMAX;
    for (int task = gw; task < 4 * (SEQ / 64); task += NGW) {
        const int wh = task & 3, tb = task >> 2, tok = tb * 64 + lane;
        const v4u* p = (const v4u*)(KV + (size_t)tok * 768 + (wh >> 1 ? 512 : 256) + (wh & 1) * 64); float s = 0.f;
#pragma unroll
        for (int c = 0; c < 8; ++c) { const v4u w = p[c]; s += bflo(w.x) * bflo(w.x) + bfhi(w.x) * bfhi(w.x) + bflo(w.y) * bflo(w.y) + bfhi(w.y) * bfhi(w.y) + bflo(w.z) * bflo(w.z) + bfhi(w.z) * bfhi(w.z) + bflo(w.w) * bflo(w.w) + bfhi(w.w) * bfhi(w.w); }
        s = wave_max(s);
        if (lane == 0) atomicMax(kmx + 2 + wh, __float_as_uint(s));
    }
    __syncthreads();
}
constexpr float LOG2E = 1.4426950408889634f;
constexpr int A2_IMP = 0;
constexpr int A2_MB = 65536;
constexpr int A2_SELB = A2_MB + 3072;
constexpr int A2_BL = A2_SELB + 2048;
constexpr int A2_STG = A2_BL + 2048;
constexpr int STG_PITCH = 144, STG_V = 9216, STG_BUF = 18432;
constexpr int A2_END = A2_STG + 2 * STG_BUF;
static_assert(A2_END <= MISC_OFF, "attention LDS map");
constexpr size_t WS_TOT = 212 * MiB;
static_assert(WS_TOT + (size_t)256 * 65536 <= WS_END && WS_VCT + 2 * 16 * 64 * 64 * 2 <= WS_TOT, "ws map (attention)");
typedef __attribute__((address_space(3))) float lds_f32;
#define DPP_F(v, ctrl) __builtin_bit_cast(float, __builtin_amdgcn_update_dpp(0, __builtin_bit_cast(int, (v)), (ctrl), 0xf, 0xf, false))
#define DPP_I(v, ctrl) __builtin_amdgcn_update_dpp(0, (v), (ctrl), 0xf, 0xf, false)

struct AttnFrag { bf16x8 k[4][2], v[4][2]; };
struct AttnStage { v4u rk, rv; };
template <bool WITH_V> __device__ __forceinline__ void stage_issue(AttnStage& s, const bf16* Kblk, int kp, const bf16* VTblk, int tid) {
    s.rk = *(const v4u*)(Kblk + (size_t)(tid >> 3) * kp + (tid & 7) * 8);
    if (WITH_V) s.rv = *(const v4u*)(VTblk + (tid >> 3) * 64 + (tid & 7) * 8);
}
template <bool WITH_V> __device__ __forceinline__ void stage_commit(LAS unsigned char* buf, const AttnStage& s, int tid) {
    *(LAS v4u*)(buf + (tid >> 3) * STG_PITCH + (tid & 7) * 16) = s.rk;
    if (WITH_V) *(LAS v4u*)(buf + STG_V + (tid >> 3) * STG_PITCH + (tid & 7) * 16) = s.rv;
}
template <bool WITH_V> __device__ __forceinline__ void frag_from_lds(AttnFrag& f, const LAS unsigned char* buf, int col, int q4) {
#pragma unroll
    for (int kt = 0; kt < 4; ++kt)
#pragma unroll
        for (int ks = 0; ks < 2; ++ks) f.k[kt][ks] = *(const LAS bf16x8*)(buf + (16 * kt + col) * STG_PITCH + (32 * ks + 8 * q4) * 2);
    if (WITH_V) {
#pragma unroll
        for (int dt = 0; dt < 4; ++dt)
#pragma unroll
            for (int ks = 0; ks < 2; ++ks) f.v[dt][ks] = *(const LAS bf16x8*)(buf + STG_V + (16 * dt + col) * STG_PITCH + (32 * ks + 8 * q4) * 2);
    }
}
template <int BR> __device__ __forceinline__ void attn_probs(f32x4 (&st)[4], const AttnFrag& f, const bf16x8 (&qf)[2], const lds_f32* BLh, float Mb, int t, int kb, int q4, bool far_, bool lsel) {
#pragma unroll
    for (int kt = 0; kt < 4; ++kt) { f32x4 z = (f32x4){0.f, 0.f, 0.f, 0.f};
        z = __builtin_amdgcn_mfma_f32_16x16x32_bf16(f.k[kt][0], qf[0], z, 0, 0, 0); st[kt] = __builtin_amdgcn_mfma_f32_16x16x32_bf16(f.k[kt][1], qf[1], z, 0, 0, 0); }
    if (far_) { const float c = BLh[127] - Mb;
#pragma unroll
        for (int kt = 0; kt < 4; ++kt)
#pragma unroll
            for (int e = 0; e < 4; ++e) st[kt][e] = lsel ? __builtin_amdgcn_exp2f(st[kt][e] + c) : 0.f;
    } else {
#pragma unroll
        for (int kt = 0; kt < 4; ++kt)
#pragma unroll
            for (int e = 0; e < 4; ++e) { const int k = kb + 16 * kt + 4 * q4 + e; const int dist = BR < 2 ? t - 16 * k - 31 : t - k;
                const bool ok = lsel && dist >= 0 && (BR != 3 || dist < WIN);
                const int dc = dist < 0 ? 0 : (dist > 127 ? 127 : dist);
                const float p = __builtin_amdgcn_exp2f(st[kt][e] + BLh[dc] - Mb); st[kt][e] = ok ? p : 0.f; }
    }
}
struct AttnAcc { f32x4 o[2][4]; float l[2]; };
__device__ __forceinline__ void attn_acc_zero(AttnAcc& A) {
#pragma unroll
    for (int G = 0; G < 2; ++G) { A.l[G] = 0.f;
#pragma unroll
        for (int dt = 0; dt < 4; ++dt) A.o[G][dt] = (f32x4){0.f, 0.f, 0.f, 0.f}; }
}
template <int BR> __device__ __forceinline__ void attn_block2(AttnAcc& A, const AttnFrag& f, const bf16x8 (&qf)[2][2], const lds_f32* BLh, const float (&Mb)[2], const int (&tq)[2], int kb, int q4, bool far_, const bool (&gact)[2], const bool (&lsel)[2]) {
#pragma unroll
    for (int G = 0; G < 2; ++G) {
        if (!gact[G]) continue;
        f32x4 st[4];
        attn_probs<BR>(st, f, qf[G], BLh, Mb[G], tq[G], kb, q4, far_, lsel[G]);
        float ls = 0.f;
#pragma unroll
        for (int kt = 0; kt < 4; ++kt) ls += (st[kt][0] + st[kt][1]) + (st[kt][2] + st[kt][3]);
        A.l[G] += ls;
        bf16x8 pb[2];
#pragma unroll
        for (int ks = 0; ks < 2; ++ks) { v4u w; w.x = pg8::cvt_pk_bf16(st[2 * ks][0], st[2 * ks][1]); w.y = pg8::cvt_pk_bf16(st[2 * ks][2], st[2 * ks][3]);
            w.z = pg8::cvt_pk_bf16(st[2 * ks + 1][0], st[2 * ks + 1][1]); w.w = pg8::cvt_pk_bf16(st[2 * ks + 1][2], st[2 * ks + 1][3]); pb[ks] = __builtin_bit_cast(bf16x8, w); }
#pragma unroll
        for (int dt = 0; dt < 4; ++dt) { A.o[G][dt] = __builtin_amdgcn_mfma_f32_16x16x32_bf16(f.v[dt][0], pb[0], A.o[G][dt], 0, 0, 0); A.o[G][dt] = __builtin_amdgcn_mfma_f32_16x16x32_bf16(f.v[dt][1], pb[1], A.o[G][dt], 0, 0, 0); }
    }
}
template <int MODE> __device__ __forceinline__ void attn_fold(const AttnAcc& A, float* tot  , const float (&gate)[2], float (&il)[2], bf16* const (&yp)[2]) {
#pragma unroll
    for (int G = 0; G < 2; ++G) { float ls = A.l[G]; ls += __shfl_xor(ls, 16); ls += __shfl_xor(ls, 32);
        il[G] = 1.0f / fmaxf(ls, 1e-30f); const float sc = gate[G] * il[G];
#pragma unroll
        for (int dt = 0; dt < 4; ++dt) { f32x4* tp = (f32x4*)(tot + (G * 4 + dt) * 256); f32x4 v = A.o[G][dt] * sc;
            if (MODE != 0) v += *tp;
            if (MODE != 2) *tp = v;
            else { v2u w; w.x = pk2(v[0], v[1]); w.y = pk2(v[2], v[3]); *(v2u*)(yp[G] + 16 * dt) = w; } } }
}
__device__ __noinline__ void attn_topk(LAS unsigned char* L, int wave, int lane, int cur) {
    const lds_f32* IMP = (const lds_f32*)(L + A2_IMP); LAS unsigned* SELB = (LAS unsigned*)(L + A2_SELB);
    const int sub = lane & 15;
    for (int pass = 0; pass < 2; ++pass) {
        const int q = wave * 8 + pass * 4 + (lane >> 4);
        unsigned word = 0u;
        if (cur < 16) { if (sub == 0) word = (cur >= 31) ? 0xffffffffu : ((1u << (cur + 1)) - 1u); }
        else {
            float v[16];
#pragma unroll
            for (int i = 0; i < 16; ++i) { const int J = 16 * i + sub; v[i] = (J >= 1 && J <= cur - 2) ? IMP[q * 256 + J] : -1.0f; }
            for (int r = 0; r < 13; ++r) {
                float m = v[0];
#pragma unroll
                for (int i = 1; i < 16; ++i) m = fmaxf(m, v[i]);
                m = fmaxf(m, DPP_F(m, 0x128)); m = fmaxf(m, DPP_F(m, 0x124)); m = fmaxf(m, DPP_F(m, 0x122)); m = fmaxf(m, DPP_F(m, 0x121));
                int c = 999;
#pragma unroll
                for (int i = 15; i >= 0; --i) c = (v[i] == m) ? 16 * i + sub : c;
                { int o = DPP_I(c, 0x128); c = o < c ? o : c; o = DPP_I(c, 0x124); c = o < c ? o : c; o = DPP_I(c, 0x122); c = o < c ? o : c; o = DPP_I(c, 0x121); c = o < c ? o : c; }
#pragma unroll
                for (int i = 0; i < 16; ++i) v[i] = (16 * i + sub == c) ? -2.0f : v[i];
                if ((c >> 5) == sub) word |= 1u << (c & 31);
            }
            if (sub == 0) word |= 1u;
            if (((cur - 1) >> 5) == sub) word |= 1u << ((cur - 1) & 31);
            if ((cur >> 5) == sub) word |= 1u << (cur & 31);
        }
        if (sub < 8) SELB[q * 8 + sub] = word;
    }
}

__device__ __forceinline__ void attn2_phase(const Args& a, const Frame& F) {
    LAS unsigned char* L = F.lds + RING_OFF;
    const bf16* Q = WSP(const bf16, WS_Q); const bf16* KV = WSP(const bf16, WS_KV); const bf16* KC = WSP(const bf16, WS_KCMP);
    const bf16* VT = WSP(const bf16, WS_VT2); const bf16* VCT = WSP(const bf16, WS_VCT); const float* GT = WSP(const float, WS_GT); bf16* Y = WSP(bf16, WS_HB);
    const unsigned* kmx = WSP(const unsigned, WS_CTL) + CW_KMAX;
    const int tid = F.tid, lane = F.lane, wave = F.wave, col = lane & 15, q4 = lane >> 4, hh = col & 3;
    float* tot = WSP(float, WS_TOT) + (size_t)F.bid * 16384 + wave * 2048 + lane * 4;
    LAS unsigned char* STG = L + A2_STG;
    for (int uu0 = F.bid; uu0 < 2 * NSLC; uu0 += F.G) {
        const int rnd = uu0 / F.G, ix = uu0 - rnd * F.G;
        int cur, g;
        if (F.G == NSLC) { g = ix & 1; cur = rnd ? NSLC - 1 - (ix >> 1) : (ix >> 1); }
        else { cur = uu0 >> 1; g = uu0 & 1; }
        const int t0 = 64 * cur;
        const bf16* Qg = Q + (size_t)t0 * 512 + g * 256;
        lds_f32* BL = (lds_f32*)(L + A2_BL); lds_f32* MB = (lds_f32*)(L + A2_MB);
        { const int h = tid >> 7, d = tid & 127; BL[tid] = LOG2E * a.in[I_RELB][(g * 4 + h) * 32 + T5_BUCKET[d]]; }
        __syncthreads();
        {   const int q = tid >> 3, h = (tid & 7) >> 1, d0 = (tid & 1) * 32; const v4u* qp = (const v4u*)(Qg + (size_t)q * 512 + h * 64 + d0); float s = 0.f;
#pragma unroll
            for (int c = 0; c < 4; ++c) { const v4u w = qp[c]; s += bflo(w.x) * bflo(w.x) + bfhi(w.x) * bfhi(w.x) + bflo(w.y) * bflo(w.y) + bfhi(w.y) * bfhi(w.y) + bflo(w.z) * bflo(w.z) + bfhi(w.z) * bfhi(w.z) + bflo(w.w) * bflo(w.w) + bfhi(w.w) * bfhi(w.w); }
            s += __shfl_xor(s, 1); const float qn = sqrtf(s);
            float bm = -3.0e38f;
            for (int d = 0; d < 128; ++d) bm = fmaxf(bm, BL[h * 128 + d]);
            if ((tid & 1) == 0) {
#pragma unroll
                for (int b = 0; b < 3; ++b) MB[b * 256 + q * 4 + h] = qn * sqrtf(__uint_as_float(kmx[2 * b + g])) * 1.001f + bm + 0.5f; }
        }
        __syncthreads();
        const lds_f32* BLh = BL + hh * 128;
        bf16x8 qf[2][2]; int tq[2];
#pragma unroll
        for (int G = 0; G < 2; ++G) { const int q = wave * 8 + G * 4 + (col >> 2); tq[G] = t0 + q;
            const bf16* qp = Qg + (size_t)q * 512 + hh * 64 + 8 * q4; qf[G][0] = *(const bf16x8*)qp; qf[G][1] = *(const bf16x8*)(qp + 32); }
#define A2_LOADM(M, b) float M[2]; _Pragma("unroll") for (int G = 0; G < 2; ++G) M[G] = MB[(b) * 256 + (wave * 8 + G * 4 + (col >> 2)) * 4 + hh]
#define A2_LOADG(gv, b) float gv[2]; _Pragma("unroll") for (int G = 0; G < 2; ++G) gv[G] = GT[(size_t)(t0 + wave * 8 + G * 4 + (col >> 2)) * 24 + (g * 4 + hh) * 3 + (b)]
        const int twlo = t0 + 8 * wave, twhi = twlo + 7;
        const bool all2[2] = {true, true};
        const int tmax = t0 + 63, nvu = tmax >= 31 ? ((tmax - 31) >> 4) + 1 : 0, nbu = (nvu + 63) >> 6;
        float il[2];
        AttnStage sg; AttnFrag fc; AttnAcc A;
        A2_LOADM(Mc, 0);
        attn_acc_zero(A);
        if (nbu > 0) stage_issue<true>(sg, KC + g * 64, 128, VCT + (size_t)(g * 16) * 4096, tid);
        for (int jc = 0; jc < nbu; ++jc) {
            LAS unsigned char* buf = STG + (jc & 1) * STG_BUF;
            stage_commit<true>(buf, sg, tid);
            __syncthreads();
            if (jc + 1 < nbu) stage_issue<true>(sg, KC + (size_t)(64 * (jc + 1)) * 128 + g * 64, 128, VCT + (size_t)(g * 16 + jc + 1) * 4096, tid);
            if (twhi - 16 * (64 * jc) - 31 >= 0) { frag_from_lds<true>(fc, buf, col, q4);
                attn_block2<0>(A, fc, qf, BLh, Mc, tq, 64 * jc, q4, twlo - 16 * (64 * jc + 63) - 31 >= 113, all2, all2); }
        }
        { A2_LOADG(gc, 0); bf16* const ypn[2] = {nullptr, nullptr}; attn_fold<0>(A, tot, gc, il, ypn); }
        __syncthreads();
        if (cur >= 16) {
            lds_f32* IMP = (lds_f32*)(L + A2_IMP);
            float carry[2] = {0.f, 0.f};
            stage_issue<false>(sg, KC + g * 64, 128, nullptr, tid);
            for (int jc = 0; jc < nbu; ++jc) {
                LAS unsigned char* buf = STG + (jc & 1) * STG_BUF;
                stage_commit<false>(buf, sg, tid);
                __syncthreads();
                if (jc + 1 < nbu) stage_issue<false>(sg, KC + (size_t)(64 * (jc + 1)) * 128 + g * 64, 128, nullptr, tid);
                if (twhi - 16 * (64 * jc) - 31 < 0) continue;
                frag_from_lds<false>(fc, buf, col, q4);
#pragma unroll
                for (int G = 0; G < 2; ++G) { f32x4 st[4];
                    attn_probs<1>(st, fc, qf[G], BLh, Mc[G], tq[G], 64 * jc, q4, twlo - 16 * (64 * jc + 63) - 31 >= 113, true);
                    float s4[4], rot[4];
#pragma unroll
                    for (int kt = 0; kt < 4; ++kt) { float x3 = st[kt][3] * il[G], x4 = (st[kt][0] + st[kt][1] + st[kt][2]) * il[G] + x3;
                        x4 += DPP_F(x4, 0xB1); x4 += DPP_F(x4, 0x4E); x3 += DPP_F(x3, 0xB1); x3 += DPP_F(x3, 0x4E); s4[kt] = x4;
                        rot[kt] = __shfl(x3, (lane + 48) & 63); }
                    const int q = wave * 8 + G * 4 + (col >> 2);
#pragma unroll
                    for (int kt = 0; kt < 4; ++kt) { const float prev = q4 > 0 ? rot[kt] : (kt > 0 ? rot[kt - 1] : carry[G]);
                        if (hh == 0) IMP[q * 256 + 16 * jc + 4 * kt + q4] = s4[kt] + prev; }
                    carry[G] = rot[3];
                }
            }
            __syncthreads();
        }
        attn_topk(L, wave, lane, cur);
        {   const LAS unsigned* SELB = (const LAS unsigned*)(L + A2_SELB);
            A2_LOADM(Ms, 1);
            attn_acc_zero(A);
            stage_issue<true>(sg, KV + 256 + g * 64, 768, VT + (size_t)((0 * 2 + g) * 256) * 4096, tid);
            for (int j = 0; j <= cur; ++j) {
                LAS unsigned char* buf = STG + (j & 1) * STG_BUF;
                stage_commit<true>(buf, sg, tid);
                __syncthreads();
                if (j + 1 <= cur) stage_issue<true>(sg, KV + (size_t)(64 * (j + 1)) * 768 + 256 + g * 64, 768, VT + (size_t)((0 * 2 + g) * 256 + j + 1) * 4096, tid);
                bool lsel[2], gact[2];
#pragma unroll
                for (int G = 0; G < 2; ++G) { lsel[G] = (SELB[(wave * 8 + G * 4 + (col >> 2)) * 8 + (j >> 5)] >> (j & 31)) & 1u; gact[G] = __ballot(lsel[G]) != 0ull; }
                if (gact[0] || gact[1]) { frag_from_lds<true>(fc, buf, col, q4);
                    attn_block2<2>(A, fc, qf, BLh, Ms, tq, 64 * j, q4, twlo - (64 * j + 63) >= 113, gact, lsel); }
            }
            A2_LOADG(gs, 1); float il2[2]; bf16* const ypn[2] = {nullptr, nullptr}; attn_fold<1>(A, tot, gs, il2, ypn);
        }
        __syncthreads();
        {   const int jlo = cur >= 8 ? cur - 8 : 0;
            A2_LOADM(Mw, 2);
            attn_acc_zero(A);
            stage_issue<true>(sg, KV + (size_t)(64 * jlo) * 768 + 512 + g * 64, 768, VT + (size_t)((1 * 2 + g) * 256 + jlo) * 4096, tid);
            for (int j = jlo; j <= cur; ++j) {
                LAS unsigned char* buf = STG + (j & 1) * STG_BUF;
                stage_commit<true>(buf, sg, tid);
                __syncthreads();
                if (j + 1 <= cur) stage_issue<true>(sg, KV + (size_t)(64 * (j + 1)) * 768 + 512 + g * 64, 768, VT + (size_t)((1 * 2 + g) * 256 + j + 1) * 4096, tid);
                if (64 * j <= twhi && 64 * j + 63 >= twlo - (WIN - 1)) { frag_from_lds<true>(fc, buf, col, q4);
                    attn_block2<3>(A, fc, qf, BLh, Mw, tq, 64 * j, q4, (twlo - (64 * j + 63) >= 113) && (twhi - 64 * j < WIN), all2, all2); }
            }
            A2_LOADG(gw, 2); float il2[2]; bf16* yp[2];
#pragma unroll
            for (int G = 0; G < 2; ++G) yp[G] = Y + (size_t)(t0 + wave * 8 + G * 4 + (col >> 2)) * DM + 512 + (g * 4 + hh) * 64 + 4 * q4;
            attn_fold<2>(A, tot, gw, il2, yp);
        }
        __syncthreads();
    }
}
__global__ void __launch_bounds__(NWAVES * 64, 2) fwd_kernel(Args a) {
    extern __shared__ __attribute__((aligned(16))) unsigned char lds[];
    Frame F;
    F.lds = (LAS unsigned char*)lds;
    F.tid = threadIdx.x; F.lane = F.tid & 63; F.wave = __builtin_amdgcn_readfirstlane(F.tid >> 6);
    F.G = gridDim.x; F.bid = blockIdx.x;
    volatile LAS unsigned* MISC = (volatile LAS unsigned*)(F.lds + MISC_OFF);
    for (int u = F.tid; u < (LDS_BYTES - LDSCTL_OFF) / 4; u += NWAVES * 64) ((LAS unsigned*)(F.lds + LDSCTL_OFF))[u] = 0u;
    __syncthreads();
    const int lo = a.ph_lo, hi = a.ph_hi;
    const bool multi = (hi - lo) > 1;
    unsigned* barw = WSP(unsigned, WS_CTL) + CW_BAR;
    XcdBarrier bar; bar.bar = barw; bar.x = 0; bar.st = MISC + 8;
    if (multi) bar = xcd_barrier_post(barw, MISC + 8);
#ifndef REP_MASK
#define REP_MASK 0
#endif
#define IN(k) (lo <= (k) && (k) < hi)
#define REPS(k) (((REP_MASK >> (k)) & 1) ? 2 : 1)
#define SEAM(k) do { if (IN(k) && IN((k) + 1)) xcd_barrier(bar); } while (0)
    PG8_LAS unsigned char* ring = F.lds + RING_OFF;

    if (IN(0)) for (int rep_ = 0; rep_ < REPS(0); ++rep_) { if (rep_) xcd_barrier(bar); p0_prologue(a, F); } SEAM(0);
    if (IN(1)) for (int rep_ = 0; rep_ < REPS(1); ++rep_) { if (rep_) xcd_barrier(bar); norm_mod_pass<true>(a, F, a.in[I_X], WSP(bf16, WS_HB), a.in[I_GFFN1], 0); } SEAM(1);
    if (IN(2)) for (int rep_ = 0; rep_ < REPS(2); ++rep_) { if (rep_) xcd_barrier(bar);
        pg8::Gemm g{WSP(const bf16, WS_HB), WSP(const bf16, WS_WGU1), SEQ, 2 * DFF, DM}; pg8::StaticOrder S; S.init(SEQ, 2 * DFF, F.G, F.bid);
        pg8::EpiSwiGLU E{WSP(bf16, WS_ACT), DFF};
        pg8::gemm_phase<pg8::EpiSwiGLU, pg8::StaticOrder, PG8_ALIGN, PG8_SP2>(ring, g, S, E);
    } SEAM(2);
    if (IN(3)) for (int rep_ = 0; rep_ < REPS(3); ++rep_) { if (rep_) xcd_barrier(bar);
        pg8::Gemm g{WSP(const bf16, WS_ACT), WSP(const bf16, WS_WD1), SEQ, DM, DFF}; pg8::StaticOrder S; S.init(SEQ, DM, F.G, F.bid);
        pg8::EpiResid E{a.in[I_X], WSP(float, WS_XB), DM, WSP(const float, WS_MOD) + 2 * DM, 0.5f};
        pg8::gemm_phase<pg8::EpiResid, pg8::StaticOrder, false, PG8_SP2>(ring, g, S, E);
    } SEAM(3);
    if (IN(4)) for (int rep_ = 0; rep_ < REPS(4); ++rep_) { if (rep_) xcd_barrier(bar); norm_mod_pass<false>(a, F, WSP(const float, WS_XB), WSP(bf16, WS_HB), a.in[I_GMIX], 1); } SEAM(4);
    if (IN(5)) for (int rep_ = 0; rep_ < REPS(5); ++rep_) { if (rep_) xcd_barrier(bar);
        pg8::Gemm g{WSP(const bf16, WS_HB), WSP(const bf16, WS_WIN), SEQ, DIN_PAD, DM}; pg8::StaticOrder S; S.init(SEQ, DIN_PAD, F.G, F.bid);
        pg8::EpiMix E{WSP(bf16, WS_HG), WSP(bf16, WS_Q), WSP(bf16, WS_KV), WSP(float, WS_GT)};
        pg8::gemm_phase<pg8::EpiMix, pg8::StaticOrder, PG8_ALIGN, PG8_SP2>(ring, g, S, E);
    } SEAM(5);
    if (IN(6)) for (int rep_ = 0; rep_ < REPS(6); ++rep_) { if (rep_) xcd_barrier(bar); conv_phase(a, F); kv_prep_phase(a, F); compress_phase(a, F); } SEAM(6);
    if (IN(7)) for (int rep_ = 0; rep_ < REPS(7); ++rep_) { if (rep_) xcd_barrier(bar); attn2_phase(a, F); } SEAM(7);
    if (IN(8)) for (int rep_ = 0; rep_ < REPS(8); ++rep_) { if (rep_) xcd_barrier(bar);
        pg8::Gemm g{WSP(const bf16, WS_HB), WSP(const bf16, WS_WOUT), SEQ, DM, DM}; pg8::StaticOrder S; S.init(SEQ, DM, F.G, F.bid);
        pg8::EpiResid E{WSP(const float, WS_XB), WSP(float, WS_XB), DM, WSP(const float, WS_MOD) + 5 * DM, 1.0f};
        pg8::gemm_phase<pg8::EpiResid, pg8::StaticOrder, false, PG8_SP2>(ring, g, S, E);
    } SEAM(8);
    if (IN(9)) for (int rep_ = 0; rep_ < REPS(9); ++rep_) { if (rep_) xcd_barrier(bar); norm_mod_pass<false>(a, F, WSP(const float, WS_XB), WSP(bf16, WS_HB), a.in[I_GFFN2], 2); } SEAM(9);
    if (IN(10)) for (int rep_ = 0; rep_ < REPS(10); ++rep_) { if (rep_) xcd_barrier(bar);
        pg8::Gemm g{WSP(const bf16, WS_HB), WSP(const bf16, WS_WGU2), SEQ, 2 * DFF, DM}; pg8::StaticOrder S; S.init(SEQ, 2 * DFF, F.G, F.bid);
        pg8::EpiSwiGLU E{WSP(bf16, WS_ACT), DFF};
        pg8::gemm_phase<pg8::EpiSwiGLU, pg8::StaticOrder, PG8_ALIGN, PG8_SP2>(ring, g, S, E);
    } SEAM(10);
    if (IN(11)) for (int rep_ = 0; rep_ < REPS(11); ++rep_) { if (rep_) xcd_barrier(bar);
        pg8::Gemm g{WSP(const bf16, WS_ACT), WSP(const bf16, WS_WD2), SEQ, DM, DFF}; pg8::StaticOrder S; S.init(SEQ, DM, F.G, F.bid);
        pg8::EpiResid E{WSP(const float, WS_XB), a.out, DM, WSP(const float, WS_MOD) + 8 * DM, 0.5f};
        pg8::gemm_phase<pg8::EpiResid, pg8::StaticOrder, false, PG8_SP2>(ring, g, S, E);
    } SEAM(11);
    if (IN(12)) for (int rep_ = 0; rep_ < REPS(12); ++rep_) { if (rep_) xcd_barrier(bar); final_norm_pass(a, F); }
#undef IN
#undef SEAM
}

extern "C" void kernel_launch(void* const* d_in, const int* in_sizes, int n_in, void* d_out, int out_size, void* d_ws, size_t ws_size, hipStream_t stream) {
    static int grid = 0;
    if (grid == 0) {
        if (n_in != N_IN || in_sizes[0] != SEQ * DM || out_size != SEQ * DM || ws_size < WS_END) { fprintf(stderr, "kernel_launch: unexpected problem shape (n_in %d, ws %zu); nothing launched\n", n_in, ws_size); grid = -1; return; }
        int dev = 0, cus = 0, per_cu = 0;
        if (hipGetDevice(&dev) != hipSuccess || hipDeviceGetAttribute(&cus, hipDeviceAttributeMultiprocessorCount, dev) != hipSuccess) { grid = -1; return; }
        if (hipFuncSetAttribute((const void*)fwd_kernel, hipFuncAttributeMaxDynamicSharedMemorySize, LDS_BYTES) != hipSuccess) { fprintf(stderr, "kernel_launch: hipFuncSetAttribute failed\n"); grid = -1; return; }
        if (hipOccupancyMaxActiveBlocksPerMultiprocessor(&per_cu, (const void*)fwd_kernel, NWAVES * 64, LDS_BYTES) != hipSuccess || per_cu < 1)
            fprintf(stderr, "kernel_launch: note: occupancy query reports %d workgroups per CU\n", per_cu);
        (void)hipGetLastError();
        grid = cus;
    }
    if (grid < 0) return;
    if (hipMemsetAsync((char*)d_ws + WS_CTL, 0, CTL_ZERO_BYTES, stream) != hipSuccess) return;
    Args a{};
    for (int i = 0; i < N_IN; ++i) a.in[i] = (const float*)d_in[i];
    a.out = (float*)d_out; a.ws = (unsigned char*)d_ws;
#ifdef PROBE_MODE
    a.probe = PROBE_MODE;
#endif
#if MK_LAUNCHES == 1
    a.ph_lo = 0; a.ph_hi = N_PHASES;
    hipLaunchKernelGGL(fwd_kernel, dim3(grid), dim3(NWAVES * 64), LDS_BYTES, stream, a);
#else
    for (int p = 0; p < N_PHASES; ++p) { a.ph_lo = p; a.ph_hi = p + 1; hipLaunchKernelGGL(fwd_kernel, dim3(grid), dim3(NWAVES * 64), LDS_BYTES, stream, a); }
#endif
}
```

```cpp
#include <hip/hip_runtime.h>
#include <cstdio>
#include <cstdint>
namespace pg8 {
#define PG8_LAS __attribute__((address_space(3)))
typedef unsigned short bf16_t;
typedef short bf16x8 __attribute__((ext_vector_type(8)));
typedef float f32x4 __attribute__((ext_vector_type(4)));
typedef unsigned u32x4 __attribute__((ext_vector_type(4)));
constexpr int BM = 256, BK = 64, HALF = 128, HTB = HALF * BK * 2  , STAGE_BYTES = 8 * HTB, NXCD = 8, WGM = 8;

__host__ __device__ __forceinline__ int lds_byte(int r, int c) { const int st = (r >> 4) * 2 + (c >> 5), rr = r & 15, cc = c & 31, ob = rr * 64 + cc * 2; return st * 1024 + (ob ^ (((ob >> 9) & 1) << 5)); }
__host__ __device__ __forceinline__ void stage_rc(int b, int& R, int& C) { const int st = b / 1024, sb = b % 1024, swz = sb ^ (((sb >> 9) & 1) << 5); R = (st >> 1) * 16 + swz / 64; C = (st & 1) * 32 + (swz % 64) / 2; }
__host__ __device__ __forceinline__ int perm32(int rho) { const int n = rho >> 4, i = rho & 15; return 8 * (i >> 2) + 4 * n + (i & 3); }

struct Unit { int pm, pn; };
struct Gemm { const bf16_t* A; const bf16_t* Bt; int M, N, K; };

struct StaticOrder {
    int nM, nN, nwg, G, c;
    __host__ __device__ void init(int M, int N, int G_, int c_) { nM = M / BM; nN = N / BM; nwg = nM * nN; G = G_; c = c_; }
    __host__ __device__ bool next(int i, Unit& u) const {
        const long L = (long)i * G + c; if (L >= nwg) return false;
        int wgid = (int)L; { const int q = nwg / NXCD, r = nwg % NXCD, xcd = wgid % NXCD, off = wgid / NXCD; wgid = (xcd < r ? xcd * (q + 1) : r * (q + 1) + (xcd - r) * q) + off; }
        const int nig = WGM * nN, gid = wgid / nig, fm = gid * WGM, gsz = (nM - fm) < WGM ? (nM - fm) : WGM;
        u.pm = fm + ((wgid % nig) % gsz); u.pn = (wgid % nig) / gsz; return true;
    }
    __device__ __forceinline__ void a_ready(const Unit&) const {}
    __device__ __forceinline__ void done(const Unit&) const {}
};


__device__ __forceinline__ unsigned cvt_pk_bf16(float lo, float hi) { unsigned r; asm volatile("v_cvt_pk_bf16_f32 %0, %1, %2" : "=v"(r) : "v"(lo), "v"(hi)); return r; }
__device__ __forceinline__ float sigmoid_f(float x) { return __builtin_amdgcn_rcpf(1.0f + __builtin_amdgcn_exp2f(-1.4426950408889634f * x)); }
__device__ __forceinline__ float silu_f(float x) { return x * sigmoid_f(x); }

template <bool GLU> __device__ __forceinline__ void gated_store(const f32x4 (&acc)[2][2][4][2], bf16_t* O, int ldc, int row0, int col0) {
#pragma unroll
    for (int ai = 0; ai < 2; ++ai)
#pragma unroll
        for (int m = 0; m < 4; ++m) { bf16_t* rowp = O + (size_t)(row0 + ai * HALF + m * 16) * ldc + col0;
            float v[8];
#pragma unroll
            for (int n = 0; n < 2; ++n)
#pragma unroll
                for (int e = 0; e < 4; ++e) { const float a = acc[ai][0][m][n][e], b = acc[ai][1][m][n][e]; v[n * 4 + e] = GLU ? a * sigmoid_f(b) : silu_f(a) * b; }
            u32x4 w; w.x = cvt_pk_bf16(v[0], v[1]); w.y = cvt_pk_bf16(v[2], v[3]); w.z = cvt_pk_bf16(v[4], v[5]); w.w = cvt_pk_bf16(v[6], v[7]);
            *(u32x4*)rowp = w; }
}
struct EpiSwiGLU {
    static constexpr bool PERM = true, AFTER_DRAIN = false;
    bf16_t* O; int ldc;
    __device__ __forceinline__ void operator()(const f32x4 (&acc)[2][2][4][2], const Unit& u, int wr, int wc, int fr, int fq) const {
        gated_store<false>(acc, O, ldc, u.pm * BM + wr * 64 + fr, u.pn * HALF + wc * 32 + 8 * fq);
    }
};
struct EpiResid {
    static constexpr bool PERM = false, AFTER_DRAIN = false;
    const float* base; float* out; int ldc; const float* gate; float scale;
    __device__ __forceinline__ void operator()(const f32x4 (&acc)[2][2][4][2], const Unit& u, int wr, int wc, int fr, int fq) const {
        const int col0 = u.pn * BM + wc * 32 + 4 * fq, row0 = u.pm * BM + wr * 64 + fr;
        f32x4 cf[2][2];
#pragma unroll
        for (int bj = 0; bj < 2; ++bj)
#pragma unroll
            for (int n = 0; n < 2; ++n) cf[bj][n] = *(const f32x4*)(gate + col0 + bj * HALF + n * 16) * scale;
#pragma unroll
        for (int ai = 0; ai < 2; ++ai)
#pragma unroll
            for (int m = 0; m < 4; ++m) { const size_t off = (size_t)(row0 + ai * HALF + m * 16) * ldc + col0;
#pragma unroll
                for (int bj = 0; bj < 2; ++bj)
#pragma unroll
                    for (int n = 0; n < 2; ++n) { const f32x4 bs = *(const f32x4*)(base + off + bj * HALF + n * 16); *(f32x4*)(out + off + bj * HALF + n * 16) = bs + cf[bj][n] * acc[ai][bj][m][n]; }
                if (m & 1) asm volatile("" ::: "memory"); }
    }
};
struct EpiMix {
    static constexpr bool PERM = true, AFTER_DRAIN = false;
    bf16_t* HG; bf16_t* Q; bf16_t* KV; float* GT;
    __device__ __forceinline__ void operator()(const f32x4 (&acc)[2][2][4][2], const Unit& u, int wr, int wc, int fr, int fq) const {
        const int row0 = u.pm * BM + wr * 64 + fr, c8 = wc * 32 + 8 * fq;
        if (u.pn < 4) { gated_store<true>(acc, HG, 512, row0, u.pn * HALF + c8); return; }
        if (u.pn == 9) {
            if (c8 < 24) {
#pragma unroll
                for (int ai = 0; ai < 2; ++ai)
#pragma unroll
                    for (int m = 0; m < 4; ++m) { float* rowp = GT + (size_t)(row0 + ai * HALF + m * 16) * 24 + c8;
#pragma unroll
                        for (int n = 0; n < 2; ++n) { const f32x4 a = acc[ai][0][m][n]; *(f32x4*)(rowp + 4 * n) = (f32x4){sigmoid_f(a[0]), sigmoid_f(a[1]), sigmoid_f(a[2]), sigmoid_f(a[3])}; } }
            }
            return;
        }
        bf16_t* O; int ldc, colt; float sc;
        if (u.pn < 6) { O = Q; ldc = 512; colt = (u.pn - 4) * BM; sc = 0.125f * 1.4426950408889634f; } else { O = KV; ldc = 768; colt = (u.pn - 6) * BM; sc = 1.0f; }
#pragma unroll
        for (int ai = 0; ai < 2; ++ai)
#pragma unroll
            for (int m = 0; m < 4; ++m) { bf16_t* rowp = O + (size_t)(row0 + ai * HALF + m * 16) * ldc + colt + c8;
#pragma unroll
                for (int bj = 0; bj < 2; ++bj) { const f32x4 v0 = acc[ai][bj][m][0] * sc, v1 = acc[ai][bj][m][1] * sc;
                    u32x4 w; w.x = cvt_pk_bf16(v0[0], v0[1]); w.y = cvt_pk_bf16(v0[2], v0[3]); w.z = cvt_pk_bf16(v1[0], v1[1]); w.w = cvt_pk_bf16(v1[2], v1[3]);
                    *(u32x4*)(rowp + bj * HALF) = w; } }
    }
};

template <class Epi, class Sched, bool ALIGN_EPI = false, bool SP2 = false>
__device__ __forceinline__ void gemm_phase(PG8_LAS unsigned char* lds, const Gemm g, const Sched& S, const Epi& E) {
    const int tid = threadIdx.x, wid = __builtin_amdgcn_readfirstlane(tid >> 6), lane = tid & 63, wr = wid >> 2, wc = wid & 3, fr = lane & 15, fq = lane >> 4;
    const int K = g.K, nt = K / BK;
    unsigned voffA[2], voffB[2];
#pragma unroll
    for (int i = 0; i < 2; ++i) { int R, C; stage_rc(tid * 16 + i * 8192, R, C); const int Rb = Epi::PERM ? ((R & ~31) + perm32(R & 31)) : R;
        voffA[i] = (unsigned)(R * K + C) * 2u; voffB[i] = (unsigned)(Rb * K + C) * 2u; }
    const size_t kstep = (size_t)(BK * 2);
    const size_t hstep = (size_t)HALF * K * 2;
    const size_t tstep = 2 * hstep;
    const unsigned ldsw = (unsigned)wid * 1024u;
    const int aoff = lds_byte(wr * 64 + fr, fq * 8), boff = lds_byte(wc * 32 + fr, fq * 8);
#define PG8_SA(b, h) (((b) * 2 + (h)) * HTB)
#define PG8_SB(b, h) ((4 + (b) * 2 + (h)) * HTB)
#define PG8_STAGE(bufoff, gbase, voff) do { _Pragma("unroll") for (int _i = 0; _i < 2; ++_i) \
        __builtin_amdgcn_global_load_lds((const unsigned*)((const char*)(gbase) + (voff)[_i]), (PG8_LAS unsigned*)(lds + (bufoff) + ldsw + _i * 8192), 16, 0, 0); } while (0)
#define PG8_LDA(dst, b, h) do { _Pragma("unroll") for (int m = 0; m < 4; ++m) _Pragma("unroll") for (int k = 0; k < 2; ++k) dst[m][k] = *(const PG8_LAS bf16x8*)(lds + PG8_SA(b, h) + aoff + m * 2048 + k * 1024); } while (0)
#define PG8_LDB(dst, b, h) do { _Pragma("unroll") for (int n = 0; n < 2; ++n) _Pragma("unroll") for (int k = 0; k < 2; ++k) dst[n][k] = *(const PG8_LAS bf16x8*)(lds + PG8_SB(b, h) + boff + n * 2048 + k * 1024); } while (0)
#define PG8_MMA(ai, bj, At, Bt) do { __builtin_amdgcn_s_setprio(1); _Pragma("unroll") for (int m = 0; m < 4; ++m) _Pragma("unroll") for (int n = 0; n < 2; ++n) _Pragma("unroll") for (int k = 0; k < 2; ++k) \
        acc[ai][bj][m][n] = __builtin_amdgcn_mfma_f32_16x16x32_bf16(Bt[n][k], At[m][k], acc[ai][bj][m][n], 0, 0, 0); __builtin_amdgcn_s_setprio(0); } while (0)
#define PG8_WAIT_V(n) asm volatile("s_waitcnt vmcnt(" #n ")" ::: "memory")
#define PG8_WAIT_L(n) asm volatile("s_waitcnt lgkmcnt(" #n ")" ::: "memory")
#define PG8_BAR __builtin_amdgcn_s_barrier()
#define PG8_SCHED __builtin_amdgcn_sched_barrier(0)
    Unit cur, nxt; int ui = 0;
    if (!S.next(0, cur)) return;
    f32x4 acc[2][2][4][2];
#pragma unroll
    for (int a = 0; a < 2; ++a)
#pragma unroll
        for (int b = 0; b < 2; ++b)
#pragma unroll
            for (int m = 0; m < 4; ++m)
#pragma unroll
                for (int n = 0; n < 2; ++n) acc[a][b][m][n] = (f32x4){0.f, 0.f, 0.f, 0.f};
    bf16x8 At[4][2], B0[2][2], B1[2][2];
    const char* cA = (const char*)g.A + (size_t)cur.pm * tstep; const char* cB = (const char*)g.Bt + (size_t)cur.pn * tstep;
    S.a_ready(cur);
    if constexpr (SP2) {
        PG8_STAGE(PG8_SB(0, 0), cB, voffB); PG8_STAGE(PG8_SB(0, 1), cB + hstep, voffB); PG8_STAGE(PG8_SA(0, 0), cA, voffA); PG8_STAGE(PG8_SA(0, 1), cA + hstep, voffA);
        if (wr == 1) PG8_BAR;
        PG8_WAIT_V(2); PG8_BAR;
        PG8_STAGE(PG8_SB(1, 0), cB + kstep, voffB); PG8_STAGE(PG8_SA(1, 0), cA + kstep, voffA); PG8_STAGE(PG8_SB(1, 1), cB + hstep + kstep, voffB);
        PG8_WAIT_V(6); PG8_BAR;
    } else {
        PG8_STAGE(PG8_SB(0, 0), cB, voffB); PG8_STAGE(PG8_SA(0, 0), cA, voffA); PG8_STAGE(PG8_SB(0, 1), cB + hstep, voffB); PG8_STAGE(PG8_SA(0, 1), cA + hstep, voffA);
        if (wr == 1) PG8_BAR;
        PG8_WAIT_V(4); PG8_BAR;
        PG8_STAGE(PG8_SB(1, 0), cB + kstep, voffB); PG8_STAGE(PG8_SA(1, 0), cA + kstep, voffA); PG8_STAGE(PG8_SB(1, 1), cB + hstep + kstep, voffB);
        PG8_WAIT_V(6); PG8_BAR;
    }
    for (;;) {
        const bool has_next = S.next(ui + 1, nxt);
        const char* nA = has_next ? (const char*)g.A + (size_t)nxt.pm * tstep : cA; const char* nB = has_next ? (const char*)g.Bt + (size_t)nxt.pn * tstep : cB;
        for (int t = 0; t < nt; t += 2) {
            const bool last = (t == nt - 2);
            const char* a1 = cA + (size_t)(t + 1) * kstep;
            const char* a2 = last ? nA : cA + (size_t)(t + 2) * kstep; const char* b2 = last ? nB : cB + (size_t)(t + 2) * kstep;
            const char* a3 = a2 + kstep; const char* b3 = b2 + kstep;
            if (last && has_next) S.a_ready(nxt);
            if constexpr (SP2) {
            PG8_LDB(B0, 0, 0); PG8_LDB(B1, 0, 1); PG8_SCHED; PG8_LDA(At, 0, 0); PG8_STAGE(PG8_SA(1, 1), a1 + hstep, voffA);
            PG8_WAIT_V(8); PG8_WAIT_L(0); PG8_BAR; PG8_MMA(0, 0, At, B0); PG8_MMA(0, 1, At, B1); PG8_BAR; PG8_SCHED;
            PG8_LDA(At, 0, 1); PG8_STAGE(PG8_SB(0, 0), b2, voffB); PG8_STAGE(PG8_SB(0, 1), b2 + hstep, voffB); PG8_STAGE(PG8_SA(0, 0), a2, voffA);
            PG8_WAIT_V(8); PG8_WAIT_L(0); PG8_BAR; PG8_MMA(1, 0, At, B0); PG8_MMA(1, 1, At, B1); PG8_BAR; PG8_SCHED;
            PG8_LDB(B0, 1, 0); PG8_LDB(B1, 1, 1); PG8_SCHED; PG8_LDA(At, 1, 0); PG8_STAGE(PG8_SA(0, 1), a2 + hstep, voffA);
            PG8_WAIT_V(8); PG8_WAIT_L(0); PG8_BAR; PG8_MMA(0, 0, At, B0); PG8_MMA(0, 1, At, B1); PG8_BAR; PG8_SCHED;
            PG8_LDA(At, 1, 1); PG8_STAGE(PG8_SB(1, 0), b3, voffB); PG8_STAGE(PG8_SB(1, 1), b3 + hstep, voffB); PG8_STAGE(PG8_SA(1, 0), a3, voffA);
            PG8_WAIT_V(8); PG8_WAIT_L(0); PG8_BAR; PG8_MMA(1, 0, At, B0); PG8_MMA(1, 1, At, B1); PG8_BAR; PG8_SCHED;
            } else {
            PG8_LDB(B0, 0, 0); PG8_SCHED; PG8_LDA(At, 0, 0); PG8_STAGE(PG8_SA(1, 1), a1 + hstep, voffA);
            PG8_WAIT_L(8); PG8_BAR; PG8_WAIT_L(0); PG8_MMA(0, 0, At, B0); PG8_BAR; PG8_SCHED;
            PG8_LDB(B1, 0, 1); PG8_STAGE(PG8_SB(0, 0), b2, voffB);
            PG8_BAR; PG8_WAIT_L(0); PG8_MMA(0, 1, At, B1); PG8_BAR;
            PG8_LDA(At, 0, 1); PG8_STAGE(PG8_SA(0, 0), a2, voffA);
            PG8_BAR; PG8_WAIT_L(0); PG8_MMA(1, 0, At, B0); PG8_BAR; PG8_SCHED;
            PG8_STAGE(PG8_SB(0, 1), b2 + hstep, voffB);
            PG8_WAIT_V(6); PG8_BAR; PG8_MMA(1, 1, At, B1); PG8_BAR;
            PG8_LDB(B0, 1, 0); PG8_SCHED; PG8_LDA(At, 1, 0); PG8_STAGE(PG8_SA(0, 1), a2 + hstep, voffA);
            PG8_WAIT_L(8); PG8_BAR; PG8_WAIT_L(0); PG8_MMA(0, 0, At, B0); PG8_BAR; PG8_SCHED;
            PG8_LDB(B1, 1, 1); PG8_STAGE(PG8_SB(1, 0), b3, voffB);
            PG8_BAR; PG8_WAIT_L(0); PG8_MMA(0, 1, At, B1); PG8_BAR;
            PG8_LDA(At, 1, 1); PG8_STAGE(PG8_SA(1, 0), a3, voffA);
            PG8_BAR; PG8_WAIT_L(0); PG8_MMA(1, 0, At, B0); PG8_BAR; PG8_SCHED;
            PG8_STAGE(PG8_SB(1, 1), b3 + hstep, voffB);
            PG8_WAIT_V(6); PG8_BAR; PG8_MMA(1, 1, At, B1); PG8_BAR;
            }
        }
        if constexpr (ALIGN_EPI) { if (wr == 0) PG8_BAR; }
        if constexpr (!Epi::AFTER_DRAIN) { E(acc, cur, wr, wc, fr, fq); S.done(cur); }
        if (!has_next) break;
#pragma unroll
        for (int a = 0; a < 2; ++a)
#pragma unroll
            for (int b = 0; b < 2; ++b)
#pragma unroll
                for (int m = 0; m < 4; ++m)
#pragma unroll
                    for (int n = 0; n < 2; ++n) acc[a][b][m][n] = (f32x4){0.f, 0.f, 0.f, 0.f};
        cur = nxt; cA = nA; cB = nB; ++ui;
        if constexpr (ALIGN_EPI) { if (wr == 1) PG8_BAR; }
    }
    PG8_WAIT_V(0);
    if constexpr (!ALIGN_EPI) { if (wr == 0) PG8_BAR; }
    PG8_BAR;
    if constexpr (Epi::AFTER_DRAIN) { E.fused(acc, cur, wr, wc, fr, fq, lds, wid, lane); S.done(cur); }
#undef PG8_SA
#undef PG8_SB
#undef PG8_STAGE
#undef PG8_LDA
#undef PG8_LDB
#undef PG8_MMA
#undef PG8_WAIT_V
#undef PG8_WAIT_L
#undef PG8_BAR
#undef PG8_SCHED
}
}
#ifndef PG8_SP2
#define PG8_SP2 true
#endif
#ifndef PG8_ALIGN
#define PG8_ALIGN true
#endif
#ifndef MK_LAUNCHES
#define MK_LAUNCHES 1
#endif

constexpr int NWAVES = 8;
constexpr int SEQ = 16384, DM = 1024, DFF = 2816, DCONV = 512, DATT = 512, NH = 8, NG = 2, HPG = 4, HD = 64;
constexpr int DIN = 2328, DIN_PAD = 2560, NCMP = 1023, CONVW = 31, CMP_HID = 128, NSLC = 256, NTOP = 16, WIN = 512;
constexpr float EPS = 1e-6f;
constexpr int N_PHASES = 13;
enum { I_X = 0, I_C, I_WADA, I_BADA, I_GFFN1, I_WGU1, I_WD1, I_GMIX, I_WIN, I_WDW, I_BDW, I_LNG, I_LNB, I_PEK, I_PEV, I_WCK1, I_WCK2, I_WCV1, I_WCV2, I_RELB, I_WOUT, I_GFFN2, I_WGU2, I_WD2, I_GFIN, N_IN };

constexpr size_t MiB = 1u << 20;
constexpr size_t WS_CTL = 0, CTL_ZERO_BYTES = 64 * 1024;
constexpr size_t WS_MODP = 1 * MiB;
constexpr size_t WS_MOD = WS_MODP + 16 * 9216 * 4;
constexpr size_t WS_KCMP = 2 * MiB, WS_VCMP = WS_KCMP + 256 * 1024;
constexpr size_t WS_WGU1 = 4 * MiB, WS_WD1 = 15 * MiB, WS_WIN = 21 * MiB, WS_WOUT = 26 * MiB, WS_WGU2 = 28 * MiB, WS_WD2 = 39 * MiB;
constexpr size_t WS_GT = 45 * MiB;
constexpr size_t WS_HB = 48 * MiB;
constexpr size_t WS_XB = 80 * MiB;
constexpr size_t WS_ACT = 144 * MiB;
constexpr size_t WS_HG = WS_ACT, WS_Q = WS_ACT + 16 * MiB, WS_KV = WS_ACT + 32 * MiB;
constexpr size_t WS_END = 232 * MiB;
static_assert(WS_WD2 + (size_t)DM * DFF * 2 <= WS_GT && WS_GT + (size_t)SEQ * 24 * 4 <= WS_HB && WS_KV + (size_t)SEQ * 768 * 2 <= WS_END && WS_ACT + (size_t)SEQ * DFF * 2 <= WS_END, "d_ws map");
constexpr int CW_BAR = 4096;
constexpr int RING_OFF = 0, RING_BYTES = 131072;
constexpr int LDS_BYTES = 163840;
constexpr int LDSCTL_OFF = LDS_BYTES - 1024, MISC_OFF = LDSCTL_OFF + 320;

#define GAS __attribute__((address_space(1)))
#define LAS __attribute__((address_space(3)))
typedef unsigned short bf16;
typedef unsigned v4u __attribute__((ext_vector_type(4)));
typedef unsigned v2u __attribute__((ext_vector_type(2)));
typedef float f32x4 __attribute__((ext_vector_type(4)));
typedef float f32x2 __attribute__((ext_vector_type(2)));
typedef short bf16x8 __attribute__((ext_vector_type(8)));
typedef GAS unsigned gu32;
#define RLX_AGENT __ATOMIC_RELAXED, __HIP_MEMORY_SCOPE_AGENT
__device__ __forceinline__ unsigned f2bf(float f) { unsigned u = __builtin_bit_cast(unsigned, f); return (u + 0x7fffu + ((u >> 16) & 1u)) >> 16; }
__device__ __forceinline__ unsigned pk2(float lo, float hi) { return f2bf(lo) | (f2bf(hi) << 16); }
__device__ __forceinline__ float bflo(unsigned w) { return __uint_as_float(w << 16); }
__device__ __forceinline__ float bfhi(unsigned w) { return __uint_as_float(w & 0xffff0000u); }
__device__ __forceinline__ float bf2f(bf16 b) { return __uint_as_float((unsigned)b << 16); }
__device__ __forceinline__ float sigmoid_f(float x) { return __builtin_amdgcn_rcpf(1.0f + __builtin_amdgcn_exp2f(-1.4426950408889634f * x)); }
__device__ __forceinline__ float silu_f(float x) { return x * sigmoid_f(x); }
__device__ __forceinline__ float wave_sum(float v) {
#pragma unroll
    for (int o = 1; o < 64; o <<= 1) v += __shfl_xor(v, o);
    return v;
}
__device__ __forceinline__ float wave_max(float v) {
#pragma unroll
    for (int o = 1; o < 64; o <<= 1) v = fmaxf(v, __shfl_xor(v, o));
    return v;
}

#define XB_TMO      128
#define XB_XCNT(j)  (256  + 64 * (j))
#define XB_XSUB(j)  (1280 + 64 * (j))
#define XB_XGEN(j)  (2304 + 64 * (j))
#define XB_TOP      3328
#define XB_TOPGEN   3392
#define XCD_BAR_WORDS 3456
#define XB_SPIN_CAP (1u << 18)
static_assert((CW_BAR + XCD_BAR_WORDS) * 4 <= (int)CTL_ZERO_BYTES, "barrier words inside the memset region");

__device__ __forceinline__ unsigned xb_ld(unsigned* p)              { return __hip_atomic_load(p, __ATOMIC_RELAXED, __HIP_MEMORY_SCOPE_AGENT); }
__device__ __forceinline__ unsigned xb_add(unsigned* p, unsigned v) { return __hip_atomic_fetch_add(p, v, __ATOMIC_RELAXED, __HIP_MEMORY_SCOPE_AGENT); }
__device__ __forceinline__ unsigned xb_xcc_id() { return (unsigned)__builtin_amdgcn_s_getreg((3 << 11) | 20) & 0xFu; }
#define XB_SPIN(cond, bar) do { unsigned _sp = 0; while (cond) { __builtin_amdgcn_s_sleep(1); \
    if ((++_sp & 255u) == 0u) { if (xb_ld(&(bar)[XB_TMO])) break; if (_sp > XB_SPIN_CAP) { atomicAdd(&(bar)[XB_TMO], 1u); break; } } } } while (0)

struct XcdBarrier {
    unsigned* bar; unsigned x;
    volatile LAS unsigned* st;
};
__device__ __forceinline__ XcdBarrier xcd_barrier_post(unsigned* bar, volatile LAS unsigned* st) {
    XcdBarrier b; b.bar = bar; b.x = xb_xcc_id(); b.st = st;
    if (threadIdx.x == 0) (void)xb_add(&bar[XB_XCNT(b.x)], 1u);
    return b;
}
__device__ __forceinline__ void xcd_barrier_complete(unsigned* bar, unsigned x, unsigned& nloc, unsigned& nx) {
    const unsigned G = gridDim.x * gridDim.y * gridDim.z;
    unsigned sum, cnt, mine, sp = 0u;
    for (;;) {
        sum = 0u; cnt = 0u; mine = 0u;
#pragma unroll
        for (unsigned j = 0; j < 16; ++j) { const unsigned c = xb_ld(&bar[XB_XCNT(j)]); sum += c; cnt += (c > 0u) ? 1u : 0u; mine = (j == x) ? c : mine; }
        if (sum == G) break;
        __builtin_amdgcn_s_sleep(1);
        if ((++sp & 255u) == 0u) { if (xb_ld(&bar[XB_TMO])) break; if (sp > XB_SPIN_CAP) { atomicAdd(&bar[XB_TMO], 1u); break; } }
    }
    nloc = mine > 0u ? mine : 1u; nx = cnt > 0u ? cnt : 1u;
}
__device__ __forceinline__ void xcd_barrier(const XcdBarrier& b) {
    asm volatile("s_waitcnt vmcnt(0)" ::: "memory");
    __syncthreads();
    if (threadIdx.x == 0) {
        unsigned* bar = b.bar;
        __builtin_amdgcn_s_waitcnt(0);
        unsigned nloc = b.st[0], nx = b.st[1];
        if (nloc == 0u) { xcd_barrier_complete(bar, b.x, nloc, nx); b.st[0] = nloc; b.st[1] = nx; }
        const unsigned old = xb_add(&bar[XB_XSUB(b.x)], 1u);
        const unsigned gen = old / nloc;
        if (old + 1u == (gen + 1u) * nloc) {
            __builtin_amdgcn_fence(__ATOMIC_RELEASE, "agent");
            asm volatile("s_waitcnt vmcnt(0)" ::: "memory");
            const unsigned og = xb_add(&bar[XB_TOP], 1u);
            const unsigned tg = og / nx;
            if (og + 1u == (tg + 1u) * nx) xb_add(&bar[XB_TOPGEN], 1u);
            else XB_SPIN(xb_ld(&bar[XB_TOPGEN]) == tg, bar);
            __builtin_amdgcn_fence(__ATOMIC_ACQUIRE, "agent");
            xb_add(&bar[XB_XGEN(b.x)], 1u);
            asm volatile("s_waitcnt vmcnt(0)" ::: "memory");
        } else {
            XB_SPIN(xb_ld(&bar[XB_XGEN(b.x)]) == gen, bar);
            __builtin_amdgcn_fence(__ATOMIC_ACQUIRE, "agent");
            asm volatile("s_waitcnt vmcnt(0)" ::: "memory");
        }
    }
    __syncthreads();
}

struct Args { const float* in[N_IN]; float* out; unsigned char* ws; int ph_lo, ph_hi, probe, pad; };
static_assert(sizeof(Args) == (N_IN + 2) * 8 + 16, "Args has no padding");
struct Frame {
    LAS unsigned char* lds;
    int tid, lane, wave, G, bid;
};
#define WSP(T, off) ((T*)(a.ws + (off)))

__device__ const unsigned char T5_BUCKET[128] = {0, 1, 2, 3, 4, 5, 6, 7, 8, 9, 10, 11, 12, 13, 14, 15, 16, 16, 16, 17, 17, 18, 18, 18, 19, 19, 19, 20, 20, 20, 20, 21, 21, 21, 21, 22, 22, 22, 22, 22, 23, 23, 23, 23, 23, 23, 24, 24, 24, 24, 24, 24, 25, 25, 25, 25, 25, 25, 25, 26, 26, 26, 26, 26, 26, 26, 26, 27, 27, 27, 27, 27, 27, 27, 27, 27, 27, 28, 28, 28, 28, 28, 28, 28, 28, 28, 28, 29, 29, 29, 29, 29, 29, 29, 29, 29, 29, 29, 29, 30, 30, 30, 30, 30, 30, 30, 30, 30, 30, 30, 30, 30, 30, 31, 31, 31, 31, 31, 31, 31, 31, 31, 31, 31, 31, 31, 31, 31};
__host__ __device__ __forceinline__ int vt_perm(int r) { return (r & 32) + 8 * ((r >> 2) & 3) + 4 * ((r >> 4) & 1) + (r & 3); }
__host__ __device__ __forceinline__ int vt_iperm(int p) { return (p & 32) + 16 * ((p >> 2) & 1) + 4 * ((p >> 3) & 3) + (p & 3); }
constexpr int CW_KMAX = 1024;
constexpr size_t WS_VT2 = 200 * MiB;
constexpr size_t WS_VCT = 208 * MiB;
static_assert(WS_VCT + 2 * 16 * 64 * 64 * 2 <= WS_END, "ws map (attention prep)");
template <int MODE> __device__ __forceinline__ int wt_row0(int n0) {
    if (MODE == 1) { const int isu = n0 >= DFF ? 1 : 0, c = n0 - isu * DFF; return 256 * (c >> 7) + 128 * isu + (c & 127); }
    if (MODE == 2) { if (n0 < 512) return 256 * (n0 >> 7) + (n0 & 127); if (n0 < 1024) { const int c = n0 - 512; return 256 * (c >> 7) + 128 + (c & 127); } return n0; }
    return n0;
}
template <int MODE> __device__ __forceinline__ void p0_transpose_item(const float* W, int K, int N, bf16* WT, LAS float* scr, int item, int lane) {
    const int nblk = (N + 31) / 32, kb = item / nblk, nb = item % nblk, k0 = 64 * kb, n0 = 32 * nb;
    const int nn = n0 + (lane & 31); const bool okn = nn < N;
#pragma unroll 8
    for (int i = 0; i < 32; ++i) { const int kk = 2 * i + (lane >> 5); scr[kk * 33 + (lane & 31)] = okn ? W[(size_t)(k0 + kk) * N + nn] : 0.f; }
    asm volatile("s_waitcnt lgkmcnt(0)" ::: "memory");
    const int c = lane & 7, r0 = wt_row0<MODE>(n0);
#pragma unroll
    for (int j = 0; j < 4; ++j) { const int n = (lane >> 3) + 8 * j; const LAS float* s = scr + (8 * c) * 33 + n;
        v4u o; o.x = pk2(s[0 * 33], s[1 * 33]); o.y = pk2(s[2 * 33], s[3 * 33]); o.z = pk2(s[4 * 33], s[5 * 33]); o.w = pk2(s[6 * 33], s[7 * 33]);
        *(v4u*)(WT + (size_t)(r0 + n) * K + k0 + 8 * c) = o; }
    asm volatile("s_waitcnt lgkmcnt(0)" ::: "memory");
}
__device__ __forceinline__ void p0_prologue(const Args& a, const Frame& F) {
    LAS float* scr = (LAS float*)(F.lds + RING_OFF + F.wave * 16384);
    const int gw = F.bid * NWAVES + F.wave, NGW = F.G * NWAVES;
    constexpr int I_GU = (DM / 64) * (2 * DFF / 32), I_D = (DFF / 64) * (DM / 32), I_IN = (DM / 64) * ((DIN + 31) / 32), I_O = (DM / 64) * (DM / 32);
    constexpr int I_MOD = 144 * 16, I_PAD = (DIN_PAD - 2336) * DM / 8 / 64;
    constexpr int NITEMS = 2 * I_GU + 2 * I_D + I_IN + I_O + I_MOD + I_PAD;
    for (int it = gw; it < NITEMS; it += NGW) {
        int r = it;
        if (r < I_MOD) {
            const int cg = r >> 4, kc = r & 15; const float* W = a.in[I_WADA] + (size_t)(kc * 64) * 9216 + cg * 64 + F.lane; const float* cv = a.in[I_C] + kc * 64;
            float s = 0.f;
#pragma unroll 16
            for (int k = 0; k < 64; ++k) s += silu_f(cv[k]) * W[(size_t)k * 9216];
            WSP(float, WS_MODP)[kc * 9216 + cg * 64 + F.lane] = s; continue; }
        r -= I_MOD;
        if (r < I_GU) { p0_transpose_item<1>(a.in[I_WGU1], DM, 2 * DFF, WSP(bf16, WS_WGU1), scr, r, F.lane); continue; } r -= I_GU;
        if (r < I_GU) { p0_transpose_item<1>(a.in[I_WGU2], DM, 2 * DFF, WSP(bf16, WS_WGU2), scr, r, F.lane); continue; } r -= I_GU;
        if (r < I_D) { p0_transpose_item<0>(a.in[I_WD1], DFF, DM, WSP(bf16, WS_WD1), scr, r, F.lane); continue; } r -= I_D;
        if (r < I_D) { p0_transpose_item<0>(a.in[I_WD2], DFF, DM, WSP(bf16, WS_WD2), scr, r, F.lane); continue; } r -= I_D;
        if (r < I_IN) { p0_transpose_item<2>(a.in[I_WIN], DM, DIN, WSP(bf16, WS_WIN), scr, r, F.lane); continue; } r -= I_IN;
        if (r < I_O) { p0_transpose_item<0>(a.in[I_WOUT], DM, DM, WSP(bf16, WS_WOUT), scr, r, F.lane); continue; } r -= I_O;
        { v4u* p = (v4u*)(WSP(bf16, WS_WIN) + (size_t)2336 * DM) + (size_t)r * 64 + F.lane; *p = (v4u){0u, 0u, 0u, 0u}; }
    }
}
template <bool FROM_PARTIALS> __device__ __forceinline__ void norm_mod_pass(const Args& a, const Frame& F, const float* src, bf16* dst, const float* gvec, int sub) {
    LAS float* CA = (LAS float*)(F.lds + RING_OFF); LAS float* CB = CA + DM;
    const float* modp = WSP(const float, WS_MODP); float* mod = WSP(float, WS_MOD); const float* bada = a.in[I_BADA];
    if (FROM_PARTIALS) {
        for (int i = F.bid * 512 + F.tid; i < 9216; i += F.G * 512) { float s = bada[i];
#pragma unroll
            for (int k = 0; k < 16; ++k) s += modp[k * 9216 + i];
            mod[i] = s; }
    }
    for (int c = F.tid; c < 2 * DM; c += 512) {
        const int i = 3 * sub * DM + c; float s;
        if (FROM_PARTIALS) { s = bada[i];
#pragma unroll
            for (int k = 0; k < 16; ++k) s += modp[k * 9216 + i]; }
        else s = mod[i];
        if (c < DM) CB[c] = s; else CA[c - DM] = gvec[c - DM] * (1.0f + s);
    }
    __syncthreads();
    const int gw = F.bid * NWAVES + F.wave, NGW = F.G * NWAVES;
    for (int m = gw; m < SEQ; m += NGW) {
        const f32x4* xr = (const f32x4*)(src + (size_t)m * DM) + F.lane;
        f32x4 v[4]; float s = 0.f;
#pragma unroll
        for (int j = 0; j < 4; ++j) { v[j] = xr[64 * j]; s += (v[j].x * v[j].x + v[j].y * v[j].y) + (v[j].z * v[j].z + v[j].w * v[j].w); }
        const float rstd = 1.0f / sqrtf(wave_sum(s) * (1.0f / DM) + EPS);
        unsigned long long* o8 = (unsigned long long*)(dst + (size_t)m * DM) + F.lane;
#pragma unroll
        for (int j = 0; j < 4; ++j) { const f32x4 ca = *(const LAS f32x4*)(CA + 256 * j + 4 * F.lane), cb = *(const LAS f32x4*)(CB + 256 * j + 4 * F.lane);
            const f32x4 h = v[j] * rstd * ca + cb;
            o8[64 * j] = (unsigned long long)pk2(h.x, h.y) | ((unsigned long long)pk2(h.z, h.w) << 32); }
    }
    __syncthreads();
}
__device__ __forceinline__ void final_norm_pass(const Args& a, const Frame& F) {
    const int gw = F.bid * NWAVES + F.wave, NGW = F.G * NWAVES; const float* g = a.in[I_GFIN];
    f32x4 gv[4];
#pragma unroll
    for (int j = 0; j < 4; ++j) gv[j] = *((const f32x4*)g + 64 * j + F.lane);
    for (int m = gw; m < SEQ; m += NGW) {
        f32x4* xr = (f32x4*)(a.out + (size_t)m * DM) + F.lane;
        f32x4 v[4]; float s = 0.f;
#pragma unroll
        for (int j = 0; j < 4; ++j) { v[j] = xr[64 * j]; s += (v[j].x * v[j].x + v[j].y * v[j].y) + (v[j].z * v[j].z + v[j].w * v[j].w); }
        const float rstd = 1.0f / sqrtf(wave_sum(s) * (1.0f / DM) + EPS);
#pragma unroll
        for (int j = 0; j < 4; ++j) xr[64 * j] = v[j] * rstd * gv[j];
    }
}
__device__ __forceinline__ void conv_phase(const Args& a, const Frame& F) {
    LAS float* WL = (LAS float*)(F.lds + RING_OFF);
    for (int i = F.tid; i < CONVW * DCONV; i += 512) WL[i] = a.in[I_WDW][i];
    __syncthreads();
    const bf16* HG = WSP(const bf16, WS_HG); bf16* Y = WSP(bf16, WS_HB);
    const int gw = F.bid * NWAVES + F.wave, NGW = F.G * NWAVES, c0 = 8 * F.lane;
    float bd[8], lg[8], lb[8];
#pragma unroll
    for (int e = 0; e < 8; ++e) { bd[e] = a.in[I_BDW][c0 + e]; lg[e] = a.in[I_LNG][c0 + e]; lb[e] = a.in[I_LNB][c0 + e]; }
    for (int t = gw; t < SEQ; t += NGW) {
        float acc[8];
#pragma unroll
        for (int e = 0; e < 8; ++e) acc[e] = bd[e];
        for (int k = 0; k < CONVW; ++k) { const int tt = t - (CONVW - 1) + k; if (tt < 0) continue;
            const v4u h = *(const v4u*)(HG + (size_t)tt * DCONV + c0); const LAS float* w = WL + k * DCONV + c0;
            const f32x4 w0 = *(const LAS f32x4*)w, w1 = *(const LAS f32x4*)(w + 4);
            acc[0] += bflo(h.x) * w0.x; acc[1] += bfhi(h.x) * w0.y; acc[2] += bflo(h.y) * w0.z; acc[3] += bfhi(h.y) * w0.w;
            acc[4] += bflo(h.z) * w1.x; acc[5] += bfhi(h.z) * w1.y; acc[6] += bflo(h.w) * w1.z; acc[7] += bfhi(h.w) * w1.w; }
        float s = 0.f;
#pragma unroll
        for (int e = 0; e < 8; ++e) s += acc[e];
        const float mu = wave_sum(s) * (1.0f / DCONV); float q = 0.f;
#pragma unroll
        for (int e = 0; e < 8; ++e) { acc[e] -= mu; q += acc[e] * acc[e]; }
        const float rstd = 1.0f / sqrtf(wave_sum(q) * (1.0f / DCONV) + EPS);
        float o[8];
#pragma unroll
        for (int e = 0; e < 8; ++e) o[e] = silu_f(acc[e] * rstd * lg[e] + lb[e]);
        v4u w; w.x = pk2(o[0], o[1]); w.y = pk2(o[2], o[3]); w.z = pk2(o[4], o[5]); w.w = pk2(o[6], o[7]);
        *(v4u*)(Y + (size_t)t * DM + c0) = w;
    }
    __syncthreads();
}
__device__ __forceinline__ void compress_phase(const Args& a, const Frame& F) {
    LAS bf16* SL = (LAS bf16*)(F.lds + RING_OFF);
    LAS float* PH = (LAS float*)(F.lds + RING_OFF + 36864);
    LAS float* HID = (LAS float*)(F.lds + RING_OFF + 36864 + 65536);
    const bf16* KV = WSP(const bf16, WS_KV);
    for (int task = F.bid; task < 256; task += F.G) {
        const int which = task >> 7, g = (task >> 6) & 1, ng = task & 63, n0 = 16 * ng;
        const float* pe = a.in[which ? I_PEV : I_PEK]; const float* w1 = a.in[which ? I_WCV1 : I_WCK1]; const float* w2 = a.in[which ? I_WCV2 : I_WCK2];
        bf16* OUT = WSP(bf16, WS_KCMP);
        const int coff = which * 128 + g * 64;
        for (int i = F.tid; i < 272 * 8; i += 512) { const int tok = 16 * n0 + (i >> 3), ch = i & 7;
            v4u v = (v4u){0u, 0u, 0u, 0u}; if (tok < SEQ) v = *(const v4u*)(KV + (size_t)tok * 768 + coff + ch * 8);
            *(LAS v4u*)(SL + (i >> 3) * 64 + ch * 8) = v; }
        __syncthreads();
        float acc[16][2];
#pragma unroll
        for (int r = 0; r < 16; ++r) { acc[r][0] = 0.f; acc[r][1] = 0.f; }
        for (int li = 0; li < 4; ++li) { const int l = 4 * F.wave + li;
            for (int d = 0; d < 64; ++d) {
                const float wa = w1[(size_t)(l * 64 + d) * CMP_HID + F.lane], wb = w1[(size_t)(l * 64 + d) * CMP_HID + 64 + F.lane], pv = pe[l * 64 + d];
#pragma unroll
                for (int r = 0; r < 16; ++r) { const float x = bf2f(SL[(16 * r + l) * 64 + d]) + pv; acc[r][0] += x * wa; acc[r][1] += x * wb; }
            } }
#pragma unroll
        for (int r = 0; r < 16; ++r) { PH[(F.wave * 16 + r) * 128 + F.lane] = acc[r][0]; PH[(F.wave * 16 + r) * 128 + 64 + F.lane] = acc[r][1]; }
        __syncthreads();
        for (int i = F.tid; i < 16 * 128; i += 512) { float s = 0.f;
#pragma unroll
            for (int w = 0; w < 8; ++w) s += PH[w * 2048 + i];
            HID[i] = silu_f(s); }
        __syncthreads();
        for (int i = F.tid; i < 16 * 64; i += 512) { const int r = i >> 6, e = i & 63; float s = 0.f;
            for (int j = 0; j < CMP_HID; ++j) s += HID[r * 128 + j] * w2[j * 64 + e];
            const int n = n0 + r; const unsigned ob = n < NCMP ? f2bf(s) : 0u;
            if (which == 0) { OUT[(size_t)n * 128 + g * 64 + e] = (bf16)ob; const float v = __uint_as_float(ob << 16), nn = wave_sum(v * v);
                if (F.lane == 0) atomicMax(WSP(unsigned, WS_CTL) + CW_KMAX + g, __float_as_uint(nn)); }
            else WSP(bf16, WS_VCT)[(size_t)((g * 16 + (n >> 6)) * 64 + e) * 64 + vt_perm(n & 63)] = (bf16)ob; }
        __syncthreads();
    }
}
__device__ __forceinline__ void kv_prep_phase(const Args& a, const Frame& F) {
    const bf16* KV = WSP(const bf16, WS_KV); bf16* VT = WSP(bf16, WS_VT2);
    LAS bf16* T = (LAS bf16*)(F.lds + RING_OFF + F.wave * 8704);
    const int gw = F.bid * NWAVES + F.wave, NGW = F.G * NWAVES, lane = F.lane;
    for (int task = gw; task < 2 * 2 * 256; task += NGW) {
        const int tv = task >> 9, g = (task >> 8) & 1, j = task & 255, voff = (tv ? 640 : 384) + g * 64;
#pragma unroll
        for (int it = 0; it < 8; ++it) { const int r = it * 8 + (lane >> 3), c = lane & 7;
            const v4u v = *(const v4u*)(KV + (size_t)(64 * j + r) * 768 + voff + 8 * c);
            LAS unsigned* d = (LAS unsigned*)(T + r * 68 + 8 * c); d[0] = v.x; d[1] = v.y; d[2] = v.z; d[3] = v.w; }
        asm volatile("s_waitcnt lgkmcnt(0)" ::: "memory");
        bf16* O = VT + (size_t)((tv * 2 + g) * 256 + j) * 4096;
#pragma unroll
        for (int it = 0; it < 8; ++it) { const int d = it * 8 + (lane >> 3), c = lane & 7; unsigned w[4];
#pragma unroll
            for (int e = 0; e < 4; ++e) { const int r0 = vt_iperm(8 * c + 2 * e), r1 = vt_iperm(8 * c + 2 * e + 1); w[e] = (unsigned)T[r0 * 68 + d] | ((unsigned)T[r1 * 68 + d] << 16); }
            *(v4u*)(O + d * 64 + 8 * c) = (v4u){w[0], w[1], w[2], w[3]}; }
        asm volatile("s_waitcnt lgkmcnt(0)" ::: "memory");
    }
    unsigned* kmx = WSP(unsigned, WS_CTL) + CW_KMAX;
    for (int task = gw; task < 4 * (SEQ / 64); task += NGW) {
        const int wh = task & 3, tb = task >> 2, tok = tb * 64 + lane;
        const v4u* p = (const v4u*)(KV + (size_t)tok * 768 + (wh >> 1 ? 512 : 256) + (wh & 1) * 64); float s = 0.f;
#pragma unroll
        for (int c = 0; c < 8; ++c) { const v4u w = p[c]; s += bflo(w.x) * bflo(w.x) + bfhi(w.x) * bfhi(w.x) + bflo(w.y) * bflo(w.y) + bfhi(w.y) * bfhi(w.y) + bflo(w.z) * bflo(w.z) + bfhi(w.z) * bfhi(w.z) + bflo(w.w) * bflo(w.w) + bfhi(w.w) * bfhi(w.w); }
        s = wave_max(s);
        if (lane == 0) atomicMax(kmx + 2 + wh, __float_as_uint(s));
    }
    __syncthreads();
}
constexpr float LOG2E = 1.4426950408889634f;
constexpr int A2_IMP = 0;
constexpr int A2_MB = 65536;
constexpr int A2_SELB = A2_MB + 3072;
constexpr int A2_BL = A2_SELB + 2048;
constexpr int A2_STG = A2_BL + 2048;
constexpr int RB = 4, STG_V = 8192, STG_BUF = 16384;
constexpr int A2_END = A2_STG + RB * STG_BUF;
static_assert(A2_END <= MISC_OFF, "attention LDS map");
constexpr size_t WS_TOT = 212 * MiB;
static_assert(WS_TOT + (size_t)256 * 65536 <= WS_END && WS_VCT + 2 * 16 * 64 * 64 * 2 <= WS_TOT, "ws map (attention)");
typedef __attribute__((address_space(3))) float lds_f32;
#define DPP_F(v, ctrl) __builtin_bit_cast(float, __builtin_amdgcn_update_dpp(0, __builtin_bit_cast(int, (v)), (ctrl), 0xf, 0xf, false))
#define DPP_I(v, ctrl) __builtin_amdgcn_update_dpp(0, (v), (ctrl), 0xf, 0xf, false)

struct AttnFrag { bf16x8 k[4][2], v[4][2]; };
template <bool WITH_V> __device__ __forceinline__ void dma_issue(LAS unsigned char* buf, const bf16* Kblk, int kp, const bf16* VTblk, int wave, int lane) {
    const int row = 8 * wave + (lane >> 3), c = (lane & 7) ^ (row & 7);
    __builtin_amdgcn_global_load_lds((const unsigned*)(Kblk + (size_t)row * kp + c * 8), (LAS unsigned*)(buf + wave * 1024), 16, 0, 0);
    if (WITH_V) __builtin_amdgcn_global_load_lds((const unsigned*)(VTblk + row * 64 + c * 8), (LAS unsigned*)(buf + STG_V + wave * 1024), 16, 0, 0);
}
template <bool WITH_V> __device__ __forceinline__ void frag_from_lds(AttnFrag& f, const LAS unsigned char* buf, int col, int q4) {
    const int sw = col & 7;
#pragma unroll
    for (int kt = 0; kt < 4; ++kt)
#pragma unroll
        for (int ks = 0; ks < 2; ++ks) f.k[kt][ks] = *(const LAS bf16x8*)(buf + (16 * kt + col) * 128 + (((4 * ks + q4) ^ sw) * 16));
    if (WITH_V) {
#pragma unroll
        for (int dt = 0; dt < 4; ++dt)
#pragma unroll
            for (int ks = 0; ks < 2; ++ks) f.v[dt][ks] = *(const LAS bf16x8*)(buf + STG_V + (16 * dt + col) * 128 + (((4 * ks + q4) ^ sw) * 16));
    }
}
#define A2_WAITBAR(n) do { asm volatile("s_waitcnt vmcnt(" #n ")" ::: "memory"); __builtin_amdgcn_s_barrier(); asm volatile("" ::: "memory"); } while (0)
template <int BR> __device__ __forceinline__ void attn_probs(f32x4 (&st)[4], const AttnFrag& f, const bf16x8 (&qf)[2], const lds_f32* BLh, float Mb, int t, int kb, int q4, bool far_, bool lsel) {
#pragma unroll
    for (int kt = 0; kt < 4; ++kt) { f32x4 z = (f32x4){0.f, 0.f, 0.f, 0.f};
        z = __builtin_amdgcn_mfma_f32_16x16x32_bf16(f.k[kt][0], qf[0], z, 0, 0, 0); st[kt] = __builtin_amdgcn_mfma_f32_16x16x32_bf16(f.k[kt][1], qf[1], z, 0, 0, 0); }
    if (far_) { const float c = BLh[127] - Mb;
#pragma unroll
        for (int kt = 0; kt < 4; ++kt)
#pragma unroll
            for (int e = 0; e < 4; ++e) st[kt][e] = lsel ? __builtin_amdgcn_exp2f(st[kt][e] + c) : 0.f;
    } else {
#pragma unroll
        for (int kt = 0; kt < 4; ++kt)
#pragma unroll
            for (int e = 0; e < 4; ++e) { const int k = kb + 16 * kt + 4 * q4 + e; const int dist = BR < 2 ? t - 16 * k - 31 : t - k;
                const bool ok = lsel && dist >= 0 && (BR != 3 || dist < WIN);
                const int dc = dist < 0 ? 0 : (dist > 127 ? 127 : dist);
                const float p = __builtin_amdgcn_exp2f(st[kt][e] + BLh[dc] - Mb); st[kt][e] = ok ? p : 0.f; }
    }
}
struct AttnAcc { f32x4 o[2][4]; float l[2]; };
__device__ __forceinline__ void attn_acc_zero(AttnAcc& A) {
#pragma unroll
    for (int G = 0; G < 2; ++G) { A.l[G] = 0.f;
#pragma unroll
        for (int dt = 0; dt < 4; ++dt) A.o[G][dt] = (f32x4){0.f, 0.f, 0.f, 0.f}; }
}
template <int BR> __device__ __forceinline__ void attn_block2(AttnAcc& A, const AttnFrag& f, const bf16x8 (&qf)[2][2], const lds_f32* BLh, const float (&Mb)[2], const int (&tq)[2], int kb, int q4, bool far_, const bool (&gact)[2], const bool (&lsel)[2]) {
#pragma unroll
    for (int G = 0; G < 2; ++G) {
        if (!gact[G]) continue;
        f32x4 st[4];
        attn_probs<BR>(st, f, qf[G], BLh, Mb[G], tq[G], kb, q4, far_, lsel[G]);
        float ls = 0.f;
#pragma unroll
        for (int kt = 0; kt < 4; ++kt) ls += (st[kt][0] + st[kt][1]) + (st[kt][2] + st[kt][3]);
        A.l[G] += ls;
        bf16x8 pb[2];
#pragma unroll
        for (int ks = 0; ks < 2; ++ks) { v4u w; w.x = pg8::cvt_pk_bf16(st[2 * ks][0], st[2 * ks][1]); w.y = pg8::cvt_pk_bf16(st[2 * ks][2], st[2 * ks][3]);
            w.z = pg8::cvt_pk_bf16(st[2 * ks + 1][0], st[2 * ks + 1][1]); w.w = pg8::cvt_pk_bf16(st[2 * ks + 1][2], st[2 * ks + 1][3]); pb[ks] = __builtin_bit_cast(bf16x8, w); }
#pragma unroll
        for (int dt = 0; dt < 4; ++dt) { A.o[G][dt] = __builtin_amdgcn_mfma_f32_16x16x32_bf16(f.v[dt][0], pb[0], A.o[G][dt], 0, 0, 0); A.o[G][dt] = __builtin_amdgcn_mfma_f32_16x16x32_bf16(f.v[dt][1], pb[1], A.o[G][dt], 0, 0, 0); }
    }
}
template <int MODE> __device__ __forceinline__ void attn_fold(const AttnAcc& A, float* tot  , const float (&gate)[2], float (&il)[2], bf16* const (&yp)[2]) {
#pragma unroll
    for (int G = 0; G < 2; ++G) { float ls = A.l[G]; ls += __shfl_xor(ls, 16); ls += __shfl_xor(ls, 32);
        il[G] = 1.0f / fmaxf(ls, 1e-30f); const float sc = gate[G] * il[G];
#pragma unroll
        for (int dt = 0; dt < 4; ++dt) { f32x4* tp = (f32x4*)(tot + (G * 4 + dt) * 256); f32x4 v = A.o[G][dt] * sc;
            if (MODE != 0) v += *tp;
            if (MODE != 2) *tp = v;
            else { v2u w; w.x = pk2(v[0], v[1]); w.y = pk2(v[2], v[3]); *(v2u*)(yp[G] + 16 * dt) = w; } } }
}
__device__ __noinline__ void attn_topk(LAS unsigned char* L, int wave, int lane, int cur) {
    const lds_f32* IMP = (const lds_f32*)(L + A2_IMP); LAS unsigned* SELB = (LAS unsigned*)(L + A2_SELB);
    const int sub = lane & 15;
    for (int pass = 0; pass < 2; ++pass) {
        const int q = wave * 8 + pass * 4 + (lane >> 4);
        unsigned word = 0u;
        if (cur < 16) { if (sub == 0) word = (cur >= 31) ? 0xffffffffu : ((1u << (cur + 1)) - 1u); }
        else {
            float v[16];
#pragma unroll
            for (int i = 0; i < 16; ++i) { const int J = 16 * i + sub; v[i] = (J >= 1 && J <= cur - 2) ? IMP[q * 256 + J] : -1.0f; }
            for (int r = 0; r < 13; ++r) {
                float m = v[0];
#pragma unroll
                for (int i = 1; i < 16; ++i) m = fmaxf(m, v[i]);
                m = fmaxf(m, DPP_F(m, 0x128)); m = fmaxf(m, DPP_F(m, 0x124)); m = fmaxf(m, DPP_F(m, 0x122)); m = fmaxf(m, DPP_F(m, 0x121));
                int c = 999;
#pragma unroll
                for (int i = 15; i >= 0; --i) c = (v[i] == m) ? 16 * i + sub : c;
                { int o = DPP_I(c, 0x128); c = o < c ? o : c; o = DPP_I(c, 0x124); c = o < c ? o : c; o = DPP_I(c, 0x122); c = o < c ? o : c; o = DPP_I(c, 0x121); c = o < c ? o : c; }
#pragma unroll
                for (int i = 0; i < 16; ++i) v[i] = (16 * i + sub == c) ? -2.0f : v[i];
                if ((c >> 5) == sub) word |= 1u << (c & 31);
            }
            if (sub == 0) word |= 1u;
            if (((cur - 1) >> 5) == sub) word |= 1u << ((cur - 1) & 31);
            if ((cur >> 5) == sub) word |= 1u << (cur & 31);
        }
        if (sub < 8) SELB[q * 8 + sub] = word;
    }
}

__device__ __forceinline__ void attn2_phase(const Args& a, const Frame& F) {
    LAS unsigned char* L = F.lds + RING_OFF;
    const bf16* Q = WSP(const bf16, WS_Q); const bf16* KV = WSP(const bf16, WS_KV); const bf16* KC = WSP(const bf16, WS_KCMP);
    const bf16* VT = WSP(const bf16, WS_VT2); const bf16* VCT = WSP(const bf16, WS_VCT); const float* GT = WSP(const float, WS_GT); bf16* Y = WSP(bf16, WS_HB);
    const unsigned* kmx = WSP(const unsigned, WS_CTL) + CW_KMAX;
    const int tid = F.tid, lane = F.lane, wave = F.wave, col = lane & 15, q4 = lane >> 4, hh = col & 3;
    float* tot = WSP(float, WS_TOT) + (size_t)F.bid * 16384 + wave * 2048 + lane * 4;
    LAS unsigned char* STG = L + A2_STG;
    for (int uu0 = F.bid; uu0 < 2 * NSLC; uu0 += F.G) {
        const int rnd = uu0 / F.G, ix = uu0 - rnd * F.G;
        int cur, g;
        if (F.G == NSLC) { g = ix & 1; cur = rnd ? NSLC - 1 - (ix >> 1) : (ix >> 1); }
        else { cur = uu0 >> 1; g = uu0 & 1; }
        const int t0 = 64 * cur;
        const bf16* Qg = Q + (size_t)t0 * 512 + g * 256;
        lds_f32* BL = (lds_f32*)(L + A2_BL); lds_f32* MB = (lds_f32*)(L + A2_MB);
        { const int h = tid >> 7, d = tid & 127; BL[tid] = LOG2E * a.in[I_RELB][(g * 4 + h) * 32 + T5_BUCKET[d]]; }
        __syncthreads();
        {   const int q = tid >> 3, h = (tid & 7) >> 1, d0 = (tid & 1) * 32; const v4u* qp = (const v4u*)(Qg + (size_t)q * 512 + h * 64 + d0); float s = 0.f;
#pragma unroll
            for (int c = 0; c < 4; ++c) { const v4u w = qp[c]; s += bflo(w.x) * bflo(w.x) + bfhi(w.x) * bfhi(w.x) + bflo(w.y) * bflo(w.y) + bfhi(w.y) * bfhi(w.y) + bflo(w.z) * bflo(w.z) + bfhi(w.z) * bfhi(w.z) + bflo(w.w) * bflo(w.w) + bfhi(w.w) * bfhi(w.w); }
            s += __shfl_xor(s, 1); const float qn = sqrtf(s);
            float bm = -3.0e38f;
            for (int d = 0; d < 128; ++d) bm = fmaxf(bm, BL[h * 128 + d]);
            if ((tid & 1) == 0) {
#pragma unroll
                for (int b = 0; b < 3; ++b) MB[b * 256 + q * 4 + h] = qn * sqrtf(__uint_as_float(kmx[2 * b + g])) * 1.001f + bm + 0.5f; }
        }
        __syncthreads();
        const lds_f32* BLh = BL + hh * 128;
        bf16x8 qf[2][2]; int tq[2];
#pragma unroll
        for (int G = 0; G < 2; ++G) { const int q = wave * 8 + G * 4 + (col >> 2); tq[G] = t0 + q;
            const bf16* qp = Qg + (size_t)q * 512 + hh * 64 + 8 * q4; qf[G][0] = *(const bf16x8*)qp; qf[G][1] = *(const bf16x8*)(qp + 32); }
#define A2_LOADM(M, b) float M[2]; _Pragma("unroll") for (int G = 0; G < 2; ++G) M[G] = MB[(b) * 256 + (wave * 8 + G * 4 + (col >> 2)) * 4 + hh]
#define A2_LOADG(gv, b) float gv[2]; _Pragma("unroll") for (int G = 0; G < 2; ++G) gv[G] = GT[(size_t)(t0 + wave * 8 + G * 4 + (col >> 2)) * 24 + (g * 4 + hh) * 3 + (b)]
        const int twlo = t0 + 8 * wave, twhi = twlo + 7;
        const bool all2[2] = {true, true};
        const int tmax = t0 + 63, nvu = tmax >= 31 ? ((tmax - 31) >> 4) + 1 : 0, nbu = (nvu + 63) >> 6;
        float il[2];
        AttnFrag fc; AttnAcc A;
        A2_LOADM(Mc, 0);
        attn_acc_zero(A);
#define KC_BLK(j) (KC + (size_t)(64 * (j)) * 128 + g * 64)
#define VC_BLK(j) (VCT + (size_t)(g * 16 + (j)) * 4096)
        {   const int last = nbu - 1;
#pragma unroll
            for (int p = 0; p < RB - 1; ++p) { const int jb = p < last ? p : last; dma_issue<true>(STG + p * STG_BUF, KC_BLK(jb), 128, VC_BLK(jb), wave, lane); }
            for (int jc = 0; jc < nbu; ++jc) {
                A2_WAITBAR(4);
                { const int jn = jc + RB - 1 < last ? jc + RB - 1 : last; dma_issue<true>(STG + ((jc + RB - 1) % RB) * STG_BUF, KC_BLK(jn), 128, VC_BLK(jn), wave, lane); }
                if (twhi - 16 * (64 * jc) - 31 >= 0) { frag_from_lds<true>(fc, STG + (jc % RB) * STG_BUF, col, q4);
                    attn_block2<0>(A, fc, qf, BLh, Mc, tq, 64 * jc, q4, twlo - 16 * (64 * jc + 63) - 31 >= 113, all2, all2); }
            }
            A2_WAITBAR(0);
        }
        { A2_LOADG(gc, 0); bf16* const ypn[2] = {nullptr, nullptr}; attn_fold<0>(A, tot, gc, il, ypn); }
        __syncthreads();
        if (cur >= 16) {
            lds_f32* IMP = (lds_f32*)(L + A2_IMP);
            float carry[2] = {0.f, 0.f};
            const int last = nbu - 1;
#pragma unroll
            for (int p = 0; p < RB - 1; ++p) { const int jb = p < last ? p : last; dma_issue<false>(STG + p * STG_BUF, KC_BLK(jb), 128, nullptr, wave, lane); }
            for (int jc = 0; jc < nbu; ++jc) {
                A2_WAITBAR(2);
                { const int jn = jc + RB - 1 < last ? jc + RB - 1 : last; dma_issue<false>(STG + ((jc + RB - 1) % RB) * STG_BUF, KC_BLK(jn), 128, nullptr, wave, lane); }
                const LAS unsigned char* buf = STG + (jc % RB) * STG_BUF;
                if (twhi - 16 * (64 * jc) - 31 < 0) continue;
                frag_from_lds<false>(fc, buf, col, q4);
#pragma unroll
                for (int G = 0; G < 2; ++G) { f32x4 st[4];
                    attn_probs<1>(st, fc, qf[G], BLh, Mc[G], tq[G], 64 * jc, q4, twlo - 16 * (64 * jc + 63) - 31 >= 113, true);
                    float s4[4], rot[4];
#pragma unroll
                    for (int kt = 0; kt < 4; ++kt) { float x3 = st[kt][3] * il[G], x4 = (st[kt][0] + st[kt][1] + st[kt][2]) * il[G] + x3;
                        x4 += DPP_F(x4, 0xB1); x4 += DPP_F(x4, 0x4E); x3 += DPP_F(x3, 0xB1); x3 += DPP_F(x3, 0x4E); s4[kt] = x4;
                        rot[kt] = __shfl(x3, (lane + 48) & 63); }
                    const int q = wave * 8 + G * 4 + (col >> 2);
#pragma unroll
                    for (int kt = 0; kt < 4; ++kt) { const float prev = q4 > 0 ? rot[kt] : (kt > 0 ? rot[kt - 1] : carry[G]);
                        if (hh == 0) IMP[q * 256 + 16 * jc + 4 * kt + q4] = s4[kt] + prev; }
                    carry[G] = rot[3];
                }
            }
            A2_WAITBAR(0);
        }
        attn_topk(L, wave, lane, cur);
        {   const LAS unsigned* SELB = (const LAS unsigned*)(L + A2_SELB);
            A2_LOADM(Ms, 1);
            attn_acc_zero(A);
#define KS_BLK(j) (KV + (size_t)(64 * (j)) * 768 + 256 + g * 64)
#define VS_BLK(j) (VT + (size_t)((0 * 2 + g) * 256 + (j)) * 4096)
#pragma unroll
            for (int p = 0; p < RB - 1; ++p) { const int jb = p < cur ? p : cur; dma_issue<true>(STG + p * STG_BUF, KS_BLK(jb), 768, VS_BLK(jb), wave, lane); }
            for (int j = 0; j <= cur; ++j) {
                A2_WAITBAR(4);
                { const int jn = j + RB - 1 < cur ? j + RB - 1 : cur; dma_issue<true>(STG + ((j + RB - 1) % RB) * STG_BUF, KS_BLK(jn), 768, VS_BLK(jn), wave, lane); }
                const LAS unsigned char* buf = STG + (j % RB) * STG_BUF;
                bool lsel[2], gact[2];
#pragma unroll
                for (int G = 0; G < 2; ++G) { lsel[G] = (SELB[(wave * 8 + G * 4 + (col >> 2)) * 8 + (j >> 5)] >> (j & 31)) & 1u; gact[G] = __ballot(lsel[G]) != 0ull; }
                if (gact[0] || gact[1]) { frag_from_lds<true>(fc, buf, col, q4);
                    attn_block2<2>(A, fc, qf, BLh, Ms, tq, 64 * j, q4, twlo - (64 * j + 63) >= 113, gact, lsel); }
            }
            A2_WAITBAR(0);
            A2_LOADG(gs, 1); float il2[2]; bf16* const ypn[2] = {nullptr, nullptr}; attn_fold<1>(A, tot, gs, il2, ypn);
        }
        __syncthreads();
        {   const int jlo = cur >= 8 ? cur - 8 : 0;
            A2_LOADM(Mw, 2);
            attn_acc_zero(A);
#define KW_BLK(j) (KV + (size_t)(64 * (j)) * 768 + 512 + g * 64)
#define VW_BLK(j) (VT + (size_t)((1 * 2 + g) * 256 + (j)) * 4096)
#pragma unroll
            for (int p = 0; p < RB - 1; ++p) { const int jb = jlo + p < cur ? jlo + p : cur; dma_issue<true>(STG + p * STG_BUF, KW_BLK(jb), 768, VW_BLK(jb), wave, lane); }
            for (int j = jlo; j <= cur; ++j) {
                A2_WAITBAR(4);
                { const int jn = j + RB - 1 < cur ? j + RB - 1 : cur; dma_issue<true>(STG + ((j - jlo + RB - 1) % RB) * STG_BUF, KW_BLK(jn), 768, VW_BLK(jn), wave, lane); }
                const LAS unsigned char* buf = STG + ((j - jlo) % RB) * STG_BUF;
                if (64 * j <= twhi && 64 * j + 63 >= twlo - (WIN - 1)) { frag_from_lds<true>(fc, buf, col, q4);
                    attn_block2<3>(A, fc, qf, BLh, Mw, tq, 64 * j, q4, (twlo - (64 * j + 63) >= 113) && (twhi - 64 * j < WIN), all2, all2); }
            }
            A2_WAITBAR(0);
            A2_LOADG(gw, 2); float il2[2]; bf16* yp[2];
#pragma unroll
            for (int G = 0; G < 2; ++G) yp[G] = Y + (size_t)(t0 + wave * 8 + G * 4 + (col >> 2)) * DM + 512 + (g * 4 + hh) * 64 + 4 * q4;
            attn_fold<2>(A, tot, gw, il2, yp);
        }
        __syncthreads();
    }
}
__global__ void __launch_bounds__(NWAVES * 64, 2) fwd_kernel(Args a) {
    extern __shared__ __attribute__((aligned(16))) unsigned char lds[];
    Frame F;
    F.lds = (LAS unsigned char*)lds;
    F.tid = threadIdx.x; F.lane = F.tid & 63; F.wave = __builtin_amdgcn_readfirstlane(F.tid >> 6);
    F.G = gridDim.x; F.bid = blockIdx.x;
    volatile LAS unsigned* MISC = (volatile LAS unsigned*)(F.lds + MISC_OFF);
    for (int u = F.tid; u < (LDS_BYTES - LDSCTL_OFF) / 4; u += NWAVES * 64) ((LAS unsigned*)(F.lds + LDSCTL_OFF))[u] = 0u;
    __syncthreads();
    const int lo = a.ph_lo, hi = a.ph_hi;
    const bool multi = (hi - lo) > 1;
    unsigned* barw = WSP(unsigned, WS_CTL) + CW_BAR;
    XcdBarrier bar; bar.bar = barw; bar.x = 0; bar.st = MISC + 8;
    if (multi) bar = xcd_barrier_post(barw, MISC + 8);
#ifndef REP_MASK
#define REP_MASK 0
#endif
#define IN(k) (lo <= (k) && (k) < hi)
#define REPS(k) (((REP_MASK >> (k)) & 1) ? 2 : 1)
#define SEAM(k) do { if (IN(k) && IN((k) + 1)) xcd_barrier(bar); } while (0)
    PG8_LAS unsigned char* ring = F.lds + RING_OFF;

    if (IN(0)) for (int rep_ = 0; rep_ < REPS(0); ++rep_) { if (rep_) xcd_barrier(bar); p0_prologue(a, F); } SEAM(0);
    if (IN(1)) for (int rep_ = 0; rep_ < REPS(1); ++rep_) { if (rep_) xcd_barrier(bar); norm_mod_pass<true>(a, F, a.in[I_X], WSP(bf16, WS_HB), a.in[I_GFFN1], 0); } SEAM(1);
    if (IN(2)) for (int rep_ = 0; rep_ < REPS(2); ++rep_) { if (rep_) xcd_barrier(bar);
        pg8::Gemm g{WSP(const bf16, WS_HB), WSP(const bf16, WS_WGU1), SEQ, 2 * DFF, DM}; pg8::StaticOrder S; S.init(SEQ, 2 * DFF, F.G, F.bid);
        pg8::EpiSwiGLU E{WSP(bf16, WS_ACT), DFF};
        pg8::gemm_phase<pg8::EpiSwiGLU, pg8::StaticOrder, PG8_ALIGN, PG8_SP2>(ring, g, S, E);
    } SEAM(2);
    if (IN(3)) for (int rep_ = 0; rep_ < REPS(3); ++rep_) { if (rep_) xcd_barrier(bar);
        pg8::Gemm g{WSP(const bf16, WS_ACT), WSP(const bf16, WS_WD1), SEQ, DM, DFF}; pg8::StaticOrder S; S.init(SEQ, DM, F.G, F.bid);
        pg8::EpiResid E{a.in[I_X], WSP(float, WS_XB), DM, WSP(const float, WS_MOD) + 2 * DM, 0.5f};
        pg8::gemm_phase<pg8::EpiResid, pg8::StaticOrder, false, PG8_SP2>(ring, g, S, E);
    } SEAM(3);
    if (IN(4)) for (int rep_ = 0; rep_ < REPS(4); ++rep_) { if (rep_) xcd_barrier(bar); norm_mod_pass<false>(a, F, WSP(const float, WS_XB), WSP(bf16, WS_HB), a.in[I_GMIX], 1); } SEAM(4);
    if (IN(5)) for (int rep_ = 0; rep_ < REPS(5); ++rep_) { if (rep_) xcd_barrier(bar);
        pg8::Gemm g{WSP(const bf16, WS_HB), WSP(const bf16, WS_WIN), SEQ, DIN_PAD, DM}; pg8::StaticOrder S; S.init(SEQ, DIN_PAD, F.G, F.bid);
        pg8::EpiMix E{WSP(bf16, WS_HG), WSP(bf16, WS_Q), WSP(bf16, WS_KV), WSP(float, WS_GT)};
        pg8::gemm_phase<pg8::EpiMix, pg8::StaticOrder, PG8_ALIGN, PG8_SP2>(ring, g, S, E);
    } SEAM(5);
    if (IN(6)) for (int rep_ = 0; rep_ < REPS(6); ++rep_) { if (rep_) xcd_barrier(bar); conv_phase(a, F); kv_prep_phase(a, F); compress_phase(a, F); } SEAM(6);
    if (IN(7)) for (int rep_ = 0; rep_ < REPS(7); ++rep_) { if (rep_) xcd_barrier(bar); attn2_phase(a, F); } SEAM(7);
    if (IN(8)) for (int rep_ = 0; rep_ < REPS(8); ++rep_) { if (rep_) xcd_barrier(bar);
        pg8::Gemm g{WSP(const bf16, WS_HB), WSP(const bf16, WS_WOUT), SEQ, DM, DM}; pg8::StaticOrder S; S.init(SEQ, DM, F.G, F.bid);
        pg8::EpiResid E{WSP(const float, WS_XB), WSP(float, WS_XB), DM, WSP(const float, WS_MOD) + 5 * DM, 1.0f};
        pg8::gemm_phase<pg8::EpiResid, pg8::StaticOrder, false, PG8_SP2>(ring, g, S, E);
    } SEAM(8);
    if (IN(9)) for (int rep_ = 0; rep_ < REPS(9); ++rep_) { if (rep_) xcd_barrier(bar); norm_mod_pass<false>(a, F, WSP(const float, WS_XB), WSP(bf16, WS_HB), a.in[I_GFFN2], 2); } SEAM(9);
    if (IN(10)) for (int rep_ = 0; rep_ < REPS(10); ++rep_) { if (rep_) xcd_barrier(bar);
        pg8::Gemm g{WSP(const bf16, WS_HB), WSP(const bf16, WS_WGU2), SEQ, 2 * DFF, DM}; pg8::StaticOrder S; S.init(SEQ, 2 * DFF, F.G, F.bid);
        pg8::EpiSwiGLU E{WSP(bf16, WS_ACT), DFF};
        pg8::gemm_phase<pg8::EpiSwiGLU, pg8::StaticOrder, PG8_ALIGN, PG8_SP2>(ring, g, S, E);
    } SEAM(10);
    if (IN(11)) for (int rep_ = 0; rep_ < REPS(11); ++rep_) { if (rep_) xcd_barrier(bar);
        pg8::Gemm g{WSP(const bf16, WS_ACT), WSP(const bf16, WS_WD2), SEQ, DM, DFF}; pg8::StaticOrder S; S.init(SEQ, DM, F.G, F.bid);
        pg8::EpiResid E{WSP(const float, WS_XB), a.out, DM, WSP(const float, WS_MOD) + 8 * DM, 0.5f};
        pg8::gemm_phase<pg8::EpiResid, pg8::StaticOrder, false, PG8_SP2>(ring, g, S, E);
    } SEAM(11);
    if (IN(12)) for (int rep_ = 0; rep_ < REPS(12); ++rep_) { if (rep_) xcd_barrier(bar); final_norm_pass(a, F); }
#undef IN
#undef SEAM
}

extern "C" void kernel_launch(void* const* d_in, const int* in_sizes, int n_in, void* d_out, int out_size, void* d_ws, size_t ws_size, hipStream_t stream) {
    static int grid = 0;
    if (grid == 0) {
        if (n_in != N_IN || in_sizes[0] != SEQ * DM || out_size != SEQ * DM || ws_size < WS_END) { fprintf(stderr, "kernel_launch: unexpected problem shape (n_in %d, ws %zu); nothing launched\n", n_in, ws_size); grid = -1; return; }
        int dev = 0, cus = 0, per_cu = 0;
        if (hipGetDevice(&dev) != hipSuccess || hipDeviceGetAttribute(&cus, hipDeviceAttributeMultiprocessorCount, dev) != hipSuccess) { grid = -1; return; }
        if (hipFuncSetAttribute((const void*)fwd_kernel, hipFuncAttributeMaxDynamicSharedMemorySize, LDS_BYTES) != hipSuccess) { fprintf(stderr, "kernel_launch: hipFuncSetAttribute failed\n"); grid = -1; return; }
        if (hipOccupancyMaxActiveBlocksPerMultiprocessor(&per_cu, (const void*)fwd_kernel, NWAVES * 64, LDS_BYTES) != hipSuccess || per_cu < 1)
            fprintf(stderr, "kernel_launch: note: occupancy query reports %d workgroups per CU\n", per_cu);
        (void)hipGetLastError();
        grid = cus;
    }
    if (grid < 0) return;
    if (hipMemsetAsync((char*)d_ws + WS_CTL, 0, CTL_ZERO_BYTES, stream) != hipSuccess) return;
    Args a{};
    for (int i = 0; i < N_IN; ++i) a.in[i] = (const float*)d_in[i];
    a.out = (float*)d_out; a.ws = (unsigned char*)d_ws;
#ifdef PROBE_MODE
    a.probe = PROBE_MODE;
#endif
#if MK_LAUNCHES == 1
    a.ph_lo = 0; a.ph_hi = N_PHASES;
    hipLaunchKernelGGL(fwd_kernel, dim3(grid), dim3(NWAVES * 64), LDS_BYTES, stream, a);
#else
    for (int p = 0; p < N_PHASES; ++p) { a.ph_lo = p; a.ph_hi = p + 1; hipLaunchKernelGGL(fwd_kernel, dim3(grid), dim3(NWAVES * 64), LDS_BYTES, stream, a); }
#endif
}
```

```cpp
#include <hip/hip_runtime.h>
#include <cstdio>
#include <cstdint>
namespace pg8 {
#define PG8_LAS __attribute__((address_space(3)))
typedef unsigned short bf16_t;
typedef short bf16x8 __attribute__((ext_vector_type(8)));
typedef float f32x4 __attribute__((ext_vector_type(4)));
typedef unsigned u32x4 __attribute__((ext_vector_type(4)));
constexpr int BM = 256, BK = 64, HALF = 128, HTB = HALF * BK * 2  , STAGE_BYTES = 8 * HTB, NXCD = 8, WGM = 8;

__host__ __device__ __forceinline__ int lds_byte(int r, int c) { const int st = (r >> 4) * 2 + (c >> 5), rr = r & 15, cc = c & 31, ob = rr * 64 + cc * 2; return st * 1024 + (ob ^ (((ob >> 9) & 1) << 5)); }
__host__ __device__ __forceinline__ void stage_rc(int b, int& R, int& C) { const int st = b / 1024, sb = b % 1024, swz = sb ^ (((sb >> 9) & 1) << 5); R = (st >> 1) * 16 + swz / 64; C = (st & 1) * 32 + (swz % 64) / 2; }
__host__ __device__ __forceinline__ int perm32(int rho) { const int n = rho >> 4, i = rho & 15; return 8 * (i >> 2) + 4 * n + (i & 3); }

struct Unit { int pm, pn; };
struct Gemm { const bf16_t* A; const bf16_t* Bt; int M, N, K; };

struct StaticOrder {
    int nM, nN, nwg, G, c;
    __host__ __device__ void init(int M, int N, int G_, int c_) { nM = M / BM; nN = N / BM; nwg = nM * nN; G = G_; c = c_; }
    __host__ __device__ bool next(int i, Unit& u) const {
        const long L = (long)i * G + c; if (L >= nwg) return false;
        int wgid = (int)L; { const int q = nwg / NXCD, r = nwg % NXCD, xcd = wgid % NXCD, off = wgid / NXCD; wgid = (xcd < r ? xcd * (q + 1) : r * (q + 1) + (xcd - r) * q) + off; }
        const int nig = WGM * nN, gid = wgid / nig, fm = gid * WGM, gsz = (nM - fm) < WGM ? (nM - fm) : WGM;
        u.pm = fm + ((wgid % nig) % gsz); u.pn = (wgid % nig) / gsz; return true;
    }
    __device__ __forceinline__ void a_ready(const Unit&) const {}
    __device__ __forceinline__ void done(const Unit&) const {}
};


__device__ __forceinline__ unsigned cvt_pk_bf16(float lo, float hi) { unsigned r; asm volatile("v_cvt_pk_bf16_f32 %0, %1, %2" : "=v"(r) : "v"(lo), "v"(hi)); return r; }
__device__ __forceinline__ float sigmoid_f(float x) { return __builtin_amdgcn_rcpf(1.0f + __builtin_amdgcn_exp2f(-1.4426950408889634f * x)); }
__device__ __forceinline__ float silu_f(float x) { return x * sigmoid_f(x); }

template <bool GLU> __device__ __forceinline__ void gated_store(const f32x4 (&acc)[2][2][4][2], bf16_t* O, int ldc, int row0, int col0) {
#pragma unroll
    for (int ai = 0; ai < 2; ++ai)
#pragma unroll
        for (int m = 0; m < 4; ++m) { bf16_t* rowp = O + (size_t)(row0 + ai * HALF + m * 16) * ldc + col0;
            float v[8];
#pragma unroll
            for (int n = 0; n < 2; ++n)
#pragma unroll
                for (int e = 0; e < 4; ++e) { const float a = acc[ai][0][m][n][e], b = acc[ai][1][m][n][e]; v[n * 4 + e] = GLU ? a * sigmoid_f(b) : silu_f(a) * b; }
            u32x4 w; w.x = cvt_pk_bf16(v[0], v[1]); w.y = cvt_pk_bf16(v[2], v[3]); w.z = cvt_pk_bf16(v[4], v[5]); w.w = cvt_pk_bf16(v[6], v[7]);
            *(u32x4*)rowp = w; }
}
struct EpiSwiGLU {
    static constexpr bool PERM = true, AFTER_DRAIN = false;
    bf16_t* O; int ldc;
    __device__ __forceinline__ void operator()(const f32x4 (&acc)[2][2][4][2], const Unit& u, int wr, int wc, int fr, int fq) const {
        gated_store<false>(acc, O, ldc, u.pm * BM + wr * 64 + fr, u.pn * HALF + wc * 32 + 8 * fq);
    }
};
struct EpiResid {
    static constexpr bool PERM = false, AFTER_DRAIN = false;
    const float* base; float* out; int ldc; const float* gate; float scale;
    __device__ __forceinline__ void operator()(const f32x4 (&acc)[2][2][4][2], const Unit& u, int wr, int wc, int fr, int fq) const {
        const int col0 = u.pn * BM + wc * 32 + 4 * fq, row0 = u.pm * BM + wr * 64 + fr;
        f32x4 cf[2][2];
#pragma unroll
        for (int bj = 0; bj < 2; ++bj)
#pragma unroll
            for (int n = 0; n < 2; ++n) cf[bj][n] = *(const f32x4*)(gate + col0 + bj * HALF + n * 16) * scale;
#pragma unroll
        for (int ai = 0; ai < 2; ++ai)
#pragma unroll
            for (int m = 0; m < 4; ++m) { const size_t off = (size_t)(row0 + ai * HALF + m * 16) * ldc + col0;
#pragma unroll
                for (int bj = 0; bj < 2; ++bj)
#pragma unroll
                    for (int n = 0; n < 2; ++n) { const f32x4 bs = *(const f32x4*)(base + off + bj * HALF + n * 16); *(f32x4*)(out + off + bj * HALF + n * 16) = bs + cf[bj][n] * acc[ai][bj][m][n]; }
                if (m & 1) asm volatile("" ::: "memory"); }
    }
};
struct EpiMix {
    static constexpr bool PERM = true, AFTER_DRAIN = false;
    bf16_t* HG; bf16_t* Q; bf16_t* KV; float* GT;
    __device__ __forceinline__ void operator()(const f32x4 (&acc)[2][2][4][2], const Unit& u, int wr, int wc, int fr, int fq) const {
        const int row0 = u.pm * BM + wr * 64 + fr, c8 = wc * 32 + 8 * fq;
        if (u.pn < 4) { gated_store<true>(acc, HG, 512, row0, u.pn * HALF + c8); return; }
        if (u.pn == 9) {
            if (c8 < 24) {
#pragma unroll
                for (int ai = 0; ai < 2; ++ai)
#pragma unroll
                    for (int m = 0; m < 4; ++m) { float* rowp = GT + (size_t)(row0 + ai * HALF + m * 16) * 24 + c8;
#pragma unroll
                        for (int n = 0; n < 2; ++n) { const f32x4 a = acc[ai][0][m][n]; *(f32x4*)(rowp + 4 * n) = (f32x4){sigmoid_f(a[0]), sigmoid_f(a[1]), sigmoid_f(a[2]), sigmoid_f(a[3])}; } }
            }
            return;
        }
        bf16_t* O; int ldc, colt; float sc;
        if (u.pn < 6) { O = Q; ldc = 512; colt = (u.pn - 4) * BM; sc = 0.125f * 1.4426950408889634f; } else { O = KV; ldc = 768; colt = (u.pn - 6) * BM; sc = 1.0f; }
#pragma unroll
        for (int ai = 0; ai < 2; ++ai)
#pragma unroll
            for (int m = 0; m < 4; ++m) { bf16_t* rowp = O + (size_t)(row0 + ai * HALF + m * 16) * ldc + colt + c8;
#pragma unroll
                for (int bj = 0; bj < 2; ++bj) { const f32x4 v0 = acc[ai][bj][m][0] * sc, v1 = acc[ai][bj][m][1] * sc;
                    u32x4 w; w.x = cvt_pk_bf16(v0[0], v0[1]); w.y = cvt_pk_bf16(v0[2], v0[3]); w.z = cvt_pk_bf16(v1[0], v1[1]); w.w = cvt_pk_bf16(v1[2], v1[3]);
                    *(u32x4*)(rowp + bj * HALF) = w; } }
    }
};

template <class Epi, class Sched, bool ALIGN_EPI = false, bool SP2 = false>
__device__ __forceinline__ void gemm_phase(PG8_LAS unsigned char* lds, const Gemm g, const Sched& S, const Epi& E) {
    const int tid = threadIdx.x, wid = __builtin_amdgcn_readfirstlane(tid >> 6), lane = tid & 63, wr = wid >> 2, wc = wid & 3, fr = lane & 15, fq = lane >> 4;
    const int K = g.K, nt = K / BK;
    unsigned voffA[2], voffB[2];
#pragma unroll
    for (int i = 0; i < 2; ++i) { int R, C; stage_rc(tid * 16 + i * 8192, R, C); const int Rb = Epi::PERM ? ((R & ~31) + perm32(R & 31)) : R;
        voffA[i] = (unsigned)(R * K + C) * 2u; voffB[i] = (unsigned)(Rb * K + C) * 2u; }
    const size_t kstep = (size_t)(BK * 2);
    const size_t hstep = (size_t)HALF * K * 2;
    const size_t tstep = 2 * hstep;
    const unsigned ldsw = (unsigned)wid * 1024u;
    const int aoff = lds_byte(wr * 64 + fr, fq * 8), boff = lds_byte(wc * 32 + fr, fq * 8);
#define PG8_SA(b, h) (((b) * 2 + (h)) * HTB)
#define PG8_SB(b, h) ((4 + (b) * 2 + (h)) * HTB)
#define PG8_STAGE(bufoff, gbase, voff) do { _Pragma("unroll") for (int _i = 0; _i < 2; ++_i) \
        __builtin_amdgcn_global_load_lds((const unsigned*)((const char*)(gbase) + (voff)[_i]), (PG8_LAS unsigned*)(lds + (bufoff) + ldsw + _i * 8192), 16, 0, 0); } while (0)
#define PG8_LDA(dst, b, h) do { _Pragma("unroll") for (int m = 0; m < 4; ++m) _Pragma("unroll") for (int k = 0; k < 2; ++k) dst[m][k] = *(const PG8_LAS bf16x8*)(lds + PG8_SA(b, h) + aoff + m * 2048 + k * 1024); } while (0)
#define PG8_LDB(dst, b, h) do { _Pragma("unroll") for (int n = 0; n < 2; ++n) _Pragma("unroll") for (int k = 0; k < 2; ++k) dst[n][k] = *(const PG8_LAS bf16x8*)(lds + PG8_SB(b, h) + boff + n * 2048 + k * 1024); } while (0)
#define PG8_MMA(ai, bj, At, Bt) do { __builtin_amdgcn_s_setprio(1); _Pragma("unroll") for (int m = 0; m < 4; ++m) _Pragma("unroll") for (int n = 0; n < 2; ++n) _Pragma("unroll") for (int k = 0; k < 2; ++k) \
        acc[ai][bj][m][n] = __builtin_amdgcn_mfma_f32_16x16x32_bf16(Bt[n][k], At[m][k], acc[ai][bj][m][n], 0, 0, 0); __builtin_amdgcn_s_setprio(0); } while (0)
#define PG8_WAIT_V(n) asm volatile("s_waitcnt vmcnt(" #n ")" ::: "memory")
#define PG8_WAIT_L(n) asm volatile("s_waitcnt lgkmcnt(" #n ")" ::: "memory")
#define PG8_BAR __builtin_amdgcn_s_barrier()
#define PG8_SCHED __builtin_amdgcn_sched_barrier(0)
    Unit cur, nxt; int ui = 0;
    if (!S.next(0, cur)) return;
    f32x4 acc[2][2][4][2];
#pragma unroll
    for (int a = 0; a < 2; ++a)
#pragma unroll
        for (int b = 0; b < 2; ++b)
#pragma unroll
            for (int m = 0; m < 4; ++m)
#pragma unroll
                for (int n = 0; n < 2; ++n) acc[a][b][m][n] = (f32x4){0.f, 0.f, 0.f, 0.f};
    bf16x8 At[4][2], B0[2][2], B1[2][2];
    const char* cA = (const char*)g.A + (size_t)cur.pm * tstep; const char* cB = (const char*)g.Bt + (size_t)cur.pn * tstep;
    S.a_ready(cur);
    if constexpr (SP2) {
        PG8_STAGE(PG8_SB(0, 0), cB, voffB); PG8_STAGE(PG8_SB(0, 1), cB + hstep, voffB); PG8_STAGE(PG8_SA(0, 0), cA, voffA); PG8_STAGE(PG8_SA(0, 1), cA + hstep, voffA);
        if (wr == 1) PG8_BAR;
        PG8_WAIT_V(2); PG8_BAR;
        PG8_STAGE(PG8_SB(1, 0), cB + kstep, voffB); PG8_STAGE(PG8_SA(1, 0), cA + kstep, voffA); PG8_STAGE(PG8_SB(1, 1), cB + hstep + kstep, voffB);
        PG8_WAIT_V(6); PG8_BAR;
    } else {
        PG8_STAGE(PG8_SB(0, 0), cB, voffB); PG8_STAGE(PG8_SA(0, 0), cA, voffA); PG8_STAGE(PG8_SB(0, 1), cB + hstep, voffB); PG8_STAGE(PG8_SA(0, 1), cA + hstep, voffA);
        if (wr == 1) PG8_BAR;
        PG8_WAIT_V(4); PG8_BAR;
        PG8_STAGE(PG8_SB(1, 0), cB + kstep, voffB); PG8_STAGE(PG8_SA(1, 0), cA + kstep, voffA); PG8_STAGE(PG8_SB(1, 1), cB + hstep + kstep, voffB);
        PG8_WAIT_V(6); PG8_BAR;
    }
    for (;;) {
        const bool has_next = S.next(ui + 1, nxt);
        const char* nA = has_next ? (const char*)g.A + (size_t)nxt.pm * tstep : cA; const char* nB = has_next ? (const char*)g.Bt + (size_t)nxt.pn * tstep : cB;
        for (int t = 0; t < nt; t += 2) {
            const bool last = (t == nt - 2);
            const char* a1 = cA + (size_t)(t + 1) * kstep;
            const char* a2 = last ? nA : cA + (size_t)(t + 2) * kstep; const char* b2 = last ? nB : cB + (size_t)(t + 2) * kstep;
            const char* a3 = a2 + kstep; const char* b3 = b2 + kstep;
            if (last && has_next) S.a_ready(nxt);
            if constexpr (SP2) {
            PG8_LDB(B0, 0, 0); PG8_LDB(B1, 0, 1); PG8_SCHED; PG8_LDA(At, 0, 0); PG8_STAGE(PG8_SA(1, 1), a1 + hstep, voffA);
            PG8_WAIT_V(8); PG8_WAIT_L(0); PG8_BAR; PG8_MMA(0, 0, At, B0); PG8_MMA(0, 1, At, B1); PG8_BAR; PG8_SCHED;
            PG8_LDA(At, 0, 1); PG8_STAGE(PG8_SB(0, 0), b2, voffB); PG8_STAGE(PG8_SB(0, 1), b2 + hstep, voffB); PG8_STAGE(PG8_SA(0, 0), a2, voffA);
            PG8_WAIT_V(8); PG8_WAIT_L(0); PG8_BAR; PG8_MMA(1, 0, At, B0); PG8_MMA(1, 1, At, B1); PG8_BAR; PG8_SCHED;
            PG8_LDB(B0, 1, 0); PG8_LDB(B1, 1, 1); PG8_SCHED; PG8_LDA(At, 1, 0); PG8_STAGE(PG8_SA(0, 1), a2 + hstep, voffA);
            PG8_WAIT_V(8); PG8_WAIT_L(0); PG8_BAR; PG8_MMA(0, 0, At, B0); PG8_MMA(0, 1, At, B1); PG8_BAR; PG8_SCHED;
            PG8_LDA(At, 1, 1); PG8_STAGE(PG8_SB(1, 0), b3, voffB); PG8_STAGE(PG8_SB(1, 1), b3 + hstep, voffB); PG8_STAGE(PG8_SA(1, 0), a3, voffA);
            PG8_WAIT_V(8); PG8_WAIT_L(0); PG8_BAR; PG8_MMA(1, 0, At, B0); PG8_MMA(1, 1, At, B1); PG8_BAR; PG8_SCHED;
            } else {
            PG8_LDB(B0, 0, 0); PG8_SCHED; PG8_LDA(At, 0, 0); PG8_STAGE(PG8_SA(1, 1), a1 + hstep, voffA);
            PG8_WAIT_L(8); PG8_BAR; PG8_WAIT_L(0); PG8_MMA(0, 0, At, B0); PG8_BAR; PG8_SCHED;
            PG8_LDB(B1, 0, 1); PG8_STAGE(PG8_SB(0, 0), b2, voffB);
            PG8_BAR; PG8_WAIT_L(0); PG8_MMA(0, 1, At, B1); PG8_BAR;
            PG8_LDA(At, 0, 1); PG8_STAGE(PG8_SA(0, 0), a2, voffA);
            PG8_BAR; PG8_WAIT_L(0); PG8_MMA(1, 0, At, B0); PG8_BAR; PG8_SCHED;
            PG8_STAGE(PG8_SB(0, 1), b2 + hstep, voffB);
            PG8_WAIT_V(6); PG8_BAR; PG8_MMA(1, 1, At, B1); PG8_BAR;
            PG8_LDB(B0, 1, 0); PG8_SCHED; PG8_LDA(At, 1, 0); PG8_STAGE(PG8_SA(0, 1), a2 + hstep, voffA);
            PG8_WAIT_L(8); PG8_BAR; PG8_WAIT_L(0); PG8_MMA(0, 0, At, B0); PG8_BAR; PG8_SCHED;
            PG8_LDB(B1, 1, 1); PG8_STAGE(PG8_SB(1, 0), b3, voffB);
            PG8_BAR; PG8_WAIT_L(0); PG8_MMA(0, 1, At, B1); PG8_BAR;
            PG8_LDA(At, 1, 1); PG8_STAGE(PG8_SA(1, 0), a3, voffA);
            PG8_BAR; PG8_WAIT_L(0); PG8_MMA(1, 0, At, B0); PG8_BAR; PG8_SCHED;
            PG8_STAGE(PG8_SB(1, 1), b3 + hstep, voffB);
            PG8_WAIT_V(6); PG8_BAR; PG8_MMA(1, 1, At, B1); PG8_BAR;
            }
        }
        if constexpr (ALIGN_EPI) { if (wr == 0) PG8_BAR; }
        if constexpr (!Epi::AFTER_DRAIN) { E(acc, cur, wr, wc, fr, fq); S.done(cur); }
        if (!has_next) break;
#pragma unroll
        for (int a = 0; a < 2; ++a)
#pragma unroll
            for (int b = 0; b < 2; ++b)
#pragma unroll
                for (int m = 0; m < 4; ++m)
#pragma unroll
                    for (int n = 0; n < 2; ++n) acc[a][b][m][n] = (f32x4){0.f, 0.f, 0.f, 0.f};
        cur = nxt; cA = nA; cB = nB; ++ui;
        if constexpr (ALIGN_EPI) { if (wr == 1) PG8_BAR; }
    }
    PG8_WAIT_V(0);
    if constexpr (!ALIGN_EPI) { if (wr == 0) PG8_BAR; }
    PG8_BAR;
    if constexpr (Epi::AFTER_DRAIN) { E.fused(acc, cur, wr, wc, fr, fq, lds, wid, lane); S.done(cur); }
#undef PG8_SA
#undef PG8_SB
#undef PG8_STAGE
#undef PG8_LDA
#undef PG8_LDB
#undef PG8_MMA
#undef PG8_WAIT_V
#undef PG8_WAIT_L
#undef PG8_BAR
#undef PG8_SCHED
}
}
#ifndef PG8_SP2
#define PG8_SP2 true
#endif
#ifndef PG8_ALIGN
#define PG8_ALIGN true
#endif
#ifndef MK_LAUNCHES
#define MK_LAUNCHES 1
#endif

constexpr int NWAVES = 8;
constexpr int SEQ = 16384, DM = 1024, DFF = 2816, DCONV = 512, DATT = 512, NH = 8, NG = 2, HPG = 4, HD = 64;
constexpr int DIN = 2328, DIN_PAD = 2560, NCMP = 1023, CONVW = 31, CMP_HID = 128, NSLC = 256, NTOP = 16, WIN = 512;
constexpr float EPS = 1e-6f;
constexpr int N_PHASES = 13;
enum { I_X = 0, I_C, I_WADA, I_BADA, I_GFFN1, I_WGU1, I_WD1, I_GMIX, I_WIN, I_WDW, I_BDW, I_LNG, I_LNB, I_PEK, I_PEV, I_WCK1, I_WCK2, I_WCV1, I_WCV2, I_RELB, I_WOUT, I_GFFN2, I_WGU2, I_WD2, I_GFIN, N_IN };

constexpr size_t MiB = 1u << 20;
constexpr size_t WS_CTL = 0, CTL_ZERO_BYTES = 64 * 1024;
constexpr size_t WS_MODP = 1 * MiB;
constexpr size_t WS_MOD = WS_MODP + 16 * 9216 * 4;
constexpr size_t WS_KCMP = 2 * MiB, WS_VCMP = WS_KCMP + 256 * 1024;
constexpr size_t WS_WGU1 = 4 * MiB, WS_WD1 = 15 * MiB, WS_WIN = 21 * MiB, WS_WOUT = 26 * MiB, WS_WGU2 = 28 * MiB, WS_WD2 = 39 * MiB;
constexpr size_t WS_GT = 45 * MiB;
constexpr size_t WS_HB = 48 * MiB;
constexpr size_t WS_XB = 80 * MiB;
constexpr size_t WS_ACT = 144 * MiB;
constexpr size_t WS_HG = WS_ACT, WS_Q = WS_ACT + 16 * MiB, WS_KV = WS_ACT + 32 * MiB;
constexpr size_t WS_ACT_END = 232 * MiB, WS_END = 240 * MiB;
static_assert(WS_WD2 + (size_t)DM * DFF * 2 <= WS_GT && WS_GT + (size_t)SEQ * 24 * 4 <= WS_HB && WS_KV + (size_t)SEQ * 768 * 2 <= WS_ACT_END && WS_ACT + (size_t)SEQ * DFF * 2 <= WS_ACT_END, "d_ws map");
constexpr int CW_BAR = 4096;
constexpr int RING_OFF = 0, RING_BYTES = 131072;
constexpr int LDS_BYTES = 163840;
constexpr int LDSCTL_OFF = LDS_BYTES - 1024, MISC_OFF = LDSCTL_OFF + 320;

#define GAS __attribute__((address_space(1)))
#define LAS __attribute__((address_space(3)))
typedef unsigned short bf16;
typedef unsigned v4u __attribute__((ext_vector_type(4)));
typedef unsigned v2u __attribute__((ext_vector_type(2)));
typedef float f32x4 __attribute__((ext_vector_type(4)));
typedef float f32x2 __attribute__((ext_vector_type(2)));
typedef short bf16x8 __attribute__((ext_vector_type(8)));
typedef GAS unsigned gu32;
#define RLX_AGENT __ATOMIC_RELAXED, __HIP_MEMORY_SCOPE_AGENT
__device__ __forceinline__ unsigned f2bf(float f) { unsigned u = __builtin_bit_cast(unsigned, f); return (u + 0x7fffu + ((u >> 16) & 1u)) >> 16; }
__device__ __forceinline__ unsigned pk2(float lo, float hi) { return f2bf(lo) | (f2bf(hi) << 16); }
__device__ __forceinline__ float bflo(unsigned w) { return __uint_as_float(w << 16); }
__device__ __forceinline__ float bfhi(unsigned w) { return __uint_as_float(w & 0xffff0000u); }
__device__ __forceinline__ float bf2f(bf16 b) { return __uint_as_float((unsigned)b << 16); }
__device__ __forceinline__ float sigmoid_f(float x) { return __builtin_amdgcn_rcpf(1.0f + __builtin_amdgcn_exp2f(-1.4426950408889634f * x)); }
__device__ __forceinline__ float silu_f(float x) { return x * sigmoid_f(x); }
__device__ __forceinline__ float wave_sum(float v) {
#pragma unroll
    for (int o = 1; o < 64; o <<= 1) v += __shfl_xor(v, o);
    return v;
}
__device__ __forceinline__ float wave_max(float v) {
#pragma unroll
    for (int o = 1; o < 64; o <<= 1) v = fmaxf(v, __shfl_xor(v, o));
    return v;
}

#define XB_TMO      128
#define XB_XCNT(j)  (256  + 64 * (j))
#define XB_XSUB(j)  (1280 + 64 * (j))
#define XB_XGEN(j)  (2304 + 64 * (j))
#define XB_TOP      3328
#define XB_TOPGEN   3392
#define XCD_BAR_WORDS 3456
#define XB_SPIN_CAP (1u << 18)
static_assert((CW_BAR + XCD_BAR_WORDS) * 4 <= (int)CTL_ZERO_BYTES, "barrier words inside the memset region");

__device__ __forceinline__ unsigned xb_ld(unsigned* p)              { return __hip_atomic_load(p, __ATOMIC_RELAXED, __HIP_MEMORY_SCOPE_AGENT); }
__device__ __forceinline__ unsigned xb_add(unsigned* p, unsigned v) { return __hip_atomic_fetch_add(p, v, __ATOMIC_RELAXED, __HIP_MEMORY_SCOPE_AGENT); }
__device__ __forceinline__ unsigned xb_xcc_id() { return (unsigned)__builtin_amdgcn_s_getreg((3 << 11) | 20) & 0xFu; }
#define XB_SPIN(cond, bar) do { unsigned _sp = 0; while (cond) { __builtin_amdgcn_s_sleep(1); \
    if ((++_sp & 255u) == 0u) { if (xb_ld(&(bar)[XB_TMO])) break; if (_sp > XB_SPIN_CAP) { atomicAdd(&(bar)[XB_TMO], 1u); break; } } } } while (0)

struct XcdBarrier {
    unsigned* bar; unsigned x;
    volatile LAS unsigned* st;
};
__device__ __forceinline__ XcdBarrier xcd_barrier_post(unsigned* bar, volatile LAS unsigned* st) {
    XcdBarrier b; b.bar = bar; b.x = xb_xcc_id(); b.st = st;
    if (threadIdx.x == 0) (void)xb_add(&bar[XB_XCNT(b.x)], 1u);
    return b;
}
__device__ __forceinline__ void xcd_barrier_complete(unsigned* bar, unsigned x, unsigned& nloc, unsigned& nx) {
    const unsigned G = gridDim.x * gridDim.y * gridDim.z;
    unsigned sum, cnt, mine, sp = 0u;
    for (;;) {
        sum = 0u; cnt = 0u; mine = 0u;
#pragma unroll
        for (unsigned j = 0; j < 16; ++j) { const unsigned c = xb_ld(&bar[XB_XCNT(j)]); sum += c; cnt += (c > 0u) ? 1u : 0u; mine = (j == x) ? c : mine; }
        if (sum == G) break;
        __builtin_amdgcn_s_sleep(1);
        if ((++sp & 255u) == 0u) { if (xb_ld(&bar[XB_TMO])) break; if (sp > XB_SPIN_CAP) { atomicAdd(&bar[XB_TMO], 1u); break; } }
    }
    nloc = mine > 0u ? mine : 1u; nx = cnt > 0u ? cnt : 1u;
}
__device__ __forceinline__ void xcd_barrier(const XcdBarrier& b) {
    asm volatile("s_waitcnt vmcnt(0)" ::: "memory");
    __syncthreads();
    if (threadIdx.x == 0) {
        unsigned* bar = b.bar;
        __builtin_amdgcn_s_waitcnt(0);
        unsigned nloc = b.st[0], nx = b.st[1];
        if (nloc == 0u) { xcd_barrier_complete(bar, b.x, nloc, nx); b.st[0] = nloc; b.st[1] = nx; }
        const unsigned old = xb_add(&bar[XB_XSUB(b.x)], 1u);
        const unsigned gen = old / nloc;
        if (old + 1u == (gen + 1u) * nloc) {
            __builtin_amdgcn_fence(__ATOMIC_RELEASE, "agent");
            asm volatile("s_waitcnt vmcnt(0)" ::: "memory");
            const unsigned og = xb_add(&bar[XB_TOP], 1u);
            const unsigned tg = og / nx;
            if (og + 1u == (tg + 1u) * nx) xb_add(&bar[XB_TOPGEN], 1u);
            else XB_SPIN(xb_ld(&bar[XB_TOPGEN]) == tg, bar);
            __builtin_amdgcn_fence(__ATOMIC_ACQUIRE, "agent");
            xb_add(&bar[XB_XGEN(b.x)], 1u);
            asm volatile("s_waitcnt vmcnt(0)" ::: "memory");
        } else {
            XB_SPIN(xb_ld(&bar[XB_XGEN(b.x)]) == gen, bar);
            __builtin_amdgcn_fence(__ATOMIC_ACQUIRE, "agent");
            asm volatile("s_waitcnt vmcnt(0)" ::: "memory");
        }
    }
    __syncthreads();
}

struct Args { const float* in[N_IN]; float* out; unsigned char* ws; int ph_lo, ph_hi, probe, pad; };
static_assert(sizeof(Args) == (N_IN + 2) * 8 + 16, "Args has no padding");
struct Frame {
    LAS unsigned char* lds;
    int tid, lane, wave, G, bid;
};
#define WSP(T, off) ((T*)(a.ws + (off)))

__device__ const unsigned char T5_BUCKET[128] = {0, 1, 2, 3, 4, 5, 6, 7, 8, 9, 10, 11, 12, 13, 14, 15, 16, 16, 16, 17, 17, 18, 18, 18, 19, 19, 19, 20, 20, 20, 20, 21, 21, 21, 21, 22, 22, 22, 22, 22, 23, 23, 23, 23, 23, 23, 24, 24, 24, 24, 24, 24, 25, 25, 25, 25, 25, 25, 25, 26, 26, 26, 26, 26, 26, 26, 26, 27, 27, 27, 27, 27, 27, 27, 27, 27, 27, 28, 28, 28, 28, 28, 28, 28, 28, 28, 28, 29, 29, 29, 29, 29, 29, 29, 29, 29, 29, 29, 29, 30, 30, 30, 30, 30, 30, 30, 30, 30, 30, 30, 30, 30, 30, 31, 31, 31, 31, 31, 31, 31, 31, 31, 31, 31, 31, 31, 31, 31};
__host__ __device__ __forceinline__ int vt_perm(int r) { return (r & 32) + 8 * ((r >> 2) & 3) + 4 * ((r >> 4) & 1) + (r & 3); }
__host__ __device__ __forceinline__ int vt_iperm(int p) { return (p & 32) + 16 * ((p >> 2) & 1) + 4 * ((p >> 3) & 3) + (p & 3); }
constexpr int CW_KMAX = 1024;
constexpr size_t WS_VT2 = 200 * MiB;
constexpr size_t WS_VCT = 208 * MiB;
static_assert(WS_VCT + 2 * 16 * 64 * 64 * 2 <= WS_ACT_END, "ws map (attention prep)");
constexpr size_t WS_W1T = 232 * MiB;
constexpr size_t WS_B1P = WS_W1T + 2 * 128 * 2048 * 2;
static_assert(WS_B1P + 16 * 256 * 4 <= 240 * MiB, "ws map (compress)");
template <int MODE> __device__ __forceinline__ int wt_row0(int n0) {
    if (MODE == 1) { const int isu = n0 >= DFF ? 1 : 0, c = n0 - isu * DFF; return 256 * (c >> 7) + 128 * isu + (c & 127); }
    if (MODE == 2) { if (n0 < 512) return 256 * (n0 >> 7) + (n0 & 127); if (n0 < 1024) { const int c = n0 - 512; return 256 * (c >> 7) + 128 + (c & 127); } return n0; }
    return n0;
}
template <int MODE> __device__ __forceinline__ void p0_transpose_item(const float* W, int K, int N, bf16* WT, LAS float* scr, int item, int lane) {
    const int nblk = (N + 31) / 32, kb = item / nblk, nb = item % nblk, k0 = 64 * kb, n0 = 32 * nb;
    const int nn = n0 + (lane & 31); const bool okn = nn < N;
#pragma unroll 8
    for (int i = 0; i < 32; ++i) { const int kk = 2 * i + (lane >> 5); scr[kk * 33 + (lane & 31)] = okn ? W[(size_t)(k0 + kk) * N + nn] : 0.f; }
    asm volatile("s_waitcnt lgkmcnt(0)" ::: "memory");
    const int c = lane & 7, r0 = wt_row0<MODE>(n0);
#pragma unroll
    for (int j = 0; j < 4; ++j) { const int n = (lane >> 3) + 8 * j; const LAS float* s = scr + (8 * c) * 33 + n;
        v4u o; o.x = pk2(s[0 * 33], s[1 * 33]); o.y = pk2(s[2 * 33], s[3 * 33]); o.z = pk2(s[4 * 33], s[5 * 33]); o.w = pk2(s[6 * 33], s[7 * 33]);
        *(v4u*)(WT + (size_t)(r0 + n) * K + k0 + 8 * c) = o; }
    asm volatile("s_waitcnt lgkmcnt(0)" ::: "memory");
}
__device__ __forceinline__ void p0_prologue(const Args& a, const Frame& F) {
    LAS float* scr = (LAS float*)(F.lds + RING_OFF + F.wave * 16384);
    const int gw = F.bid * NWAVES + F.wave, NGW = F.G * NWAVES;
    constexpr int I_GU = (DM / 64) * (2 * DFF / 32), I_D = (DFF / 64) * (DM / 32), I_IN = (DM / 64) * ((DIN + 31) / 32), I_O = (DM / 64) * (DM / 32);
    constexpr int I_MOD = 144 * 16, I_PAD = (DIN_PAD - 2336) * DM / 8 / 64, I_W1 = (2048 / 64) * (128 / 32), I_B1 = 2 * 2 * 16;
    constexpr int NITEMS = 2 * I_GU + 2 * I_D + I_IN + I_O + I_MOD + I_PAD + 2 * I_W1 + I_B1;
    for (int it = gw; it < NITEMS; it += NGW) {
        int r = it;
        if (r < I_MOD) {
            const int cg = r >> 4, kc = r & 15; const float* W = a.in[I_WADA] + (size_t)(kc * 64) * 9216 + cg * 64 + F.lane; const float* cv = a.in[I_C] + kc * 64;
            float s = 0.f;
#pragma unroll 16
            for (int k = 0; k < 64; ++k) s += silu_f(cv[k]) * W[(size_t)k * 9216];
            WSP(float, WS_MODP)[kc * 9216 + cg * 64 + F.lane] = s; continue; }
        r -= I_MOD;
        if (r < I_GU) { p0_transpose_item<1>(a.in[I_WGU1], DM, 2 * DFF, WSP(bf16, WS_WGU1), scr, r, F.lane); continue; } r -= I_GU;
        if (r < I_GU) { p0_transpose_item<1>(a.in[I_WGU2], DM, 2 * DFF, WSP(bf16, WS_WGU2), scr, r, F.lane); continue; } r -= I_GU;
        if (r < I_D) { p0_transpose_item<0>(a.in[I_WD1], DFF, DM, WSP(bf16, WS_WD1), scr, r, F.lane); continue; } r -= I_D;
        if (r < I_D) { p0_transpose_item<0>(a.in[I_WD2], DFF, DM, WSP(bf16, WS_WD2), scr, r, F.lane); continue; } r -= I_D;
        if (r < I_IN) { p0_transpose_item<2>(a.in[I_WIN], DM, DIN, WSP(bf16, WS_WIN), scr, r, F.lane); continue; } r -= I_IN;
        if (r < I_O) { p0_transpose_item<0>(a.in[I_WOUT], DM, DM, WSP(bf16, WS_WOUT), scr, r, F.lane); continue; } r -= I_O;
        if (r < I_PAD) { v4u* p = (v4u*)(WSP(bf16, WS_WIN) + (size_t)2336 * DM) + (size_t)r * 64 + F.lane; *p = (v4u){0u, 0u, 0u, 0u}; continue; } r -= I_PAD;
        if (r < I_W1) { p0_transpose_item<0>(a.in[I_WCK1], 2048, 128, WSP(bf16, WS_W1T), scr, r, F.lane); continue; } r -= I_W1;
        if (r < I_W1) { p0_transpose_item<0>(a.in[I_WCV1], 2048, 128, WSP(bf16, WS_W1T) + 128 * 2048, scr, r, F.lane); continue; } r -= I_W1;
        {
            const int which = r >> 5, ch = (r >> 4) & 1, kc = r & 15; const float* w1 = a.in[which ? I_WCV1 : I_WCK1] + (size_t)(kc * 128) * 128 + ch * 64 + F.lane; const float* pe = a.in[which ? I_PEV : I_PEK] + kc * 128;
            float s = 0.f;
#pragma unroll 16
            for (int k = 0; k < 128; ++k) s += pe[k] * w1[(size_t)k * 128];
            WSP(float, WS_B1P)[kc * 256 + which * 128 + ch * 64 + F.lane] = s; }
    }
}
template <bool FROM_PARTIALS> __device__ __forceinline__ void norm_mod_pass(const Args& a, const Frame& F, const float* src, bf16* dst, const float* gvec, int sub) {
    LAS float* CA = (LAS float*)(F.lds + RING_OFF); LAS float* CB = CA + DM;
    const float* modp = WSP(const float, WS_MODP); float* mod = WSP(float, WS_MOD); const float* bada = a.in[I_BADA];
    if (FROM_PARTIALS) {
        for (int i = F.bid * 512 + F.tid; i < 9216; i += F.G * 512) { float s = bada[i];
#pragma unroll
            for (int k = 0; k < 16; ++k) s += modp[k * 9216 + i];
            mod[i] = s; }
    }
    for (int c = F.tid; c < 2 * DM; c += 512) {
        const int i = 3 * sub * DM + c; float s;
        if (FROM_PARTIALS) { s = bada[i];
#pragma unroll
            for (int k = 0; k < 16; ++k) s += modp[k * 9216 + i]; }
        else s = mod[i];
        if (c < DM) CB[c] = s; else CA[c - DM] = gvec[c - DM] * (1.0f + s);
    }
    __syncthreads();
    const int gw = F.bid * NWAVES + F.wave, NGW = F.G * NWAVES;
    for (int m = gw; m < SEQ; m += NGW) {
        const f32x4* xr = (const f32x4*)(src + (size_t)m * DM) + F.lane;
        f32x4 v[4]; float s = 0.f;
#pragma unroll
        for (int j = 0; j < 4; ++j) { v[j] = xr[64 * j]; s += (v[j].x * v[j].x + v[j].y * v[j].y) + (v[j].z * v[j].z + v[j].w * v[j].w); }
        const float rstd = 1.0f / sqrtf(wave_sum(s) * (1.0f / DM) + EPS);
        unsigned long long* o8 = (unsigned long long*)(dst + (size_t)m * DM) + F.lane;
#pragma unroll
        for (int j = 0; j < 4; ++j) { const f32x4 ca = *(const LAS f32x4*)(CA + 256 * j + 4 * F.lane), cb = *(const LAS f32x4*)(CB + 256 * j + 4 * F.lane);
            const f32x4 h = v[j] * rstd * ca + cb;
            o8[64 * j] = (unsigned long long)pk2(h.x, h.y) | ((unsigned long long)pk2(h.z, h.w) << 32); }
    }
    __syncthreads();
}
__device__ __forceinline__ void final_norm_pass(const Args& a, const Frame& F) {
    const int gw = F.bid * NWAVES + F.wave, NGW = F.G * NWAVES; const float* g = a.in[I_GFIN];
    f32x4 gv[4];
#pragma unroll
    for (int j = 0; j < 4; ++j) gv[j] = *((const f32x4*)g + 64 * j + F.lane);
    for (int m = gw; m < SEQ; m += NGW) {
        f32x4* xr = (f32x4*)(a.out + (size_t)m * DM) + F.lane;
        f32x4 v[4]; float s = 0.f;
#pragma unroll
        for (int j = 0; j < 4; ++j) { v[j] = xr[64 * j]; s += (v[j].x * v[j].x + v[j].y * v[j].y) + (v[j].z * v[j].z + v[j].w * v[j].w); }
        const float rstd = 1.0f / sqrtf(wave_sum(s) * (1.0f / DM) + EPS);
#pragma unroll
        for (int j = 0; j < 4; ++j) xr[64 * j] = v[j] * rstd * gv[j];
    }
}
__device__ __forceinline__ float wave_sum_dpp(float v) {
    v += __builtin_bit_cast(float, __builtin_amdgcn_update_dpp(0, __builtin_bit_cast(int, v), 0xB1, 0xf, 0xf, false));
    v += __builtin_bit_cast(float, __builtin_amdgcn_update_dpp(0, __builtin_bit_cast(int, v), 0x4E, 0xf, 0xf, false));
    v += __builtin_bit_cast(float, __builtin_amdgcn_update_dpp(0, __builtin_bit_cast(int, v), 0x124, 0xf, 0xf, false));
    v += __builtin_bit_cast(float, __builtin_amdgcn_update_dpp(0, __builtin_bit_cast(int, v), 0x128, 0xf, 0xf, false));
    v += __shfl_xor(v, 16); v += __shfl_xor(v, 32); return v;
}
__device__ __forceinline__ void conv_phase(const Args& a, const Frame& F) {
    LAS float* WL = (LAS float*)(F.lds + RING_OFF);
    LAS bf16* TL = (LAS bf16*)(F.lds + RING_OFF + 63488);
    for (int i = F.tid; i < CONVW * DCONV; i += 512) WL[i] = a.in[I_WDW][i];
    const bf16* HG = WSP(const bf16, WS_HG); bf16* Y = WSP(bf16, WS_HB);
    const int c0 = 8 * F.lane;
    float bd[8], lg[8], lb[8];
#pragma unroll
    for (int e = 0; e < 8; ++e) { bd[e] = a.in[I_BDW][c0 + e]; lg[e] = a.in[I_LNG][c0 + e]; lb[e] = a.in[I_LNB][c0 + e]; }
    for (int tile = F.bid; tile < SEQ / 64; tile += F.G) {
        const int t0 = 64 * tile;
        __syncthreads();
        for (int i = F.tid; i < 94 * 64; i += 512) { const int rr = i >> 6, ch = i & 63, tok = t0 - 30 + rr;
            v4u v = (v4u){0u, 0u, 0u, 0u}; if (tok >= 0) v = *(const v4u*)(HG + (size_t)tok * DCONV + ch * 8);
            *(LAS v4u*)(TL + rr * DCONV + ch * 8) = v; }
        __syncthreads();
        const LAS bf16* tw = TL + (8 * F.wave) * DCONV + c0;
        float acc[8][8], hw[8][8];
#pragma unroll
        for (int j = 0; j < 8; ++j)
#pragma unroll
            for (int e = 0; e < 8; ++e) acc[j][e] = bd[e];
#pragma unroll
        for (int m = 0; m < 8; ++m) { const v4u h = *(const LAS v4u*)(tw + m * DCONV);
            hw[m][0] = bflo(h.x); hw[m][1] = bfhi(h.x); hw[m][2] = bflo(h.y); hw[m][3] = bfhi(h.y); hw[m][4] = bflo(h.z); hw[m][5] = bfhi(h.z); hw[m][6] = bflo(h.w); hw[m][7] = bfhi(h.w); }
        for (int k = 0; k < CONVW; ++k) {
            const f32x4 w0 = *(const LAS f32x4*)(WL + k * DCONV + c0), w1 = *(const LAS f32x4*)(WL + k * DCONV + c0 + 4);
            const int kn = k + 8 < 38 ? k + 8 : 37; const v4u h = *(const LAS v4u*)(tw + kn * DCONV);
#pragma unroll
            for (int j = 0; j < 8; ++j) {
                acc[j][0] += hw[j][0] * w0.x; acc[j][1] += hw[j][1] * w0.y; acc[j][2] += hw[j][2] * w0.z; acc[j][3] += hw[j][3] * w0.w;
                acc[j][4] += hw[j][4] * w1.x; acc[j][5] += hw[j][5] * w1.y; acc[j][6] += hw[j][6] * w1.z; acc[j][7] += hw[j][7] * w1.w; }
#pragma unroll
            for (int j = 0; j < 7; ++j)
#pragma unroll
                for (int e = 0; e < 8; ++e) hw[j][e] = hw[j + 1][e];
            hw[7][0] = bflo(h.x); hw[7][1] = bfhi(h.x); hw[7][2] = bflo(h.y); hw[7][3] = bfhi(h.y); hw[7][4] = bflo(h.z); hw[7][5] = bfhi(h.z); hw[7][6] = bflo(h.w); hw[7][7] = bfhi(h.w);
        }
#pragma unroll
        for (int j = 0; j < 8; ++j) {
            float s = 0.f;
#pragma unroll
            for (int e = 0; e < 8; ++e) s += acc[j][e];
            const float mu = wave_sum_dpp(s) * (1.0f / DCONV); float q = 0.f;
#pragma unroll
            for (int e = 0; e < 8; ++e) { acc[j][e] -= mu; q += acc[j][e] * acc[j][e]; }
            const float rstd = 1.0f / sqrtf(wave_sum_dpp(q) * (1.0f / DCONV) + EPS);
            float o[8];
#pragma unroll
            for (int e = 0; e < 8; ++e) o[e] = silu_f(acc[j][e] * rstd * lg[e] + lb[e]);
            v4u w; w.x = pk2(o[0], o[1]); w.y = pk2(o[2], o[3]); w.z = pk2(o[4], o[5]); w.w = pk2(o[6], o[7]);
            *(v4u*)(Y + (size_t)(t0 + 8 * F.wave + j) * DM + c0) = w;
        }
    }
    __syncthreads();
}
__device__ __forceinline__ void compress_phase(const Args& a, const Frame& F) {
    LAS bf16* SL = (LAS bf16*)(F.lds + RING_OFF);
    LAS float* W2L = (LAS float*)(F.lds + RING_OFF + 39168);
    LAS float* HID = (LAS float*)(F.lds + RING_OFF + 39168 + 32768);
    LAS float* B1 = HID + 2048;
    const bf16* KV = WSP(const bf16, WS_KV);
    const int lane = F.lane, wave = F.wave, col = lane & 15, q4 = lane >> 4;
    for (int task = F.bid; task < 256; task += F.G) {
        const int which = task >> 7, g = (task >> 6) & 1, ng = task & 63, n0 = 16 * ng;
        const float* w2 = a.in[which ? I_WCV2 : I_WCK2];
        const bf16* W1T = WSP(const bf16, WS_W1T) + (size_t)which * 128 * 2048;
        const int coff = which * 128 + g * 64;
        __syncthreads();
        for (int i = F.tid; i < 272 * 8; i += 512) { const int tok = 16 * n0 + (i >> 3), ch = i & 7;
            v4u v = (v4u){0u, 0u, 0u, 0u}; if (tok < SEQ) v = *(const v4u*)(KV + (size_t)tok * 768 + coff + ch * 8);
            *(LAS v4u*)(SL + (i >> 3) * 72 + ch * 8) = v; }
        for (int i = F.tid; i < 128 * 64; i += 512) W2L[i] = w2[i];
        if (F.tid < 128) { float s = 0.f; const float* bp = WSP(const float, WS_B1P) + which * 128 + F.tid;
#pragma unroll
            for (int k = 0; k < 16; ++k) s += bp[k * 256];
            B1[F.tid] = s; }
        __syncthreads();
        f32x4 acc = (f32x4){0.f, 0.f, 0.f, 0.f};
        const bf16* bp = W1T + (size_t)(16 * wave + col) * 2048 + 8 * q4;
        const LAS bf16* ap = SL + (16 * col) * 72 + 8 * q4;
#pragma unroll 8
        for (int ks = 0; ks < 64; ++ks) { const int l = ks >> 1, d0 = (ks & 1) * 32;
            const bf16x8 bfr = *(const bf16x8*)(bp + ks * 32);
            const bf16x8 afr = *(const LAS bf16x8*)(ap + l * 72 + d0);
            acc = __builtin_amdgcn_mfma_f32_16x16x32_bf16(afr, bfr, acc, 0, 0, 0); }
#pragma unroll
        for (int e = 0; e < 4; ++e) HID[(4 * q4 + e) * 128 + 16 * wave + col] = silu_f(acc[e] + B1[16 * wave + col]);
        __syncthreads();
        for (int i = F.tid; i < 16 * 64; i += 512) { const int r = i >> 6, e = i & 63; float s = 0.f;
#pragma unroll 8
            for (int j = 0; j < CMP_HID; ++j) s += HID[r * 128 + j] * W2L[j * 64 + e];
            const int n = n0 + r; const unsigned ob = n < NCMP ? f2bf(s) : 0u;
            if (which == 0) { WSP(bf16, WS_KCMP)[(size_t)n * 128 + g * 64 + e] = (bf16)ob; const float v = __uint_as_float(ob << 16), nn = wave_sum(v * v);
                if (F.lane == 0) atomicMax(WSP(unsigned, WS_CTL) + CW_KMAX + g, __float_as_uint(nn)); }
            else WSP(bf16, WS_VCT)[(size_t)((g * 16 + (n >> 6)) * 64 + e) * 64 + vt_perm(n & 63)] = (bf16)ob; }
    }
    __syncthreads();
}
__device__ __forceinline__ void kv_prep_phase(const Args& a, const Frame& F) {
    const bf16* KV = WSP(const bf16, WS_KV); bf16* VT = WSP(bf16, WS_VT2);
    LAS bf16* T = (LAS bf16*)(F.lds + RING_OFF + F.wave * 8704);
    const int gw = F.bid * NWAVES + F.wave, NGW = F.G * NWAVES, lane = F.lane;
    for (int task = gw; task < 2 * 2 * 256; task += NGW) {
        const int tv = task >> 9, g = (task >> 8) & 1, j = task & 255, voff = (tv ? 640 : 384) + g * 64;
#pragma unroll
        for (int it = 0; it < 8; ++it) { const int r = it * 8 + (lane >> 3), c = lane & 7;
            const v4u v = *(const v4u*)(KV + (size_t)(64 * j + r) * 768 + voff + 8 * c);
            LAS unsigned* d = (LAS unsigned*)(T + r * 68 + 8 * c); d[0] = v.x; d[1] = v.y; d[2] = v.z; d[3] = v.w; }
        asm volatile("s_waitcnt lgkmcnt(0)" ::: "memory");
        bf16* O = VT + (size_t)((tv * 2 + g) * 256 + j) * 4096;
#pragma unroll
        for (int it = 0; it < 8; ++it) { const int d = it * 8 + (lane >> 3), c = lane & 7; unsigned w[4];
#pragma unroll
            for (int e = 0; e < 4; ++e) { const int r0 = vt_iperm(8 * c + 2 * e), r1 = vt_iperm(8 * c + 2 * e + 1); w[e] = (unsigned)T[r0 * 68 + d] | ((unsigned)T[r1 * 68 + d] << 16); }
            *(v4u*)(O + d * 64 + 8 * c) = (v4u){w[0], w[1], w[2], w[3]}; }
        asm volatile("s_waitcnt lgkmcnt(0)" ::: "memory");
    }
    unsigned* kmx = WSP(unsigned, WS_CTL) + CW_KMAX;
    for (int task = gw; task < 4 * (SEQ / 64); task += NGW) {
        const int wh = task & 3, tb = task >> 2, tok = tb * 64 + lane;
        const v4u* p = (const v4u*)(KV + (size_t)tok * 768 + (wh >> 1 ? 512 : 256) + (wh & 1) * 64); float s = 0.f;
#pragma unroll
        for (int c = 0; c < 8; ++c) { const v4u w = p[c]; s += bflo(w.x) * bflo(w.x) + bfhi(w.x) * bfhi(w.x) + bflo(w.y) * bflo(w.y) + bfhi(w.y) * bfhi(w.y) + bflo(w.z) * bflo(w.z) + bfhi(w.z) * bfhi(w.z) + bflo(w.w) * bflo(w.w) + bfhi(w.w) * bfhi(w.w); }
        s = wave_max(s);
        if (lane == 0) atomicMax(kmx + 2 + wh, __float_as_uint(s));
    }
    __syncthreads();
}
constexpr float LOG2E = 1.4426950408889634f;
constexpr int A2_IMP = 0;
constexpr int A2_MB = 65536;
constexpr int A2_SELB = A2_MB + 3072;
constexpr int A2_BL = A2_SELB + 2048;
constexpr int A2_STG = A2_BL + 2048;
constexpr int RB = 4, STG_V = 8192, STG_BUF = 16384;
constexpr int A2_END = A2_STG + RB * STG_BUF;
static_assert(A2_END <= MISC_OFF, "attention LDS map");
constexpr size_t WS_TOT = 212 * MiB;
static_assert(WS_TOT + (size_t)256 * 65536 <= WS_ACT_END && WS_VCT + 2 * 16 * 64 * 64 * 2 <= WS_TOT, "ws map (attention)");
typedef __attribute__((address_space(3))) float lds_f32;
#define DPP_F(v, ctrl) __builtin_bit_cast(float, __builtin_amdgcn_update_dpp(0, __builtin_bit_cast(int, (v)), (ctrl), 0xf, 0xf, false))
#define DPP_I(v, ctrl) __builtin_amdgcn_update_dpp(0, (v), (ctrl), 0xf, 0xf, false)

struct AttnFrag { bf16x8 k[4][2], v[4][2]; };
template <bool WITH_V> __device__ __forceinline__ void dma_issue(LAS unsigned char* buf, const bf16* Kblk, int kp, const bf16* VTblk, int wave, int lane) {
    const int row = 8 * wave + (lane >> 3), c = (lane & 7) ^ (row & 7);
    __builtin_amdgcn_global_load_lds((const unsigned*)(Kblk + (size_t)row * kp + c * 8), (LAS unsigned*)(buf + wave * 1024), 16, 0, 0);
    if (WITH_V) __builtin_amdgcn_global_load_lds((const unsigned*)(VTblk + row * 64 + c * 8), (LAS unsigned*)(buf + STG_V + wave * 1024), 16, 0, 0);
}
template <bool WITH_V> __device__ __forceinline__ void frag_from_lds(AttnFrag& f, const LAS unsigned char* buf, int col, int q4) {
    const int sw = col & 7;
#pragma unroll
    for (int kt = 0; kt < 4; ++kt)
#pragma unroll
        for (int ks = 0; ks < 2; ++ks) f.k[kt][ks] = *(const LAS bf16x8*)(buf + (16 * kt + col) * 128 + (((4 * ks + q4) ^ sw) * 16));
    if (WITH_V) {
#pragma unroll
        for (int dt = 0; dt < 4; ++dt)
#pragma unroll
            for (int ks = 0; ks < 2; ++ks) f.v[dt][ks] = *(const LAS bf16x8*)(buf + STG_V + (16 * dt + col) * 128 + (((4 * ks + q4) ^ sw) * 16));
    }
}
#define A2_WAITBAR(n) do { asm volatile("s_waitcnt vmcnt(" #n ")" ::: "memory"); __builtin_amdgcn_s_barrier(); asm volatile("" ::: "memory"); } while (0)
template <int BR> __device__ __forceinline__ void attn_probs(f32x4 (&st)[4], const AttnFrag& f, const bf16x8 (&qf)[2], const lds_f32* BLh, float Mb, int t, int kb, int q4, bool far_, bool lsel) {
#pragma unroll
    for (int kt = 0; kt < 4; ++kt) { f32x4 z = (f32x4){0.f, 0.f, 0.f, 0.f};
        z = __builtin_amdgcn_mfma_f32_16x16x32_bf16(f.k[kt][0], qf[0], z, 0, 0, 0); st[kt] = __builtin_amdgcn_mfma_f32_16x16x32_bf16(f.k[kt][1], qf[1], z, 0, 0, 0); }
    if (far_) { const float c = BLh[127] - Mb;
#pragma unroll
        for (int kt = 0; kt < 4; ++kt)
#pragma unroll
            for (int e = 0; e < 4; ++e) st[kt][e] = lsel ? __builtin_amdgcn_exp2f(st[kt][e] + c) : 0.f;
    } else {
#pragma unroll
        for (int kt = 0; kt < 4; ++kt)
#pragma unroll
            for (int e = 0; e < 4; ++e) { const int k = kb + 16 * kt + 4 * q4 + e; const int dist = BR < 2 ? t - 16 * k - 31 : t - k;
                const bool ok = lsel && dist >= 0 && (BR != 3 || dist < WIN);
                const int dc = dist < 0 ? 0 : (dist > 127 ? 127 : dist);
                const float p = __builtin_amdgcn_exp2f(st[kt][e] + BLh[dc] - Mb); st[kt][e] = ok ? p : 0.f; }
    }
}
struct AttnAcc { f32x4 o[2][4]; float l[2]; };
__device__ __forceinline__ void attn_acc_zero(AttnAcc& A) {
#pragma unroll
    for (int G = 0; G < 2; ++G) { A.l[G] = 0.f;
#pragma unroll
        for (int dt = 0; dt < 4; ++dt) A.o[G][dt] = (f32x4){0.f, 0.f, 0.f, 0.f}; }
}
template <int BR> __device__ __forceinline__ void attn_block2(AttnAcc& A, const AttnFrag& f, const bf16x8 (&qf)[2][2], const lds_f32* BLh, const float (&Mb)[2], const int (&tq)[2], int kb, int q4, bool far_, const bool (&gact)[2], const bool (&lsel)[2]) {
#pragma unroll
    for (int G = 0; G < 2; ++G) {
        if (!gact[G]) continue;
        f32x4 st[4];
        attn_probs<BR>(st, f, qf[G], BLh, Mb[G], tq[G], kb, q4, far_, lsel[G]);
        float ls = 0.f;
#pragma unroll
        for (int kt = 0; kt < 4; ++kt) ls += (st[kt][0] + st[kt][1]) + (st[kt][2] + st[kt][3]);
        A.l[G] += ls;
        bf16x8 pb[2];
#pragma unroll
        for (int ks = 0; ks < 2; ++ks) { v4u w; w.x = pg8::cvt_pk_bf16(st[2 * ks][0], st[2 * ks][1]); w.y = pg8::cvt_pk_bf16(st[2 * ks][2], st[2 * ks][3]);
            w.z = pg8::cvt_pk_bf16(st[2 * ks + 1][0], st[2 * ks + 1][1]); w.w = pg8::cvt_pk_bf16(st[2 * ks + 1][2], st[2 * ks + 1][3]); pb[ks] = __builtin_bit_cast(bf16x8, w); }
#pragma unroll
        for (int dt = 0; dt < 4; ++dt) { A.o[G][dt] = __builtin_amdgcn_mfma_f32_16x16x32_bf16(f.v[dt][0], pb[0], A.o[G][dt], 0, 0, 0); A.o[G][dt] = __builtin_amdgcn_mfma_f32_16x16x32_bf16(f.v[dt][1], pb[1], A.o[G][dt], 0, 0, 0); }
    }
}
template <int MODE> __device__ __forceinline__ void attn_fold(const AttnAcc& A, float* tot  , const float (&gate)[2], float (&il)[2], bf16* const (&yp)[2]) {
#pragma unroll
    for (int G = 0; G < 2; ++G) { float ls = A.l[G]; ls += __shfl_xor(ls, 16); ls += __shfl_xor(ls, 32);
        il[G] = 1.0f / fmaxf(ls, 1e-30f); const float sc = gate[G] * il[G];
#pragma unroll
        for (int dt = 0; dt < 4; ++dt) { f32x4* tp = (f32x4*)(tot + (G * 4 + dt) * 256); f32x4 v = A.o[G][dt] * sc;
            if (MODE != 0) v += *tp;
            if (MODE != 2) *tp = v;
            else { v2u w; w.x = pk2(v[0], v[1]); w.y = pk2(v[2], v[3]); *(v2u*)(yp[G] + 16 * dt) = w; } } }
}
__device__ __noinline__ void attn_topk(LAS unsigned char* L, int wave, int lane, int cur) {
    const lds_f32* IMP = (const lds_f32*)(L + A2_IMP); LAS unsigned* SELB = (LAS unsigned*)(L + A2_SELB);
    const int sub = lane & 15;
    for (int pass = 0; pass < 2; ++pass) {
        const int q = wave * 8 + pass * 4 + (lane >> 4);
        unsigned word = 0u;
        if (cur < 16) { if (sub == 0) word = (cur >= 31) ? 0xffffffffu : ((1u << (cur + 1)) - 1u); }
        else {
            float v[16];
#pragma unroll
            for (int i = 0; i < 16; ++i) { const int J = 16 * i + sub; v[i] = (J >= 1 && J <= cur - 2) ? IMP[q * 256 + J] : -1.0f; }
            for (int r = 0; r < 13; ++r) {
                float m = v[0];
#pragma unroll
                for (int i = 1; i < 16; ++i) m = fmaxf(m, v[i]);
                m = fmaxf(m, DPP_F(m, 0x128)); m = fmaxf(m, DPP_F(m, 0x124)); m = fmaxf(m, DPP_F(m, 0x122)); m = fmaxf(m, DPP_F(m, 0x121));
                int c = 999;
#pragma unroll
                for (int i = 15; i >= 0; --i) c = (v[i] == m) ? 16 * i + sub : c;
                { int o = DPP_I(c, 0x128); c = o < c ? o : c; o = DPP_I(c, 0x124); c = o < c ? o : c; o = DPP_I(c, 0x122); c = o < c ? o : c; o = DPP_I(c, 0x121); c = o < c ? o : c; }
#pragma unroll
                for (int i = 0; i < 16; ++i) v[i] = (16 * i + sub == c) ? -2.0f : v[i];
                if ((c >> 5) == sub) word |= 1u << (c & 31);
            }
            if (sub == 0) word |= 1u;
            if (((cur - 1) >> 5) == sub) word |= 1u << ((cur - 1) & 31);
            if ((cur >> 5) == sub) word |= 1u << (cur & 31);
        }
        if (sub < 8) SELB[q * 8 + sub] = word;
    }
}

__device__ __forceinline__ void attn2_phase(const Args& a, const Frame& F) {
    LAS unsigned char* L = F.lds + RING_OFF;
    const bf16* Q = WSP(const bf16, WS_Q); const bf16* KV = WSP(const bf16, WS_KV); const bf16* KC = WSP(const bf16, WS_KCMP);
    const bf16* VT = WSP(const bf16, WS_VT2); const bf16* VCT = WSP(const bf16, WS_VCT); const float* GT = WSP(const float, WS_GT); bf16* Y = WSP(bf16, WS_HB);
    const unsigned* kmx = WSP(const unsigned, WS_CTL) + CW_KMAX;
    const int tid = F.tid, lane = F.lane, wave = F.wave, col = lane & 15, q4 = lane >> 4, hh = col & 3;
    float* tot = WSP(float, WS_TOT) + (size_t)F.bid * 16384 + wave * 2048 + lane * 4;
    LAS unsigned char* STG = L + A2_STG;
    for (int uu0 = F.bid; uu0 < 2 * NSLC; uu0 += F.G) {
        const int rnd = uu0 / F.G, ix = uu0 - rnd * F.G;
        int cur, g;
        if (F.G == NSLC) { g = ix & 1; cur = rnd ? NSLC - 1 - (ix >> 1) : (ix >> 1); }
        else { cur = uu0 >> 1; g = uu0 & 1; }
        const int t0 = 64 * cur;
        const bf16* Qg = Q + (size_t)t0 * 512 + g * 256;
        lds_f32* BL = (lds_f32*)(L + A2_BL); lds_f32* MB = (lds_f32*)(L + A2_MB);
        { const int h = tid >> 7, d = tid & 127; BL[tid] = LOG2E * a.in[I_RELB][(g * 4 + h) * 32 + T5_BUCKET[d]]; }
        __syncthreads();
        {   const int q = tid >> 3, h = (tid & 7) >> 1, d0 = (tid & 1) * 32; const v4u* qp = (const v4u*)(Qg + (size_t)q * 512 + h * 64 + d0); float s = 0.f;
#pragma unroll
            for (int c = 0; c < 4; ++c) { const v4u w = qp[c]; s += bflo(w.x) * bflo(w.x) + bfhi(w.x) * bfhi(w.x) + bflo(w.y) * bflo(w.y) + bfhi(w.y) * bfhi(w.y) + bflo(w.z) * bflo(w.z) + bfhi(w.z) * bfhi(w.z) + bflo(w.w) * bflo(w.w) + bfhi(w.w) * bfhi(w.w); }
            s += __shfl_xor(s, 1); const float qn = sqrtf(s);
            float bm = -3.0e38f;
            for (int d = 0; d < 128; ++d) bm = fmaxf(bm, BL[h * 128 + d]);
            if ((tid & 1) == 0) {
#pragma unroll
                for (int b = 0; b < 3; ++b) MB[b * 256 + q * 4 + h] = qn * sqrtf(__uint_as_float(kmx[2 * b + g])) * 1.001f + bm + 0.5f; }
        }
        __syncthreads();
        const lds_f32* BLh = BL + hh * 128;
        bf16x8 qf[2][2]; int tq[2];
#pragma unroll
        for (int G = 0; G < 2; ++G) { const int q = wave * 8 + G * 4 + (col >> 2); tq[G] = t0 + q;
            const bf16* qp = Qg + (size_t)q * 512 + hh * 64 + 8 * q4; qf[G][0] = *(const bf16x8*)qp; qf[G][1] = *(const bf16x8*)(qp + 32); }
#define A2_LOADM(M, b) float M[2]; _Pragma("unroll") for (int G = 0; G < 2; ++G) M[G] = MB[(b) * 256 + (wave * 8 + G * 4 + (col >> 2)) * 4 + hh]
#define A2_LOADG(gv, b) float gv[2]; _Pragma("unroll") for (int G = 0; G < 2; ++G) gv[G] = GT[(size_t)(t0 + wave * 8 + G * 4 + (col >> 2)) * 24 + (g * 4 + hh) * 3 + (b)]
        const int twlo = t0 + 8 * wave, twhi = twlo + 7;
        const bool all2[2] = {true, true};
        const int tmax = t0 + 63, nvu = tmax >= 31 ? ((tmax - 31) >> 4) + 1 : 0, nbu = (nvu + 63) >> 6;
        float il[2];
        AttnFrag fc; AttnAcc A;
        A2_LOADM(Mc, 0);
        attn_acc_zero(A);
#define KC_BLK(j) (KC + (size_t)(64 * (j)) * 128 + g * 64)
#define VC_BLK(j) (VCT + (size_t)(g * 16 + (j)) * 4096)
        {   const int last = nbu - 1;
#pragma unroll
            for (int p = 0; p < RB - 1; ++p) { const int jb = p < last ? p : last; dma_issue<true>(STG + p * STG_BUF, KC_BLK(jb), 128, VC_BLK(jb), wave, lane); }
            for (int jc = 0; jc < nbu; ++jc) {
                A2_WAITBAR(4);
                { const int jn = jc + RB - 1 < last ? jc + RB - 1 : last; dma_issue<true>(STG + ((jc + RB - 1) % RB) * STG_BUF, KC_BLK(jn), 128, VC_BLK(jn), wave, lane); }
                if (twhi - 16 * (64 * jc) - 31 >= 0) { frag_from_lds<true>(fc, STG + (jc % RB) * STG_BUF, col, q4);
                    attn_block2<0>(A, fc, qf, BLh, Mc, tq, 64 * jc, q4, twlo - 16 * (64 * jc + 63) - 31 >= 113, all2, all2); }
            }
            A2_WAITBAR(0);
        }
        { A2_LOADG(gc, 0); bf16* const ypn[2] = {nullptr, nullptr}; attn_fold<0>(A, tot, gc, il, ypn); }
        __syncthreads();
        if (cur >= 16) {
            lds_f32* IMP = (lds_f32*)(L + A2_IMP);
            float carry[2] = {0.f, 0.f};
            const int last = nbu - 1;
#pragma unroll
            for (int p = 0; p < RB - 1; ++p) { const int jb = p < last ? p : last; dma_issue<false>(STG + p * STG_BUF, KC_BLK(jb), 128, nullptr, wave, lane); }
            for (int jc = 0; jc < nbu; ++jc) {
                A2_WAITBAR(2);
                { const int jn = jc + RB - 1 < last ? jc + RB - 1 : last; dma_issue<false>(STG + ((jc + RB - 1) % RB) * STG_BUF, KC_BLK(jn), 128, nullptr, wave, lane); }
                const LAS unsigned char* buf = STG + (jc % RB) * STG_BUF;
                if (twhi - 16 * (64 * jc) - 31 < 0) continue;
                frag_from_lds<false>(fc, buf, col, q4);
#pragma unroll
                for (int G = 0; G < 2; ++G) { f32x4 st[4];
                    attn_probs<1>(st, fc, qf[G], BLh, Mc[G], tq[G], 64 * jc, q4, twlo - 16 * (64 * jc + 63) - 31 >= 113, true);
                    float s4[4], rot[4];
#pragma unroll
                    for (int kt = 0; kt < 4; ++kt) { float x3 = st[kt][3] * il[G], x4 = (st[kt][0] + st[kt][1] + st[kt][2]) * il[G] + x3;
                        x4 += DPP_F(x4, 0xB1); x4 += DPP_F(x4, 0x4E); x3 += DPP_F(x3, 0xB1); x3 += DPP_F(x3, 0x4E); s4[kt] = x4;
                        rot[kt] = __shfl(x3, (lane + 48) & 63); }
                    const int q = wave * 8 + G * 4 + (col >> 2);
#pragma unroll
                    for (int kt = 0; kt < 4; ++kt) { const float prev = q4 > 0 ? rot[kt] : (kt > 0 ? rot[kt - 1] : carry[G]);
                        if (hh == 0) IMP[q * 256 + 16 * jc + 4 * kt + q4] = s4[kt] + prev; }
                    carry[G] = rot[3];
                }
            }
            A2_WAITBAR(0);
        }
        attn_topk(L, wave, lane, cur);
        {   const LAS unsigned* SELB = (const LAS unsigned*)(L + A2_SELB);
            A2_LOADM(Ms, 1);
            attn_acc_zero(A);
#define KS_BLK(j) (KV + (size_t)(64 * (j)) * 768 + 256 + g * 64)
#define VS_BLK(j) (VT + (size_t)((0 * 2 + g) * 256 + (j)) * 4096)
#pragma unroll
            for (int p = 0; p < RB - 1; ++p) { const int jb = p < cur ? p : cur; dma_issue<true>(STG + p * STG_BUF, KS_BLK(jb), 768, VS_BLK(jb), wave, lane); }
            for (int j = 0; j <= cur; ++j) {
                A2_WAITBAR(4);
                { const int jn = j + RB - 1 < cur ? j + RB - 1 : cur; dma_issue<true>(STG + ((j + RB - 1) % RB) * STG_BUF, KS_BLK(jn), 768, VS_BLK(jn), wave, lane); }
                const LAS unsigned char* buf = STG + (j % RB) * STG_BUF;
                bool lsel[2], gact[2];
#pragma unroll
                for (int G = 0; G < 2; ++G) { lsel[G] = (SELB[(wave * 8 + G * 4 + (col >> 2)) * 8 + (j >> 5)] >> (j & 31)) & 1u; gact[G] = __ballot(lsel[G]) != 0ull; }
                if (gact[0] || gact[1]) { frag_from_lds<true>(fc, buf, col, q4);
                    attn_block2<2>(A, fc, qf, BLh, Ms, tq, 64 * j, q4, twlo - (64 * j + 63) >= 113, gact, lsel); }
            }
            A2_WAITBAR(0);
            A2_LOADG(gs, 1); float il2[2]; bf16* const ypn[2] = {nullptr, nullptr}; attn_fold<1>(A, tot, gs, il2, ypn);
        }
        __syncthreads();
        {   const int jlo = cur >= 8 ? cur - 8 : 0;
            A2_LOADM(Mw, 2);
            attn_acc_zero(A);
#define KW_BLK(j) (KV + (size_t)(64 * (j)) * 768 + 512 + g * 64)
#define VW_BLK(j) (VT + (size_t)((1 * 2 + g) * 256 + (j)) * 4096)
#pragma unroll
            for (int p = 0; p < RB - 1; ++p) { const int jb = jlo + p < cur ? jlo + p : cur; dma_issue<true>(STG + p * STG_BUF, KW_BLK(jb), 768, VW_BLK(jb), wave, lane); }
            for (int j = jlo; j <= cur; ++j) {
                A2_WAITBAR(4);
                { const int jn = j + RB - 1 < cur ? j + RB - 1 : cur; dma_issue<true>(STG + ((j - jlo + RB - 1) % RB) * STG_BUF, KW_BLK(jn), 768, VW_BLK(jn), wave, lane); }
                const LAS unsigned char* buf = STG + ((j - jlo) % RB) * STG_BUF;
                if (64 * j <= twhi && 64 * j + 63 >= twlo - (WIN - 1)) { frag_from_lds<true>(fc, buf, col, q4);
                    attn_block2<3>(A, fc, qf, BLh, Mw, tq, 64 * j, q4, (twlo - (64 * j + 63) >= 113) && (twhi - 64 * j < WIN), all2, all2); }
            }
            A2_WAITBAR(0);
            A2_LOADG(gw, 2); float il2[2]; bf16* yp[2];
#pragma unroll
            for (int G = 0; G < 2; ++G) yp[G] = Y + (size_t)(t0 + wave * 8 + G * 4 + (col >> 2)) * DM + 512 + (g * 4 + hh) * 64 + 4 * q4;
            attn_fold<2>(A, tot, gw, il2, yp);
        }
        __syncthreads();
    }
}
__global__ void __launch_bounds__(NWAVES * 64, 2) fwd_kernel(Args a) {
    extern __shared__ __attribute__((aligned(16))) unsigned char lds[];
    Frame F;
    F.lds = (LAS unsigned char*)lds;
    F.tid = threadIdx.x; F.lane = F.tid & 63; F.wave = __builtin_amdgcn_readfirstlane(F.tid >> 6);
    F.G = gridDim.x; F.bid = blockIdx.x;
    volatile LAS unsigned* MISC = (volatile LAS unsigned*)(F.lds + MISC_OFF);
    for (int u = F.tid; u < (LDS_BYTES - LDSCTL_OFF) / 4; u += NWAVES * 64) ((LAS unsigned*)(F.lds + LDSCTL_OFF))[u] = 0u;
    __syncthreads();
    const int lo = a.ph_lo, hi = a.ph_hi;
    const bool multi = (hi - lo) > 1;
    unsigned* barw = WSP(unsigned, WS_CTL) + CW_BAR;
    XcdBarrier bar; bar.bar = barw; bar.x = 0; bar.st = MISC + 8;
    if (multi) bar = xcd_barrier_post(barw, MISC + 8);
#ifndef REP_MASK
#define REP_MASK 0
#endif
#define IN(k) (lo <= (k) && (k) < hi)
#define REPS(k) (((REP_MASK >> (k)) & 1) ? 2 : 1)
#define SEAM(k) do { if (IN(k) && IN((k) + 1)) xcd_barrier(bar); } while (0)
    PG8_LAS unsigned char* ring = F.lds + RING_OFF;

    if (IN(0)) for (int rep_ = 0; rep_ < REPS(0); ++rep_) { if (rep_) xcd_barrier(bar); p0_prologue(a, F); } SEAM(0);
    if (IN(1)) for (int rep_ = 0; rep_ < REPS(1); ++rep_) { if (rep_) xcd_barrier(bar); norm_mod_pass<true>(a, F, a.in[I_X], WSP(bf16, WS_HB), a.in[I_GFFN1], 0); } SEAM(1);
    if (IN(2)) for (int rep_ = 0; rep_ < REPS(2); ++rep_) { if (rep_) xcd_barrier(bar);
        pg8::Gemm g{WSP(const bf16, WS_HB), WSP(const bf16, WS_WGU1), SEQ, 2 * DFF, DM}; pg8::StaticOrder S; S.init(SEQ, 2 * DFF, F.G, F.bid);
        pg8::EpiSwiGLU E{WSP(bf16, WS_ACT), DFF};
        pg8::gemm_phase<pg8::EpiSwiGLU, pg8::StaticOrder, PG8_ALIGN, PG8_SP2>(ring, g, S, E);
    } SEAM(2);
    if (IN(3)) for (int rep_ = 0; rep_ < REPS(3); ++rep_) { if (rep_) xcd_barrier(bar);
        pg8::Gemm g{WSP(const bf16, WS_ACT), WSP(const bf16, WS_WD1), SEQ, DM, DFF}; pg8::StaticOrder S; S.init(SEQ, DM, F.G, F.bid);
        pg8::EpiResid E{a.in[I_X], WSP(float, WS_XB), DM, WSP(const float, WS_MOD) + 2 * DM, 0.5f};
        pg8::gemm_phase<pg8::EpiResid, pg8::StaticOrder, false, PG8_SP2>(ring, g, S, E);
    } SEAM(3);
    if (IN(4)) for (int rep_ = 0; rep_ < REPS(4); ++rep_) { if (rep_) xcd_barrier(bar); norm_mod_pass<false>(a, F, WSP(const float, WS_XB), WSP(bf16, WS_HB), a.in[I_GMIX], 1); } SEAM(4);
    if (IN(5)) for (int rep_ = 0; rep_ < REPS(5); ++rep_) { if (rep_) xcd_barrier(bar);
        pg8::Gemm g{WSP(const bf16, WS_HB), WSP(const bf16, WS_WIN), SEQ, DIN_PAD, DM}; pg8::StaticOrder S; S.init(SEQ, DIN_PAD, F.G, F.bid);
        pg8::EpiMix E{WSP(bf16, WS_HG), WSP(bf16, WS_Q), WSP(bf16, WS_KV), WSP(float, WS_GT)};
        pg8::gemm_phase<pg8::EpiMix, pg8::StaticOrder, PG8_ALIGN, PG8_SP2>(ring, g, S, E);
    } SEAM(5);
    if (IN(6)) for (int rep_ = 0; rep_ < REPS(6); ++rep_) { if (rep_) xcd_barrier(bar); conv_phase(a, F); kv_prep_phase(a, F); compress_phase(a, F); } SEAM(6);
    if (IN(7)) for (int rep_ = 0; rep_ < REPS(7); ++rep_) { if (rep_) xcd_barrier(bar); attn2_phase(a, F); } SEAM(7);
    if (IN(8)) for (int rep_ = 0; rep_ < REPS(8); ++rep_) { if (rep_) xcd_barrier(bar);
        pg8::Gemm g{WSP(const bf16, WS_HB), WSP(const bf16, WS_WOUT), SEQ, DM, DM}; pg8::StaticOrder S; S.init(SEQ, DM, F.G, F.bid);
        pg8::EpiResid E{WSP(const float, WS_XB), WSP(float, WS_XB), DM, WSP(const float, WS_MOD) + 5 * DM, 1.0f};
        pg8::gemm_phase<pg8::EpiResid, pg8::StaticOrder, false, PG8_SP2>(ring, g, S, E);
    } SEAM(8);
    if (IN(9)) for (int rep_ = 0; rep_ < REPS(9); ++rep_) { if (rep_) xcd_barrier(bar); norm_mod_pass<false>(a, F, WSP(const float, WS_XB), WSP(bf16, WS_HB), a.in[I_GFFN2], 2); } SEAM(9);
    if (IN(10)) for (int rep_ = 0; rep_ < REPS(10); ++rep_) { if (rep_) xcd_barrier(bar);
        pg8::Gemm g{WSP(const bf16, WS_HB), WSP(const bf16, WS_WGU2), SEQ, 2 * DFF, DM}; pg8::StaticOrder S; S.init(SEQ, 2 * DFF, F.G, F.bid);
        pg8::EpiSwiGLU E{WSP(bf16, WS_ACT), DFF};
        pg8::gemm_phase<pg8::EpiSwiGLU, pg8::StaticOrder, PG8_ALIGN, PG8_SP2>(ring, g, S, E);
    } SEAM(10);
    if (IN(11)) for (int rep_ = 0; rep_ < REPS(11); ++rep_) { if (rep_) xcd_barrier(bar);
        pg8::Gemm g{WSP(const bf16, WS_ACT), WSP(const bf16, WS_WD2), SEQ, DM, DFF}; pg8::StaticOrder S; S.init(SEQ, DM, F.G, F.bid);
        pg8::EpiResid E{WSP(const float, WS_XB), a.out, DM, WSP(const float, WS_MOD) + 8 * DM, 0.5f};
        pg8::gemm_phase<pg8::EpiResid, pg8::StaticOrder, false, PG8_SP2>(ring, g, S, E);
    } SEAM(11);
    if (IN(12)) for (int rep_ = 0; rep_ < REPS(12); ++rep_) { if (rep_) xcd_barrier(bar); final_norm_pass(a, F); }
#undef IN
#undef SEAM
}

extern "C" void kernel_launch(void* const* d_in, const int* in_sizes, int n_in, void* d_out, int out_size, void* d_ws, size_t ws_size, hipStream_t stream) {
    static int grid = 0;
    if (grid == 0) {
        if (n_in != N_IN || in_sizes[0] != SEQ * DM || out_size != SEQ * DM || ws_size < WS_END) { fprintf(stderr, "kernel_launch: unexpected problem shape (n_in %d, ws %zu); nothing launched\n", n_in, ws_size); grid = -1; return; }
        int dev = 0, cus = 0, per_cu = 0;
        if (hipGetDevice(&dev) != hipSuccess || hipDeviceGetAttribute(&cus, hipDeviceAttributeMultiprocessorCount, dev) != hipSuccess) { grid = -1; return; }
        if (hipFuncSetAttribute((const void*)fwd_kernel, hipFuncAttributeMaxDynamicSharedMemorySize, LDS_BYTES) != hipSuccess) { fprintf(stderr, "kernel_launch: hipFuncSetAttribute failed\n"); grid = -1; return; }
        if (hipOccupancyMaxActiveBlocksPerMultiprocessor(&per_cu, (const void*)fwd_kernel, NWAVES * 64, LDS_BYTES) != hipSuccess || per_cu < 1)
            fprintf(stderr, "kernel_launch: note: occupancy query reports %d workgroups per CU\n", per_cu);
        (void)hipGetLastError();
        grid = cus;
    }
    if (grid < 0) return;
    if (hipMemsetAsync((char*)d_ws + WS_CTL, 0, CTL_ZERO_BYTES, stream) != hipSuccess) return;
    Args a{};
    for (int i = 0; i < N_IN; ++i) a.in[i] = (const float*)d_in[i];
    a.out = (float*)d_out; a.ws = (unsigned char*)d_ws;
#ifdef PROBE_MODE
    a.probe = PROBE_MODE;
#endif
#if MK_LAUNCHES == 1
    a.ph_lo = 0; a.ph_hi = N_PHASES;
    hipLaunchKernelGGL(fwd_kernel, dim3(grid), dim3(NWAVES * 64), LDS_BYTES, stream, a);
#else
    for (int p = 0; p < N_PHASES; ++p) { a.ph_lo = p; a.ph_hi = p + 1; hipLaunchKernelGGL(fwd_kernel, dim3(grid), dim3(NWAVES * 64), LDS_BYTES, stream, a); }
#endif
}
```

```cpp
#include <hip/hip_runtime.h>
#include <cstdio>
#include <cstdint>
namespace pg8 {
#define PG8_LAS __attribute__((address_space(3)))
typedef unsigned short bf16_t;
typedef short bf16x8 __attribute__((ext_vector_type(8)));
typedef float f32x4 __attribute__((ext_vector_type(4)));
typedef unsigned u32x4 __attribute__((ext_vector_type(4)));
constexpr int BM = 256, BK = 64, HALF = 128, HTB = HALF * BK * 2  , STAGE_BYTES = 8 * HTB, NXCD = 8, WGM = 8;

__host__ __device__ __forceinline__ int lds_byte(int r, int c) { const int st = (r >> 4) * 2 + (c >> 5), rr = r & 15, cc = c & 31, ob = rr * 64 + cc * 2; return st * 1024 + (ob ^ (((ob >> 9) & 1) << 5)); }
__host__ __device__ __forceinline__ void stage_rc(int b, int& R, int& C) { const int st = b / 1024, sb = b % 1024, swz = sb ^ (((sb >> 9) & 1) << 5); R = (st >> 1) * 16 + swz / 64; C = (st & 1) * 32 + (swz % 64) / 2; }
__host__ __device__ __forceinline__ int perm32(int rho) { const int n = rho >> 4, i = rho & 15; return 8 * (i >> 2) + 4 * n + (i & 3); }

struct Unit { int pm, pn; };
struct Gemm { const bf16_t* A; const bf16_t* Bt; int M, N, K; };

struct StaticOrder {
    int nM, nN, nwg, G, c;
    __host__ __device__ void init(int M, int N, int G_, int c_) { nM = M / BM; nN = N / BM; nwg = nM * nN; G = G_; c = c_; }
    __host__ __device__ bool next(int i, Unit& u) const {
        const long L = (long)i * G + c; if (L >= nwg) return false;
        int wgid = (int)L; { const int q = nwg / NXCD, r = nwg % NXCD, xcd = wgid % NXCD, off = wgid / NXCD; wgid = (xcd < r ? xcd * (q + 1) : r * (q + 1) + (xcd - r) * q) + off; }
        const int nig = WGM * nN, gid = wgid / nig, fm = gid * WGM, gsz = (nM - fm) < WGM ? (nM - fm) : WGM;
        u.pm = fm + ((wgid % nig) % gsz); u.pn = (wgid % nig) / gsz; return true;
    }
    __device__ __forceinline__ void a_ready(const Unit&) const {}
    __device__ __forceinline__ void done(const Unit&) const {}
};


__device__ __forceinline__ unsigned cvt_pk_bf16(float lo, float hi) { unsigned r; asm volatile("v_cvt_pk_bf16_f32 %0, %1, %2" : "=v"(r) : "v"(lo), "v"(hi)); return r; }
__device__ __forceinline__ float sigmoid_f(float x) { return __builtin_amdgcn_rcpf(1.0f + __builtin_amdgcn_exp2f(-1.4426950408889634f * x)); }
__device__ __forceinline__ float silu_f(float x) { return x * sigmoid_f(x); }

template <bool GLU> __device__ __forceinline__ void gated_store(const f32x4 (&acc)[2][2][4][2], bf16_t* O, int ldc, int row0, int col0) {
#pragma unroll
    for (int ai = 0; ai < 2; ++ai)
#pragma unroll
        for (int m = 0; m < 4; ++m) { bf16_t* rowp = O + (size_t)(row0 + ai * HALF + m * 16) * ldc + col0;
            float v[8];
#pragma unroll
            for (int n = 0; n < 2; ++n)
#pragma unroll
                for (int e = 0; e < 4; ++e) { const float a = acc[ai][0][m][n][e], b = acc[ai][1][m][n][e]; v[n * 4 + e] = GLU ? a * sigmoid_f(b) : silu_f(a) * b; }
            u32x4 w; w.x = cvt_pk_bf16(v[0], v[1]); w.y = cvt_pk_bf16(v[2], v[3]); w.z = cvt_pk_bf16(v[4], v[5]); w.w = cvt_pk_bf16(v[6], v[7]);
            *(u32x4*)rowp = w; }
}
struct EpiSwiGLU {
    static constexpr bool PERM = true, AFTER_DRAIN = false;
    bf16_t* O; int ldc;
    __device__ __forceinline__ void operator()(const f32x4 (&acc)[2][2][4][2], const Unit& u, int wr, int wc, int fr, int fq) const {
        gated_store<false>(acc, O, ldc, u.pm * BM + wr * 64 + fr, u.pn * HALF + wc * 32 + 8 * fq);
    }
};
struct EpiResid {
    static constexpr bool PERM = false, AFTER_DRAIN = false;
    const float* base; float* out; int ldc; const float* gate; float scale;
    __device__ __forceinline__ void operator()(const f32x4 (&acc)[2][2][4][2], const Unit& u, int wr, int wc, int fr, int fq) const {
        const int col0 = u.pn * BM + wc * 32 + 4 * fq, row0 = u.pm * BM + wr * 64 + fr;
        f32x4 cf[2][2];
#pragma unroll
        for (int bj = 0; bj < 2; ++bj)
#pragma unroll
            for (int n = 0; n < 2; ++n) cf[bj][n] = *(const f32x4*)(gate + col0 + bj * HALF + n * 16) * scale;
#pragma unroll
        for (int ai = 0; ai < 2; ++ai)
#pragma unroll
            for (int m = 0; m < 4; ++m) { const size_t off = (size_t)(row0 + ai * HALF + m * 16) * ldc + col0;
#pragma unroll
                for (int bj = 0; bj < 2; ++bj)
#pragma unroll
                    for (int n = 0; n < 2; ++n) { const f32x4 bs = *(const f32x4*)(base + off + bj * HALF + n * 16); *(f32x4*)(out + off + bj * HALF + n * 16) = bs + cf[bj][n] * acc[ai][bj][m][n]; }
                if (m & 1) asm volatile("" ::: "memory"); }
    }
};
struct EpiMix {
    static constexpr bool PERM = true, AFTER_DRAIN = false;
    bf16_t* HG; bf16_t* Q; bf16_t* KV; float* GT;
    __device__ __forceinline__ void operator()(const f32x4 (&acc)[2][2][4][2], const Unit& u, int wr, int wc, int fr, int fq) const {
        const int row0 = u.pm * BM + wr * 64 + fr, c8 = wc * 32 + 8 * fq;
        if (u.pn < 4) { gated_store<true>(acc, HG, 512, row0, u.pn * HALF + c8); return; }
        if (u.pn == 9) {
            if (c8 < 24) {
#pragma unroll
                for (int ai = 0; ai < 2; ++ai)
#pragma unroll
                    for (int m = 0; m < 4; ++m) { float* rowp = GT + (size_t)(row0 + ai * HALF + m * 16) * 24 + c8;
#pragma unroll
                        for (int n = 0; n < 2; ++n) { const f32x4 a = acc[ai][0][m][n]; *(f32x4*)(rowp + 4 * n) = (f32x4){sigmoid_f(a[0]), sigmoid_f(a[1]), sigmoid_f(a[2]), sigmoid_f(a[3])}; } }
            }
            return;
        }
        bf16_t* O; int ldc, colt; float sc;
        if (u.pn < 6) { O = Q; ldc = 512; colt = (u.pn - 4) * BM; sc = 0.125f * 1.4426950408889634f; } else { O = KV; ldc = 768; colt = (u.pn - 6) * BM; sc = 1.0f; }
#pragma unroll
        for (int ai = 0; ai < 2; ++ai)
#pragma unroll
            for (int m = 0; m < 4; ++m) { bf16_t* rowp = O + (size_t)(row0 + ai * HALF + m * 16) * ldc + colt + c8;
#pragma unroll
                for (int bj = 0; bj < 2; ++bj) { const f32x4 v0 = acc[ai][bj][m][0] * sc, v1 = acc[ai][bj][m][1] * sc;
                    u32x4 w; w.x = cvt_pk_bf16(v0[0], v0[1]); w.y = cvt_pk_bf16(v0[2], v0[3]); w.z = cvt_pk_bf16(v1[0], v1[1]); w.w = cvt_pk_bf16(v1[2], v1[3]);
                    *(u32x4*)(rowp + bj * HALF) = w; } }
    }
};

template <class Epi, class Sched, bool ALIGN_EPI = false, bool SP2 = false>
__device__ __forceinline__ void gemm_phase(PG8_LAS unsigned char* lds, const Gemm g, const Sched& S, const Epi& E) {
    const int tid = threadIdx.x, wid = __builtin_amdgcn_readfirstlane(tid >> 6), lane = tid & 63, wr = wid >> 2, wc = wid & 3, fr = lane & 15, fq = lane >> 4;
    const int K = g.K, nt = K / BK;
    unsigned voffA[2], voffB[2];
#pragma unroll
    for (int i = 0; i < 2; ++i) { int R, C; stage_rc(tid * 16 + i * 8192, R, C); const int Rb = Epi::PERM ? ((R & ~31) + perm32(R & 31)) : R;
        voffA[i] = (unsigned)(R * K + C) * 2u; voffB[i] = (unsigned)(Rb * K + C) * 2u; }
    const size_t kstep = (size_t)(BK * 2);
    const size_t hstep = (size_t)HALF * K * 2;
    const size_t tstep = 2 * hstep;
    const unsigned ldsw = (unsigned)wid * 1024u;
    const int aoff = lds_byte(wr * 64 + fr, fq * 8), boff = lds_byte(wc * 32 + fr, fq * 8);
#define PG8_SA(b, h) (((b) * 2 + (h)) * HTB)
#define PG8_SB(b, h) ((4 + (b) * 2 + (h)) * HTB)
#define PG8_STAGE(bufoff, gbase, voff) do { _Pragma("unroll") for (int _i = 0; _i < 2; ++_i) \
        __builtin_amdgcn_global_load_lds((const unsigned*)((const char*)(gbase) + (voff)[_i]), (PG8_LAS unsigned*)(lds + (bufoff) + ldsw + _i * 8192), 16, 0, 0); } while (0)
#define PG8_LDA(dst, b, h) do { _Pragma("unroll") for (int m = 0; m < 4; ++m) _Pragma("unroll") for (int k = 0; k < 2; ++k) dst[m][k] = *(const PG8_LAS bf16x8*)(lds + PG8_SA(b, h) + aoff + m * 2048 + k * 1024); } while (0)
#define PG8_LDB(dst, b, h) do { _Pragma("unroll") for (int n = 0; n < 2; ++n) _Pragma("unroll") for (int k = 0; k < 2; ++k) dst[n][k] = *(const PG8_LAS bf16x8*)(lds + PG8_SB(b, h) + boff + n * 2048 + k * 1024); } while (0)
#define PG8_MMA(ai, bj, At, Bt) do { __builtin_amdgcn_s_setprio(1); _Pragma("unroll") for (int m = 0; m < 4; ++m) _Pragma("unroll") for (int n = 0; n < 2; ++n) _Pragma("unroll") for (int k = 0; k < 2; ++k) \
        acc[ai][bj][m][n] = __builtin_amdgcn_mfma_f32_16x16x32_bf16(Bt[n][k], At[m][k], acc[ai][bj][m][n], 0, 0, 0); __builtin_amdgcn_s_setprio(0); } while (0)
#define PG8_WAIT_V(n) asm volatile("s_waitcnt vmcnt(" #n ")" ::: "memory")
#define PG8_WAIT_L(n) asm volatile("s_waitcnt lgkmcnt(" #n ")" ::: "memory")
#define PG8_BAR __builtin_amdgcn_s_barrier()
#define PG8_SCHED __builtin_amdgcn_sched_barrier(0)
    Unit cur, nxt; int ui = 0;
    if (!S.next(0, cur)) return;
    f32x4 acc[2][2][4][2];
#pragma unroll
    for (int a = 0; a < 2; ++a)
#pragma unroll
        for (int b = 0; b < 2; ++b)
#pragma unroll
            for (int m = 0; m < 4; ++m)
#pragma unroll
                for (int n = 0; n < 2; ++n) acc[a][b][m][n] = (f32x4){0.f, 0.f, 0.f, 0.f};
    bf16x8 At[4][2], B0[2][2], B1[2][2];
    const char* cA = (const char*)g.A + (size_t)cur.pm * tstep; const char* cB = (const char*)g.Bt + (size_t)cur.pn * tstep;
    S.a_ready(cur);
    if constexpr (SP2) {
        PG8_STAGE(PG8_SB(0, 0), cB, voffB); PG8_STAGE(PG8_SB(0, 1), cB + hstep, voffB); PG8_STAGE(PG8_SA(0, 0), cA, voffA); PG8_STAGE(PG8_SA(0, 1), cA + hstep, voffA);
        if (wr == 1) PG8_BAR;
        PG8_WAIT_V(2); PG8_BAR;
        PG8_STAGE(PG8_SB(1, 0), cB + kstep, voffB); PG8_STAGE(PG8_SA(1, 0), cA + kstep, voffA); PG8_STAGE(PG8_SB(1, 1), cB + hstep + kstep, voffB);
        PG8_WAIT_V(6); PG8_BAR;
    } else {
        PG8_STAGE(PG8_SB(0, 0), cB, voffB); PG8_STAGE(PG8_SA(0, 0), cA, voffA); PG8_STAGE(PG8_SB(0, 1), cB + hstep, voffB); PG8_STAGE(PG8_SA(0, 1), cA + hstep, voffA);
        if (wr == 1) PG8_BAR;
        PG8_WAIT_V(4); PG8_BAR;
        PG8_STAGE(PG8_SB(1, 0), cB + kstep, voffB); PG8_STAGE(PG8_SA(1, 0), cA + kstep, voffA); PG8_STAGE(PG8_SB(1, 1), cB + hstep + kstep, voffB);
        PG8_WAIT_V(6); PG8_BAR;
    }
    for (;;) {
        const bool has_next = S.next(ui + 1, nxt);
        const char* nA = has_next ? (const char*)g.A + (size_t)nxt.pm * tstep : cA; const char* nB = has_next ? (const char*)g.Bt + (size_t)nxt.pn * tstep : cB;
        for (int t = 0; t < nt; t += 2) {
            const bool last = (t == nt - 2);
            const char* a1 = cA + (size_t)(t + 1) * kstep;
            const char* a2 = last ? nA : cA + (size_t)(t + 2) * kstep; const char* b2 = last ? nB : cB + (size_t)(t + 2) * kstep;
            const char* a3 = a2 + kstep; const char* b3 = b2 + kstep;
            if (last && has_next) S.a_ready(nxt);
            if constexpr (SP2) {
            PG8_LDB(B0, 0, 0); PG8_LDB(B1, 0, 1); PG8_SCHED; PG8_LDA(At, 0, 0); PG8_STAGE(PG8_SA(1, 1), a1 + hstep, voffA);
            PG8_WAIT_V(8); PG8_WAIT_L(0); PG8_BAR; PG8_MMA(0, 0, At, B0); PG8_MMA(0, 1, At, B1); PG8_BAR; PG8_SCHED;
            PG8_LDA(At, 0, 1); PG8_STAGE(PG8_SB(0, 0), b2, voffB); PG8_STAGE(PG8_SB(0, 1), b2 + hstep, voffB); PG8_STAGE(PG8_SA(0, 0), a2, voffA);
            PG8_WAIT_V(8); PG8_WAIT_L(0); PG8_BAR; PG8_MMA(1, 0, At, B0); PG8_MMA(1, 1, At, B1); PG8_BAR; PG8_SCHED;
            PG8_LDB(B0, 1, 0); PG8_LDB(B1, 1, 1); PG8_SCHED; PG8_LDA(At, 1, 0); PG8_STAGE(PG8_SA(0, 1), a2 + hstep, voffA);
            PG8_WAIT_V(8); PG8_WAIT_L(0); PG8_BAR; PG8_MMA(0, 0, At, B0); PG8_MMA(0, 1, At, B1); PG8_BAR; PG8_SCHED;
            PG8_LDA(At, 1, 1); PG8_STAGE(PG8_SB(1, 0), b3, voffB); PG8_STAGE(PG8_SB(1, 1), b3 + hstep, voffB); PG8_STAGE(PG8_SA(1, 0), a3, voffA);
            PG8_WAIT_V(8); PG8_WAIT_L(0); PG8_BAR; PG8_MMA(1, 0, At, B0); PG8_MMA(1, 1, At, B1); PG8_BAR; PG8_SCHED;
            } else {
            PG8_LDB(B0, 0, 0); PG8_SCHED; PG8_LDA(At, 0, 0); PG8_STAGE(PG8_SA(1, 1), a1 + hstep, voffA);
            PG8_WAIT_L(8); PG8_BAR; PG8_WAIT_L(0); PG8_MMA(0, 0, At, B0); PG8_BAR; PG8_SCHED;
            PG8_LDB(B1, 0, 1); PG8_STAGE(PG8_SB(0, 0), b2, voffB);
            PG8_BAR; PG8_WAIT_L(0); PG8_MMA(0, 1, At, B1); PG8_BAR;
            PG8_LDA(At, 0, 1); PG8_STAGE(PG8_SA(0, 0), a2, voffA);
            PG8_BAR; PG8_WAIT_L(0); PG8_MMA(1, 0, At, B0); PG8_BAR; PG8_SCHED;
            PG8_STAGE(PG8_SB(0, 1), b2 + hstep, voffB);
            PG8_WAIT_V(6); PG8_BAR; PG8_MMA(1, 1, At, B1); PG8_BAR;
            PG8_LDB(B0, 1, 0); PG8_SCHED; PG8_LDA(At, 1, 0); PG8_STAGE(PG8_SA(0, 1), a2 + hstep, voffA);
            PG8_WAIT_L(8); PG8_BAR; PG8_WAIT_L(0); PG8_MMA(0, 0, At, B0); PG8_BAR; PG8_SCHED;
            PG8_LDB(B1, 1, 1); PG8_STAGE(PG8_SB(1, 0), b3, voffB);
            PG8_BAR; PG8_WAIT_L(0); PG8_MMA(0, 1, At, B1); PG8_BAR;
            PG8_LDA(At, 1, 1); PG8_STAGE(PG8_SA(1, 0), a3, voffA);
            PG8_BAR; PG8_WAIT_L(0); PG8_MMA(1, 0, At, B0); PG8_BAR; PG8_SCHED;
            PG8_STAGE(PG8_SB(1, 1), b3 + hstep, voffB);
            PG8_WAIT_V(6); PG8_BAR; PG8_MMA(1, 1, At, B1); PG8_BAR;
            }
        }
        if constexpr (ALIGN_EPI) { if (wr == 0) PG8_BAR; }
        if constexpr (!Epi::AFTER_DRAIN) { E(acc, cur, wr, wc, fr, fq); S.done(cur); }
        if (!has_next) break;
#pragma unroll
        for (int a = 0; a < 2; ++a)
#pragma unroll
            for (int b = 0; b < 2; ++b)
#pragma unroll
                for (int m = 0; m < 4; ++m)
#pragma unroll
                    for (int n = 0; n < 2; ++n) acc[a][b][m][n] = (f32x4){0.f, 0.f, 0.f, 0.f};
        cur = nxt; cA = nA; cB = nB; ++ui;
        if constexpr (ALIGN_EPI) { if (wr == 1) PG8_BAR; }
    }
    PG8_WAIT_V(0);
    if constexpr (!ALIGN_EPI) { if (wr == 0) PG8_BAR; }
    PG8_BAR;
    if constexpr (Epi::AFTER_DRAIN) { E.fused(acc, cur, wr, wc, fr, fq, lds, wid, lane); S.done(cur); }
#undef PG8_SA
#undef PG8_SB
#undef PG8_STAGE
#undef PG8_LDA
#undef PG8_LDB
#undef PG8_MMA
#undef PG8_WAIT_V
#undef PG8_WAIT_L
#undef PG8_BAR
#undef PG8_SCHED
}
}
#ifndef PG8_SP2
#define PG8_SP2 true
#endif
#ifndef PG8_ALIGN
#define PG8_ALIGN true
#endif
#ifndef MK_LAUNCHES
#define MK_LAUNCHES 1
#endif

constexpr int NWAVES = 8;
constexpr int SEQ = 16384, DM = 1024, DFF = 2816, DCONV = 512, DATT = 512, NH = 8, NG = 2, HPG = 4, HD = 64;
constexpr int DIN = 2328, DIN_PAD = 2560, NCMP = 1023, CONVW = 31, CMP_HID = 128, NSLC = 256, NTOP = 16, WIN = 512;
constexpr float EPS = 1e-6f;
constexpr int N_PHASES = 13;
enum { I_X = 0, I_C, I_WADA, I_BADA, I_GFFN1, I_WGU1, I_WD1, I_GMIX, I_WIN, I_WDW, I_BDW, I_LNG, I_LNB, I_PEK, I_PEV, I_WCK1, I_WCK2, I_WCV1, I_WCV2, I_RELB, I_WOUT, I_GFFN2, I_WGU2, I_WD2, I_GFIN, N_IN };

constexpr size_t MiB = 1u << 20;
constexpr size_t WS_CTL = 0, CTL_ZERO_BYTES = 64 * 1024;
constexpr size_t WS_MODP = 1 * MiB;
constexpr size_t WS_MOD = WS_MODP + 16 * 9216 * 4;
constexpr size_t WS_KCMP = 2 * MiB, WS_VCMP = WS_KCMP + 256 * 1024;
constexpr size_t WS_WGU1 = 4 * MiB, WS_WD1 = 15 * MiB, WS_WIN = 21 * MiB, WS_WOUT = 26 * MiB, WS_WGU2 = 28 * MiB, WS_WD2 = 39 * MiB;
constexpr size_t WS_GT = 45 * MiB;
constexpr size_t WS_HB = 48 * MiB;
constexpr size_t WS_XB = 80 * MiB;
constexpr size_t WS_ACT = 144 * MiB;
constexpr size_t WS_HG = WS_ACT, WS_Q = WS_ACT + 16 * MiB, WS_KV = WS_ACT + 32 * MiB;
constexpr size_t WS_ACT_END = 232 * MiB, WS_END = 240 * MiB;
static_assert(WS_WD2 + (size_t)DM * DFF * 2 <= WS_GT && WS_GT + (size_t)SEQ * 24 * 4 <= WS_HB && WS_KV + (size_t)SEQ * 768 * 2 <= WS_ACT_END && WS_ACT + (size_t)SEQ * DFF * 2 <= WS_ACT_END, "d_ws map");
constexpr int CW_BAR = 4096;
constexpr int RING_OFF = 0, RING_BYTES = 131072;
constexpr int LDS_BYTES = 163840;
constexpr int LDSCTL_OFF = LDS_BYTES - 1024, MISC_OFF = LDSCTL_OFF + 320;

#define GAS __attribute__((address_space(1)))
#define LAS __attribute__((address_space(3)))
typedef unsigned short bf16;
typedef unsigned v4u __attribute__((ext_vector_type(4)));
typedef unsigned v2u __attribute__((ext_vector_type(2)));
typedef float f32x4 __attribute__((ext_vector_type(4)));
typedef float f32x2 __attribute__((ext_vector_type(2)));
typedef short bf16x8 __attribute__((ext_vector_type(8)));
typedef GAS unsigned gu32;
#define RLX_AGENT __ATOMIC_RELAXED, __HIP_MEMORY_SCOPE_AGENT
__device__ __forceinline__ unsigned f2bf(float f) { unsigned u = __builtin_bit_cast(unsigned, f); return (u + 0x7fffu + ((u >> 16) & 1u)) >> 16; }
__device__ __forceinline__ unsigned pk2(float lo, float hi) { return f2bf(lo) | (f2bf(hi) << 16); }
__device__ __forceinline__ float bflo(unsigned w) { return __uint_as_float(w << 16); }
__device__ __forceinline__ float bfhi(unsigned w) { return __uint_as_float(w & 0xffff0000u); }
__device__ __forceinline__ float bf2f(bf16 b) { return __uint_as_float((unsigned)b << 16); }
__device__ __forceinline__ float sigmoid_f(float x) { return __builtin_amdgcn_rcpf(1.0f + __builtin_amdgcn_exp2f(-1.4426950408889634f * x)); }
__device__ __forceinline__ float silu_f(float x) { return x * sigmoid_f(x); }
__device__ __forceinline__ float wave_sum(float v) {
#pragma unroll
    for (int o = 1; o < 64; o <<= 1) v += __shfl_xor(v, o);
    return v;
}
__device__ __forceinline__ float wave_max(float v) {
#pragma unroll
    for (int o = 1; o < 64; o <<= 1) v = fmaxf(v, __shfl_xor(v, o));
    return v;
}

#define XB_TMO      128
#define XB_XCNT(j)  (256  + 64 * (j))
#define XB_XSUB(j)  (1280 + 64 * (j))
#define XB_XGEN(j)  (2304 + 64 * (j))
#define XB_TOP      3328
#define XB_TOPGEN   3392
#define XCD_BAR_WORDS 3456
#define XB_SPIN_CAP (1u << 18)
static_assert((CW_BAR + XCD_BAR_WORDS) * 4 <= (int)CTL_ZERO_BYTES, "barrier words inside the memset region");

__device__ __forceinline__ unsigned xb_ld(unsigned* p)              { return __hip_atomic_load(p, __ATOMIC_RELAXED, __HIP_MEMORY_SCOPE_AGENT); }
__device__ __forceinline__ unsigned xb_add(unsigned* p, unsigned v) { return __hip_atomic_fetch_add(p, v, __ATOMIC_RELAXED, __HIP_MEMORY_SCOPE_AGENT); }
__device__ __forceinline__ unsigned xb_xcc_id() { return (unsigned)__builtin_amdgcn_s_getreg((3 << 11) | 20) & 0xFu; }
#define XB_SPIN(cond, bar) do { unsigned _sp = 0; while (cond) { __builtin_amdgcn_s_sleep(1); \
    if ((++_sp & 255u) == 0u) { if (xb_ld(&(bar)[XB_TMO])) break; if (_sp > XB_SPIN_CAP) { atomicAdd(&(bar)[XB_TMO], 1u); break; } } } } while (0)

struct XcdBarrier {
    unsigned* bar; unsigned x;
    volatile LAS unsigned* st;
};
__device__ __forceinline__ XcdBarrier xcd_barrier_post(unsigned* bar, volatile LAS unsigned* st) {
    XcdBarrier b; b.bar = bar; b.x = xb_xcc_id(); b.st = st;
    if (threadIdx.x == 0) (void)xb_add(&bar[XB_XCNT(b.x)], 1u);
    return b;
}
__device__ __forceinline__ void xcd_barrier_complete(unsigned* bar, unsigned x, unsigned& nloc, unsigned& nx) {
    const unsigned G = gridDim.x * gridDim.y * gridDim.z;
    unsigned sum, cnt, mine, sp = 0u;
    for (;;) {
        sum = 0u; cnt = 0u; mine = 0u;
#pragma unroll
        for (unsigned j = 0; j < 16; ++j) { const unsigned c = xb_ld(&bar[XB_XCNT(j)]); sum += c; cnt += (c > 0u) ? 1u : 0u; mine = (j == x) ? c : mine; }
        if (sum == G) break;
        __builtin_amdgcn_s_sleep(1);
        if ((++sp & 255u) == 0u) { if (xb_ld(&bar[XB_TMO])) break; if (sp > XB_SPIN_CAP) { atomicAdd(&bar[XB_TMO], 1u); break; } }
    }
    nloc = mine > 0u ? mine : 1u; nx = cnt > 0u ? cnt : 1u;
}
__device__ __forceinline__ void xcd_barrier(const XcdBarrier& b) {
    asm volatile("s_waitcnt vmcnt(0)" ::: "memory");
    __syncthreads();
    if (threadIdx.x == 0) {
        unsigned* bar = b.bar;
        __builtin_amdgcn_s_waitcnt(0);
        unsigned nloc = b.st[0], nx = b.st[1];
        if (nloc == 0u) { xcd_barrier_complete(bar, b.x, nloc, nx); b.st[0] = nloc; b.st[1] = nx; }
        const unsigned old = xb_add(&bar[XB_XSUB(b.x)], 1u);
        const unsigned gen = old / nloc;
        if (old + 1u == (gen + 1u) * nloc) {
            __builtin_amdgcn_fence(__ATOMIC_RELEASE, "agent");
            asm volatile("s_waitcnt vmcnt(0)" ::: "memory");
            const unsigned og = xb_add(&bar[XB_TOP], 1u);
            const unsigned tg = og / nx;
            if (og + 1u == (tg + 1u) * nx) xb_add(&bar[XB_TOPGEN], 1u);
            else XB_SPIN(xb_ld(&bar[XB_TOPGEN]) == tg, bar);
            __builtin_amdgcn_fence(__ATOMIC_ACQUIRE, "agent");
            xb_add(&bar[XB_XGEN(b.x)], 1u);
            asm volatile("s_waitcnt vmcnt(0)" ::: "memory");
        } else {
            XB_SPIN(xb_ld(&bar[XB_XGEN(b.x)]) == gen, bar);
            __builtin_amdgcn_fence(__ATOMIC_ACQUIRE, "agent");
            asm volatile("s_waitcnt vmcnt(0)" ::: "memory");
        }
    }
    __syncthreads();
}

struct Args { const float* in[N_IN]; float* out; unsigned char* ws; int ph_lo, ph_hi, probe, pad; };
static_assert(sizeof(Args) == (N_IN + 2) * 8 + 16, "Args has no padding");
struct Frame {
    LAS unsigned char* lds;
    int tid, lane, wave, G, bid;
};
#define WSP(T, off) ((T*)(a.ws + (off)))

__device__ const unsigned char T5_BUCKET[128] = {0, 1, 2, 3, 4, 5, 6, 7, 8, 9, 10, 11, 12, 13, 14, 15, 16, 16, 16, 17, 17, 18, 18, 18, 19, 19, 19, 20, 20, 20, 20, 21, 21, 21, 21, 22, 22, 22, 22, 22, 23, 23, 23, 23, 23, 23, 24, 24, 24, 24, 24, 24, 25, 25, 25, 25, 25, 25, 25, 26, 26, 26, 26, 26, 26, 26, 26, 27, 27, 27, 27, 27, 27, 27, 27, 27, 27, 28, 28, 28, 28, 28, 28, 28, 28, 28, 28, 29, 29, 29, 29, 29, 29, 29, 29, 29, 29, 29, 29, 30, 30, 30, 30, 30, 30, 30, 30, 30, 30, 30, 30, 30, 30, 31, 31, 31, 31, 31, 31, 31, 31, 31, 31, 31, 31, 31, 31, 31};
__host__ __device__ __forceinline__ int vt_perm(int r) { return (r & 32) + 8 * ((r >> 2) & 3) + 4 * ((r >> 4) & 1) + (r & 3); }
__host__ __device__ __forceinline__ int vt_iperm(int p) { return (p & 32) + 16 * ((p >> 2) & 1) + 4 * ((p >> 3) & 3) + (p & 3); }
constexpr int CW_KMAX = 1024;
constexpr size_t WS_VT2 = 200 * MiB;
constexpr size_t WS_VCT = 208 * MiB;
static_assert(WS_VCT + 2 * 16 * 64 * 64 * 2 <= WS_ACT_END, "ws map (attention prep)");
constexpr size_t WS_W1T = 232 * MiB;
constexpr size_t WS_B1P = WS_W1T + 2 * 128 * 2048 * 2;
static_assert(WS_B1P + 16 * 256 * 4 <= 240 * MiB, "ws map (compress)");
template <int MODE> __device__ __forceinline__ int wt_row0(int n0) {
    if (MODE == 1) { const int isu = n0 >= DFF ? 1 : 0, c = n0 - isu * DFF; return 256 * (c >> 7) + 128 * isu + (c & 127); }
    if (MODE == 2) { if (n0 < 512) return 256 * (n0 >> 7) + (n0 & 127); if (n0 < 1024) { const int c = n0 - 512; return 256 * (c >> 7) + 128 + (c & 127); } return n0; }
    return n0;
}
template <int MODE> __device__ __forceinline__ void p0_transpose_item(const float* W, int K, int N, bf16* WT, LAS float* scr, int item, int lane) {
    const int nblk = (N + 31) / 32, kb = item / nblk, nb = item % nblk, k0 = 64 * kb, n0 = 32 * nb;
    const int nn = n0 + (lane & 31); const bool okn = nn < N;
#pragma unroll 8
    for (int i = 0; i < 32; ++i) { const int kk = 2 * i + (lane >> 5); scr[kk * 33 + (lane & 31)] = okn ? W[(size_t)(k0 + kk) * N + nn] : 0.f; }
    asm volatile("s_waitcnt lgkmcnt(0)" ::: "memory");
    const int c = lane & 7, r0 = wt_row0<MODE>(n0);
#pragma unroll
    for (int j = 0; j < 4; ++j) { const int n = (lane >> 3) + 8 * j; const LAS float* s = scr + (8 * c) * 33 + n;
        v4u o; o.x = pk2(s[0 * 33], s[1 * 33]); o.y = pk2(s[2 * 33], s[3 * 33]); o.z = pk2(s[4 * 33], s[5 * 33]); o.w = pk2(s[6 * 33], s[7 * 33]);
        *(v4u*)(WT + (size_t)(r0 + n) * K + k0 + 8 * c) = o; }
    asm volatile("s_waitcnt lgkmcnt(0)" ::: "memory");
}
__device__ __forceinline__ void p0_prologue(const Args& a, const Frame& F) {
    LAS float* scr = (LAS float*)(F.lds + RING_OFF + F.wave * 16384);
    const int gw = F.bid * NWAVES + F.wave, NGW = F.G * NWAVES;
    constexpr int I_GU = (DM / 64) * (2 * DFF / 32), I_D = (DFF / 64) * (DM / 32), I_IN = (DM / 64) * ((DIN + 31) / 32), I_O = (DM / 64) * (DM / 32);
    constexpr int I_MOD = 144 * 16, I_PAD = (DIN_PAD - 2336) * DM / 8 / 64, I_W1 = (2048 / 64) * (128 / 32), I_B1 = 2 * 2 * 16;
    constexpr int NITEMS = 2 * I_GU + 2 * I_D + I_IN + I_O + I_MOD + I_PAD + 2 * I_W1 + I_B1;
    for (int it = gw; it < NITEMS; it += NGW) {
        int r = it;
        if (r < I_MOD) {
            const int cg = r >> 4, kc = r & 15; const float* W = a.in[I_WADA] + (size_t)(kc * 64) * 9216 + cg * 64 + F.lane; const float* cv = a.in[I_C] + kc * 64;
            float s = 0.f;
#pragma unroll 16
            for (int k = 0; k < 64; ++k) s += silu_f(cv[k]) * W[(size_t)k * 9216];
            WSP(float, WS_MODP)[kc * 9216 + cg * 64 + F.lane] = s; continue; }
        r -= I_MOD;
        if (r < I_GU) { p0_transpose_item<1>(a.in[I_WGU1], DM, 2 * DFF, WSP(bf16, WS_WGU1), scr, r, F.lane); continue; } r -= I_GU;
        if (r < I_GU) { p0_transpose_item<1>(a.in[I_WGU2], DM, 2 * DFF, WSP(bf16, WS_WGU2), scr, r, F.lane); continue; } r -= I_GU;
        if (r < I_D) { p0_transpose_item<0>(a.in[I_WD1], DFF, DM, WSP(bf16, WS_WD1), scr, r, F.lane); continue; } r -= I_D;
        if (r < I_D) { p0_transpose_item<0>(a.in[I_WD2], DFF, DM, WSP(bf16, WS_WD2), scr, r, F.lane); continue; } r -= I_D;
        if (r < I_IN) { p0_transpose_item<2>(a.in[I_WIN], DM, DIN, WSP(bf16, WS_WIN), scr, r, F.lane); continue; } r -= I_IN;
        if (r < I_O) { p0_transpose_item<0>(a.in[I_WOUT], DM, DM, WSP(bf16, WS_WOUT), scr, r, F.lane); continue; } r -= I_O;
        if (r < I_PAD) { v4u* p = (v4u*)(WSP(bf16, WS_WIN) + (size_t)2336 * DM) + (size_t)r * 64 + F.lane; *p = (v4u){0u, 0u, 0u, 0u}; continue; } r -= I_PAD;
        if (r < I_W1) { p0_transpose_item<0>(a.in[I_WCK1], 2048, 128, WSP(bf16, WS_W1T), scr, r, F.lane); continue; } r -= I_W1;
        if (r < I_W1) { p0_transpose_item<0>(a.in[I_WCV1], 2048, 128, WSP(bf16, WS_W1T) + 128 * 2048, scr, r, F.lane); continue; } r -= I_W1;
        {
            const int which = r >> 5, ch = (r >> 4) & 1, kc = r & 15; const float* w1 = a.in[which ? I_WCV1 : I_WCK1] + (size_t)(kc * 128) * 128 + ch * 64 + F.lane; const float* pe = a.in[which ? I_PEV : I_PEK] + kc * 128;
            float s = 0.f;
#pragma unroll 16
            for (int k = 0; k < 128; ++k) s += pe[k] * w1[(size_t)k * 128];
            WSP(float, WS_B1P)[kc * 256 + which * 128 + ch * 64 + F.lane] = s; }
    }
}
template <bool FROM_PARTIALS> __device__ __forceinline__ void norm_mod_pass(const Args& a, const Frame& F, const float* src, bf16* dst, const float* gvec, int sub) {
    LAS float* CA = (LAS float*)(F.lds + RING_OFF); LAS float* CB = CA + DM;
    const float* modp = WSP(const float, WS_MODP); float* mod = WSP(float, WS_MOD); const float* bada = a.in[I_BADA];
    if (FROM_PARTIALS) {
        for (int i = F.bid * 512 + F.tid; i < 9216; i += F.G * 512) { float s = bada[i];
#pragma unroll
            for (int k = 0; k < 16; ++k) s += modp[k * 9216 + i];
            mod[i] = s; }
    }
    for (int c = F.tid; c < 2 * DM; c += 512) {
        const int i = 3 * sub * DM + c; float s;
        if (FROM_PARTIALS) { s = bada[i];
#pragma unroll
            for (int k = 0; k < 16; ++k) s += modp[k * 9216 + i]; }
        else s = mod[i];
        if (c < DM) CB[c] = s; else CA[c - DM] = gvec[c - DM] * (1.0f + s);
    }
    __syncthreads();
    const int gw = F.bid * NWAVES + F.wave, NGW = F.G * NWAVES;
    for (int m = gw; m < SEQ; m += NGW) {
        const f32x4* xr = (const f32x4*)(src + (size_t)m * DM) + F.lane;
        f32x4 v[4]; float s = 0.f;
#pragma unroll
        for (int j = 0; j < 4; ++j) { v[j] = xr[64 * j]; s += (v[j].x * v[j].x + v[j].y * v[j].y) + (v[j].z * v[j].z + v[j].w * v[j].w); }
        const float rstd = 1.0f / sqrtf(wave_sum(s) * (1.0f / DM) + EPS);
        unsigned long long* o8 = (unsigned long long*)(dst + (size_t)m * DM) + F.lane;
#pragma unroll
        for (int j = 0; j < 4; ++j) { const f32x4 ca = *(const LAS f32x4*)(CA + 256 * j + 4 * F.lane), cb = *(const LAS f32x4*)(CB + 256 * j + 4 * F.lane);
            const f32x4 h = v[j] * rstd * ca + cb;
            o8[64 * j] = (unsigned long long)pk2(h.x, h.y) | ((unsigned long long)pk2(h.z, h.w) << 32); }
    }
    __syncthreads();
}
__device__ __forceinline__ void final_norm_pass(const Args& a, const Frame& F) {
    const int gw = F.bid * NWAVES + F.wave, NGW = F.G * NWAVES; const float* g = a.in[I_GFIN];
    f32x4 gv[4];
#pragma unroll
    for (int j = 0; j < 4; ++j) gv[j] = *((const f32x4*)g + 64 * j + F.lane);
    for (int m = gw; m < SEQ; m += NGW) {
        f32x4* xr = (f32x4*)(a.out + (size_t)m * DM) + F.lane;
        f32x4 v[4]; float s = 0.f;
#pragma unroll
        for (int j = 0; j < 4; ++j) { v[j] = xr[64 * j]; s += (v[j].x * v[j].x + v[j].y * v[j].y) + (v[j].z * v[j].z + v[j].w * v[j].w); }
        const float rstd = 1.0f / sqrtf(wave_sum(s) * (1.0f / DM) + EPS);
#pragma unroll
        for (int j = 0; j < 4; ++j) xr[64 * j] = v[j] * rstd * gv[j];
    }
}
__device__ __forceinline__ float wave_sum_dpp(float v) {
    v += __builtin_bit_cast(float, __builtin_amdgcn_update_dpp(0, __builtin_bit_cast(int, v), 0xB1, 0xf, 0xf, false));
    v += __builtin_bit_cast(float, __builtin_amdgcn_update_dpp(0, __builtin_bit_cast(int, v), 0x4E, 0xf, 0xf, false));
    v += __builtin_bit_cast(float, __builtin_amdgcn_update_dpp(0, __builtin_bit_cast(int, v), 0x124, 0xf, 0xf, false));
    v += __builtin_bit_cast(float, __builtin_amdgcn_update_dpp(0, __builtin_bit_cast(int, v), 0x128, 0xf, 0xf, false));
    v += __shfl_xor(v, 16); v += __shfl_xor(v, 32); return v;
}
__device__ __forceinline__ void conv_phase(const Args& a, const Frame& F) {
    LAS float* WL = (LAS float*)(F.lds + RING_OFF);
    LAS bf16* TL = (LAS bf16*)(F.lds + RING_OFF + 63488);
    for (int i = F.tid; i < CONVW * DCONV; i += 512) WL[i] = a.in[I_WDW][i];
    const bf16* HG = WSP(const bf16, WS_HG); bf16* Y = WSP(bf16, WS_HB);
    const int c0 = 8 * F.lane;
    float bd[8], lg[8], lb[8];
#pragma unroll
    for (int e = 0; e < 8; ++e) { bd[e] = a.in[I_BDW][c0 + e]; lg[e] = a.in[I_LNG][c0 + e]; lb[e] = a.in[I_LNB][c0 + e]; }
    const int ntile_ = (SEQ / 64) * (a.probe == 206 ? 2 : 1);
    for (int tile_ = F.bid; tile_ < ntile_; tile_ += F.G) {
        const int tile = tile_ & (SEQ / 64 - 1), t0 = 64 * tile;
        __syncthreads();
        for (int i = F.tid; i < 94 * 64; i += 512) { const int rr = i >> 6, ch = i & 63, tok = t0 - 30 + rr;
            v4u v = (v4u){0u, 0u, 0u, 0u}; if (tok >= 0) v = *(const v4u*)(HG + (size_t)tok * DCONV + ch * 8);
            *(LAS v4u*)(TL + rr * DCONV + ch * 8) = v; }
        __syncthreads();
        const LAS bf16* tw = TL + (8 * F.wave) * DCONV + c0;
        float acc[8][8], hw[8][8];
#pragma unroll
        for (int j = 0; j < 8; ++j)
#pragma unroll
            for (int e = 0; e < 8; ++e) acc[j][e] = bd[e];
#pragma unroll
        for (int m = 0; m < 8; ++m) { const v4u h = *(const LAS v4u*)(tw + m * DCONV);
            hw[m][0] = bflo(h.x); hw[m][1] = bfhi(h.x); hw[m][2] = bflo(h.y); hw[m][3] = bfhi(h.y); hw[m][4] = bflo(h.z); hw[m][5] = bfhi(h.z); hw[m][6] = bflo(h.w); hw[m][7] = bfhi(h.w); }
        for (int k = 0; k < CONVW; ++k) {
            const f32x4 w0 = *(const LAS f32x4*)(WL + k * DCONV + c0), w1 = *(const LAS f32x4*)(WL + k * DCONV + c0 + 4);
            const int kn = k + 8 < 38 ? k + 8 : 37; const v4u h = *(const LAS v4u*)(tw + kn * DCONV);
#pragma unroll
            for (int j = 0; j < 8; ++j) {
                acc[j][0] += hw[j][0] * w0.x; acc[j][1] += hw[j][1] * w0.y; acc[j][2] += hw[j][2] * w0.z; acc[j][3] += hw[j][3] * w0.w;
                acc[j][4] += hw[j][4] * w1.x; acc[j][5] += hw[j][5] * w1.y; acc[j][6] += hw[j][6] * w1.z; acc[j][7] += hw[j][7] * w1.w; }
#pragma unroll
            for (int j = 0; j < 7; ++j)
#pragma unroll
                for (int e = 0; e < 8; ++e) hw[j][e] = hw[j + 1][e];
            hw[7][0] = bflo(h.x); hw[7][1] = bfhi(h.x); hw[7][2] = bflo(h.y); hw[7][3] = bfhi(h.y); hw[7][4] = bflo(h.z); hw[7][5] = bfhi(h.z); hw[7][6] = bflo(h.w); hw[7][7] = bfhi(h.w);
        }
#pragma unroll
        for (int j = 0; j < 8; ++j) {
            float s = 0.f;
#pragma unroll
            for (int e = 0; e < 8; ++e) s += acc[j][e];
            const float mu = wave_sum_dpp(s) * (1.0f / DCONV); float q = 0.f;
#pragma unroll
            for (int e = 0; e < 8; ++e) { acc[j][e] -= mu; q += acc[j][e] * acc[j][e]; }
            const float rstd = 1.0f / sqrtf(wave_sum_dpp(q) * (1.0f / DCONV) + EPS);
            float o[8];
#pragma unroll
            for (int e = 0; e < 8; ++e) o[e] = silu_f(acc[j][e] * rstd * lg[e] + lb[e]);
            v4u w; w.x = pk2(o[0], o[1]); w.y = pk2(o[2], o[3]); w.z = pk2(o[4], o[5]); w.w = pk2(o[6], o[7]);
            *(v4u*)(Y + (size_t)(t0 + 8 * F.wave + j) * DM + c0) = w;
        }
    }
    __syncthreads();
}
__device__ __forceinline__ void compress_phase(const Args& a, const Frame& F) {
    LAS bf16* SL = (LAS bf16*)(F.lds + RING_OFF);
    LAS float* W2L = (LAS float*)(F.lds + RING_OFF + 39168);
    LAS float* HID = (LAS float*)(F.lds + RING_OFF + 39168 + 32768);
    LAS float* B1 = HID + 2048;
    const bf16* KV = WSP(const bf16, WS_KV);
    const int lane = F.lane, wave = F.wave, col = lane & 15, q4 = lane >> 4;
    const int ntask_ = 256 * (a.probe == 208 ? 2 : 1);
    for (int task_ = F.bid; task_ < ntask_; task_ += F.G) {
        const int task = task_ & 255, which = task >> 7, g = (task >> 6) & 1, ng = task & 63, n0 = 16 * ng;
        const float* w2 = a.in[which ? I_WCV2 : I_WCK2];
        const bf16* W1T = WSP(const bf16, WS_W1T) + (size_t)which * 128 * 2048;
        const int coff = which * 128 + g * 64;
        __syncthreads();
        for (int i = F.tid; i < 272 * 8; i += 512) { const int tok = 16 * n0 + (i >> 3), ch = i & 7;
            v4u v = (v4u){0u, 0u, 0u, 0u}; if (tok < SEQ) v = *(const v4u*)(KV + (size_t)tok * 768 + coff + ch * 8);
            *(LAS v4u*)(SL + (i >> 3) * 72 + ch * 8) = v; }
        for (int i = F.tid; i < 128 * 64; i += 512) W2L[i] = w2[i];
        if (F.tid < 128) { float s = 0.f; const float* bp = WSP(const float, WS_B1P) + which * 128 + F.tid;
#pragma unroll
            for (int k = 0; k < 16; ++k) s += bp[k * 256];
            B1[F.tid] = s; }
        __syncthreads();
        f32x4 acc = (f32x4){0.f, 0.f, 0.f, 0.f};
        const bf16* bp = W1T + (size_t)(16 * wave + col) * 2048 + 8 * q4;
        const LAS bf16* ap = SL + (16 * col) * 72 + 8 * q4;
#pragma unroll 8
        for (int ks = 0; ks < 64; ++ks) { const int l = ks >> 1, d0 = (ks & 1) * 32;
            const bf16x8 bfr = *(const bf16x8*)(bp + ks * 32);
            const bf16x8 afr = *(const LAS bf16x8*)(ap + l * 72 + d0);
            acc = __builtin_amdgcn_mfma_f32_16x16x32_bf16(afr, bfr, acc, 0, 0, 0); }
#pragma unroll
        for (int e = 0; e < 4; ++e) HID[(4 * q4 + e) * 128 + 16 * wave + col] = silu_f(acc[e] + B1[16 * wave + col]);
        __syncthreads();
        for (int i = F.tid; i < 16 * 64; i += 512) { const int r = i >> 6, e = i & 63; float s = 0.f;
#pragma unroll 8
            for (int j = 0; j < CMP_HID; ++j) s += HID[r * 128 + j] * W2L[j * 64 + e];
            const int n = n0 + r; const unsigned ob = n < NCMP ? f2bf(s) : 0u;
            if (which == 0) { WSP(bf16, WS_KCMP)[(size_t)n * 128 + g * 64 + e] = (bf16)ob; const float v = __uint_as_float(ob << 16), nn = wave_sum(v * v);
                if (F.lane == 0) atomicMax(WSP(unsigned, WS_CTL) + CW_KMAX + g, __float_as_uint(nn)); }
            else WSP(bf16, WS_VCT)[(size_t)((g * 16 + (n >> 6)) * 64 + e) * 64 + vt_perm(n & 63)] = (bf16)ob; }
    }
    __syncthreads();
}
__device__ __forceinline__ void kv_prep_phase(const Args& a, const Frame& F) {
    const bf16* KV = WSP(const bf16, WS_KV); bf16* VT = WSP(bf16, WS_VT2);
    LAS bf16* T = (LAS bf16*)(F.lds + RING_OFF + F.wave * 8704);
    const int gw = F.bid * NWAVES + F.wave, NGW = F.G * NWAVES, lane = F.lane;
    const int nprep_ = 1024 * (a.probe == 207 ? 2 : 1);
    for (int task_ = gw; task_ < nprep_; task_ += NGW) {
        const int task = task_ & 1023, tv = task >> 9, g = (task >> 8) & 1, j = task & 255, voff = (tv ? 640 : 384) + g * 64;
#pragma unroll
        for (int it = 0; it < 8; ++it) { const int r = it * 8 + (lane >> 3), c = lane & 7;
            const v4u v = *(const v4u*)(KV + (size_t)(64 * j + r) * 768 + voff + 8 * c);
            LAS unsigned* d = (LAS unsigned*)(T + r * 68 + 8 * c); d[0] = v.x; d[1] = v.y; d[2] = v.z; d[3] = v.w; }
        asm volatile("s_waitcnt lgkmcnt(0)" ::: "memory");
        bf16* O = VT + (size_t)((tv * 2 + g) * 256 + j) * 4096;
#pragma unroll
        for (int it = 0; it < 8; ++it) { const int d = it * 8 + (lane >> 3), c = lane & 7; unsigned w[4];
#pragma unroll
            for (int e = 0; e < 4; ++e) { const int r0 = vt_iperm(8 * c + 2 * e), r1 = vt_iperm(8 * c + 2 * e + 1); w[e] = (unsigned)T[r0 * 68 + d] | ((unsigned)T[r1 * 68 + d] << 16); }
            *(v4u*)(O + d * 64 + 8 * c) = (v4u){w[0], w[1], w[2], w[3]}; }
        asm volatile("s_waitcnt lgkmcnt(0)" ::: "memory");
    }
    unsigned* kmx = WSP(unsigned, WS_CTL) + CW_KMAX;
    for (int task = gw; task < 4 * (SEQ / 64); task += NGW) {
        const int wh = task & 3, tb = task >> 2, tok = tb * 64 + lane;
        const v4u* p = (const v4u*)(KV + (size_t)tok * 768 + (wh >> 1 ? 512 : 256) + (wh & 1) * 64); float s = 0.f;
#pragma unroll
        for (int c = 0; c < 8; ++c) { const v4u w = p[c]; s += bflo(w.x) * bflo(w.x) + bfhi(w.x) * bfhi(w.x) + bflo(w.y) * bflo(w.y) + bfhi(w.y) * bfhi(w.y) + bflo(w.z) * bflo(w.z) + bfhi(w.z) * bfhi(w.z) + bflo(w.w) * bflo(w.w) + bfhi(w.w) * bfhi(w.w); }
        s = wave_max(s);
        if (lane == 0) atomicMax(kmx + 2 + wh, __float_as_uint(s));
    }
    __syncthreads();
}
constexpr float LOG2E = 1.4426950408889634f;
constexpr int A2_IMP = 0;
constexpr int A2_MB = 65536;
constexpr int A2_SELB = A2_MB + 3072;
constexpr int A2_BL = A2_SELB + 2048;
constexpr int A2_STG = A2_BL + 2048;
constexpr int RB = 4, STG_V = 8192, STG_BUF = 16384;
constexpr int A2_END = A2_STG + RB * STG_BUF;
static_assert(A2_END <= MISC_OFF, "attention LDS map");
constexpr size_t WS_TOT = 212 * MiB;
static_assert(WS_TOT + (size_t)256 * 65536 <= WS_ACT_END && WS_VCT + 2 * 16 * 64 * 64 * 2 <= WS_TOT, "ws map (attention)");
typedef __attribute__((address_space(3))) float lds_f32;
#define DPP_F(v, ctrl) __builtin_bit_cast(float, __builtin_amdgcn_update_dpp(0, __builtin_bit_cast(int, (v)), (ctrl), 0xf, 0xf, false))
#define DPP_I(v, ctrl) __builtin_amdgcn_update_dpp(0, (v), (ctrl), 0xf, 0xf, false)

struct AttnFrag { bf16x8 k[4][2], v[4][2]; };
template <bool WITH_V> __device__ __forceinline__ void dma_issue(LAS unsigned char* buf, const bf16* Kblk, int kp, const bf16* VTblk, int wave, int lane) {
    const int row = 8 * wave + (lane >> 3), c = (lane & 7) ^ (row & 7);
    __builtin_amdgcn_global_load_lds((const unsigned*)(Kblk + (size_t)row * kp + c * 8), (LAS unsigned*)(buf + wave * 1024), 16, 0, 0);
    if (WITH_V) __builtin_amdgcn_global_load_lds((const unsigned*)(VTblk + row * 64 + c * 8), (LAS unsigned*)(buf + STG_V + wave * 1024), 16, 0, 0);
}
template <bool WITH_V> __device__ __forceinline__ void frag_from_lds(AttnFrag& f, const LAS unsigned char* buf, int col, int q4) {
    const int sw = col & 7;
#pragma unroll
    for (int kt = 0; kt < 4; ++kt)
#pragma unroll
        for (int ks = 0; ks < 2; ++ks) f.k[kt][ks] = *(const LAS bf16x8*)(buf + (16 * kt + col) * 128 + (((4 * ks + q4) ^ sw) * 16));
    if (WITH_V) {
#pragma unroll
        for (int dt = 0; dt < 4; ++dt)
#pragma unroll
            for (int ks = 0; ks < 2; ++ks) f.v[dt][ks] = *(const LAS bf16x8*)(buf + STG_V + (16 * dt + col) * 128 + (((4 * ks + q4) ^ sw) * 16));
    }
}
#define A2_WAITBAR(n) do { asm volatile("s_waitcnt vmcnt(" #n ")" ::: "memory"); __builtin_amdgcn_s_barrier(); asm volatile("" ::: "memory"); } while (0)
template <int BR> __device__ __forceinline__ void attn_probs(f32x4 (&st)[4], const AttnFrag& f, const bf16x8 (&qf)[2], const lds_f32* BLh, float Mb, int t, int kb, int q4, bool far_, bool lsel) {
#pragma unroll
    for (int kt = 0; kt < 4; ++kt) { f32x4 z = (f32x4){0.f, 0.f, 0.f, 0.f};
        z = __builtin_amdgcn_mfma_f32_16x16x32_bf16(f.k[kt][0], qf[0], z, 0, 0, 0); st[kt] = __builtin_amdgcn_mfma_f32_16x16x32_bf16(f.k[kt][1], qf[1], z, 0, 0, 0); }
    if (far_) { const float c = lsel ? BLh[127] - Mb : -__builtin_inff();
#pragma unroll
        for (int kt = 0; kt < 4; ++kt)
#pragma unroll
            for (int e = 0; e < 4; ++e) st[kt][e] = __builtin_amdgcn_exp2f(st[kt][e] + c);
    } else {
#pragma unroll
        for (int kt = 0; kt < 4; ++kt)
#pragma unroll
            for (int e = 0; e < 4; ++e) { const int k = kb + 16 * kt + 4 * q4 + e; const int dist = BR < 2 ? t - 16 * k - 31 : t - k;
                const bool ok = lsel && dist >= 0 && (BR != 3 || dist < WIN);
                const int dc = dist < 0 ? 0 : (dist > 127 ? 127 : dist);
                const float p = __builtin_amdgcn_exp2f(st[kt][e] + BLh[dc] - Mb); st[kt][e] = ok ? p : 0.f; }
    }
}
struct AttnAcc { f32x4 o[2][4]; float l[2]; };
__device__ __forceinline__ void attn_acc_zero(AttnAcc& A) {
#pragma unroll
    for (int G = 0; G < 2; ++G) { A.l[G] = 0.f;
#pragma unroll
        for (int dt = 0; dt < 4; ++dt) A.o[G][dt] = (f32x4){0.f, 0.f, 0.f, 0.f}; }
}
template <int BR> __device__ __forceinline__ void attn_block2(AttnAcc& A, const AttnFrag& f, const bf16x8 (&qf)[2][2], const lds_f32* BLh, const float (&Mb)[2], const int (&tq)[2], int kb, int q4, bool far_, const bool (&gact)[2], const bool (&lsel)[2]) {
#pragma unroll
    for (int G = 0; G < 2; ++G) {
        if (!gact[G]) continue;
        f32x4 st[4];
        attn_probs<BR>(st, f, qf[G], BLh, Mb[G], tq[G], kb, q4, far_, lsel[G]);
        float ls = 0.f;
#pragma unroll
        for (int kt = 0; kt < 4; ++kt) ls += (st[kt][0] + st[kt][1]) + (st[kt][2] + st[kt][3]);
        A.l[G] += ls;
        bf16x8 pb[2];
#pragma unroll
        for (int ks = 0; ks < 2; ++ks) { v4u w; w.x = pg8::cvt_pk_bf16(st[2 * ks][0], st[2 * ks][1]); w.y = pg8::cvt_pk_bf16(st[2 * ks][2], st[2 * ks][3]);
            w.z = pg8::cvt_pk_bf16(st[2 * ks + 1][0], st[2 * ks + 1][1]); w.w = pg8::cvt_pk_bf16(st[2 * ks + 1][2], st[2 * ks + 1][3]); pb[ks] = __builtin_bit_cast(bf16x8, w); }
#pragma unroll
        for (int dt = 0; dt < 4; ++dt) { A.o[G][dt] = __builtin_amdgcn_mfma_f32_16x16x32_bf16(f.v[dt][0], pb[0], A.o[G][dt], 0, 0, 0); A.o[G][dt] = __builtin_amdgcn_mfma_f32_16x16x32_bf16(f.v[dt][1], pb[1], A.o[G][dt], 0, 0, 0); }
    }
}
template <int MODE> __device__ __forceinline__ void attn_fold(const AttnAcc& A, float* tot  , const float (&gate)[2], float (&il)[2], bf16* const (&yp)[2]) {
#pragma unroll
    for (int G = 0; G < 2; ++G) { float ls = A.l[G]; ls += __shfl_xor(ls, 16); ls += __shfl_xor(ls, 32);
        il[G] = 1.0f / fmaxf(ls, 1e-30f); const float sc = gate[G] * il[G];
#pragma unroll
        for (int dt = 0; dt < 4; ++dt) { f32x4* tp = (f32x4*)(tot + (G * 4 + dt) * 256); f32x4 v = A.o[G][dt] * sc;
            if (MODE != 0) v += *tp;
            if (MODE != 2) *tp = v;
            else { v2u w; w.x = pk2(v[0], v[1]); w.y = pk2(v[2], v[3]); *(v2u*)(yp[G] + 16 * dt) = w; } } }
}
__device__ __noinline__ void attn_topk(LAS unsigned char* L, int wave, int lane, int cur) {
    const lds_f32* IMP = (const lds_f32*)(L + A2_IMP); LAS unsigned* SELB = (LAS unsigned*)(L + A2_SELB);
    const int sub = lane & 15;
    for (int pass = 0; pass < 2; ++pass) {
        const int q = wave * 8 + pass * 4 + (lane >> 4);
        unsigned word = 0u;
        if (cur < 16) { if (sub == 0) word = (cur >= 31) ? 0xffffffffu : ((1u << (cur + 1)) - 1u); }
        else {
            float v[16];
#pragma unroll
            for (int i = 0; i < 16; ++i) { const int J = 16 * i + sub; v[i] = (J >= 1 && J <= cur - 2) ? IMP[q * 256 + J] : -1.0f; }
            for (int r = 0; r < 13; ++r) {
                float m = v[0];
#pragma unroll
                for (int i = 1; i < 16; ++i) m = fmaxf(m, v[i]);
                m = fmaxf(m, DPP_F(m, 0x128)); m = fmaxf(m, DPP_F(m, 0x124)); m = fmaxf(m, DPP_F(m, 0x122)); m = fmaxf(m, DPP_F(m, 0x121));
                int c = 999;
#pragma unroll
                for (int i = 15; i >= 0; --i) c = (v[i] == m) ? 16 * i + sub : c;
                { int o = DPP_I(c, 0x128); c = o < c ? o : c; o = DPP_I(c, 0x124); c = o < c ? o : c; o = DPP_I(c, 0x122); c = o < c ? o : c; o = DPP_I(c, 0x121); c = o < c ? o : c; }
#pragma unroll
                for (int i = 0; i < 16; ++i) v[i] = (16 * i + sub == c) ? -2.0f : v[i];
                if ((c >> 5) == sub) word |= 1u << (c & 31);
            }
            if (sub == 0) word |= 1u;
            if (((cur - 1) >> 5) == sub) word |= 1u << ((cur - 1) & 31);
            if ((cur >> 5) == sub) word |= 1u << (cur & 31);
        }
        if (sub < 8) SELB[q * 8 + sub] = word;
    }
}

__device__ __forceinline__ void attn2_phase(const Args& a, const Frame& F) {
    LAS unsigned char* L = F.lds + RING_OFF;
    const bf16* Q = WSP(const bf16, WS_Q); const bf16* KV = WSP(const bf16, WS_KV); const bf16* KC = WSP(const bf16, WS_KCMP);
    const bf16* VT = WSP(const bf16, WS_VT2); const bf16* VCT = WSP(const bf16, WS_VCT); const float* GT = WSP(const float, WS_GT); bf16* Y = WSP(bf16, WS_HB);
    const unsigned* kmx = WSP(const unsigned, WS_CTL) + CW_KMAX;
    const int tid = F.tid, lane = F.lane, wave = F.wave, col = lane & 15, q4 = lane >> 4, hh = col & 3;
    float* tot = WSP(float, WS_TOT) + (size_t)F.bid * 16384 + wave * 2048 + lane * 4;
    LAS unsigned char* STG = L + A2_STG;
    for (int uu0 = F.bid; uu0 < 2 * NSLC; uu0 += F.G) {
        const int rnd = uu0 / F.G, ix = uu0 - rnd * F.G;
        int cur, g;
        if (F.G == NSLC) { g = ix & 1; cur = rnd ? NSLC - 1 - (ix >> 1) : (ix >> 1); }
        else { cur = uu0 >> 1; g = uu0 & 1; }
        const int t0 = 64 * cur;
        const bf16* Qg = Q + (size_t)t0 * 512 + g * 256;
        lds_f32* BL = (lds_f32*)(L + A2_BL); lds_f32* MB = (lds_f32*)(L + A2_MB);
        { const int h = tid >> 7, d = tid & 127; BL[tid] = LOG2E * a.in[I_RELB][(g * 4 + h) * 32 + T5_BUCKET[d]]; }
        __syncthreads();
        {   const int q = tid >> 3, h = (tid & 7) >> 1, d0 = (tid & 1) * 32; const v4u* qp = (const v4u*)(Qg + (size_t)q * 512 + h * 64 + d0); float s = 0.f;
#pragma unroll
            for (int c = 0; c < 4; ++c) { const v4u w = qp[c]; s += bflo(w.x) * bflo(w.x) + bfhi(w.x) * bfhi(w.x) + bflo(w.y) * bflo(w.y) + bfhi(w.y) * bfhi(w.y) + bflo(w.z) * bflo(w.z) + bfhi(w.z) * bfhi(w.z) + bflo(w.w) * bflo(w.w) + bfhi(w.w) * bfhi(w.w); }
            s += __shfl_xor(s, 1); const float qn = sqrtf(s);
            float bm = -3.0e38f;
            for (int d = 0; d < 128; ++d) bm = fmaxf(bm, BL[h * 128 + d]);
            if ((tid & 1) == 0) {
#pragma unroll
                for (int b = 0; b < 3; ++b) MB[b * 256 + q * 4 + h] = qn * sqrtf(__uint_as_float(kmx[2 * b + g])) * 1.001f + bm + 0.5f; }
        }
        __syncthreads();
        const lds_f32* BLh = BL + hh * 128;
        bf16x8 qf[2][2]; int tq[2];
#pragma unroll
        for (int G = 0; G < 2; ++G) { const int q = wave * 8 + G * 4 + (col >> 2); tq[G] = t0 + q;
            const bf16* qp = Qg + (size_t)q * 512 + hh * 64 + 8 * q4; qf[G][0] = *(const bf16x8*)qp; qf[G][1] = *(const bf16x8*)(qp + 32); }
#define A2_LOADM(M, b) float M[2]; _Pragma("unroll") for (int G = 0; G < 2; ++G) M[G] = MB[(b) * 256 + (wave * 8 + G * 4 + (col >> 2)) * 4 + hh]
#define A2_LOADG(gv, b) float gv[2]; _Pragma("unroll") for (int G = 0; G < 2; ++G) gv[G] = GT[(size_t)(t0 + wave * 8 + G * 4 + (col >> 2)) * 24 + (g * 4 + hh) * 3 + (b)]
        const int twlo = t0 + 8 * wave, twhi = twlo + 7;
        const bool all2[2] = {true, true};
        const int tmax = t0 + 63, nvu = tmax >= 31 ? ((tmax - 31) >> 4) + 1 : 0, nbu = (nvu + 63) >> 6;
        float il[2];
        AttnFrag fc; AttnAcc A;
        A2_LOADM(Mc, 0);
        attn_acc_zero(A);
#define KC_BLK(j) (KC + (size_t)(64 * (j)) * 128 + g * 64)
#define VC_BLK(j) (VCT + (size_t)(g * 16 + (j)) * 4096)
        {   const int last = nbu - 1;
#pragma unroll
            for (int p = 0; p < RB - 1; ++p) { const int jb = p < last ? p : last; dma_issue<true>(STG + p * STG_BUF, KC_BLK(jb), 128, VC_BLK(jb), wave, lane); }
            for (int jc = 0; jc < nbu; ++jc) {
                A2_WAITBAR(4);
                { const int jn = jc + RB - 1 < last ? jc + RB - 1 : last; dma_issue<true>(STG + ((jc + RB - 1) % RB) * STG_BUF, KC_BLK(jn), 128, VC_BLK(jn), wave, lane); }
                if (twhi - 16 * (64 * jc) - 31 >= 0) { frag_from_lds<true>(fc, STG + (jc % RB) * STG_BUF, col, q4);
                    attn_block2<0>(A, fc, qf, BLh, Mc, tq, 64 * jc, q4, twlo - 16 * (64 * jc + 63) - 31 >= 113, all2, all2); }
            }
            A2_WAITBAR(0);
        }
        { A2_LOADG(gc, 0); bf16* const ypn[2] = {nullptr, nullptr}; attn_fold<0>(A, tot, gc, il, ypn); }
        __syncthreads();
        if (cur >= 16) {
            lds_f32* IMP = (lds_f32*)(L + A2_IMP);
            float carry[2] = {0.f, 0.f};
            const int last = nbu - 1;
#pragma unroll
            for (int p = 0; p < RB - 1; ++p) { const int jb = p < last ? p : last; dma_issue<false>(STG + p * STG_BUF, KC_BLK(jb), 128, nullptr, wave, lane); }
            for (int jc = 0; jc < nbu; ++jc) {
                A2_WAITBAR(2);
                { const int jn = jc + RB - 1 < last ? jc + RB - 1 : last; dma_issue<false>(STG + ((jc + RB - 1) % RB) * STG_BUF, KC_BLK(jn), 128, nullptr, wave, lane); }
                const LAS unsigned char* buf = STG + (jc % RB) * STG_BUF;
                if (twhi - 16 * (64 * jc) - 31 < 0) continue;
                frag_from_lds<false>(fc, buf, col, q4);
#pragma unroll
                for (int G = 0; G < 2; ++G) { f32x4 st[4];
                    attn_probs<1>(st, fc, qf[G], BLh, Mc[G], tq[G], 64 * jc, q4, twlo - 16 * (64 * jc + 63) - 31 >= 113, true);
                    float s4[4], rot[4];
#pragma unroll
                    for (int kt = 0; kt < 4; ++kt) { float x3 = st[kt][3] * il[G], x4 = (st[kt][0] + st[kt][1] + st[kt][2]) * il[G] + x3;
                        x4 += DPP_F(x4, 0xB1); x4 += DPP_F(x4, 0x4E); x3 += DPP_F(x3, 0xB1); x3 += DPP_F(x3, 0x4E); s4[kt] = x4;
                        rot[kt] = __shfl(x3, (lane + 48) & 63); }
                    const int q = wave * 8 + G * 4 + (col >> 2);
#pragma unroll
                    for (int kt = 0; kt < 4; ++kt) { const float prev = q4 > 0 ? rot[kt] : (kt > 0 ? rot[kt - 1] : carry[G]);
                        if (hh == 0) IMP[q * 256 + 16 * jc + 4 * kt + q4] = s4[kt] + prev; }
                    carry[G] = rot[3];
                }
            }
            A2_WAITBAR(0);
        }
        attn_topk(L, wave, lane, cur);
        {   const LAS unsigned* SELB = (const LAS unsigned*)(L + A2_SELB);
            A2_LOADM(Ms, 1);
            attn_acc_zero(A);
#define KS_BLK(j) (KV + (size_t)(64 * (j)) * 768 + 256 + g * 64)
#define VS_BLK(j) (VT + (size_t)((0 * 2 + g) * 256 + (j)) * 4096)
#define SLC_BUF(b) ((b) < 4 ? STG + (b) * STG_BUF : L + A2_IMP + ((b) - 4) * STG_BUF)
            const int nslot = (cur + 4) >> 2;
#pragma unroll
            for (int p = 0; p < 4; ++p) { const int jb = p < cur ? p : cur; dma_issue<true>(SLC_BUF(p), KS_BLK(jb), 768, VS_BLK(jb), wave, lane); }
            for (int sl = 0; sl < nslot; ++sl) {
                A2_WAITBAR(0);
                if (sl + 1 < nslot) {
#pragma unroll
                    for (int p = 0; p < 4; ++p) { const int jb = 4 * (sl + 1) + p < cur ? 4 * (sl + 1) + p : cur; dma_issue<true>(SLC_BUF(((sl + 1) & 1) * 4 + p), KS_BLK(jb), 768, VS_BLK(jb), wave, lane); }
                }
#pragma unroll
                for (int p = 0; p < 4; ++p) { const int j = 4 * sl + p; if (j > cur) break;
                    const LAS unsigned char* buf = SLC_BUF((sl & 1) * 4 + p);
                    bool lsel[2], gact[2];
#pragma unroll
                    for (int G = 0; G < 2; ++G) { lsel[G] = (SELB[(wave * 8 + G * 4 + (col >> 2)) * 8 + (j >> 5)] >> (j & 31)) & 1u; gact[G] = __ballot(lsel[G]) != 0ull; }
                    if (gact[0] || gact[1]) { frag_from_lds<true>(fc, buf, col, q4);
                        attn_block2<2>(A, fc, qf, BLh, Ms, tq, 64 * j, q4, twlo - (64 * j + 63) >= 113, gact, lsel); }
                }
            }
            A2_WAITBAR(0);
            A2_LOADG(gs, 1); float il2[2]; bf16* const ypn[2] = {nullptr, nullptr}; attn_fold<1>(A, tot, gs, il2, ypn);
        }
        __syncthreads();
        {   const int jlo = cur >= 8 ? cur - 8 : 0;
            A2_LOADM(Mw, 2);
            attn_acc_zero(A);
#define KW_BLK(j) (KV + (size_t)(64 * (j)) * 768 + 512 + g * 64)
#define VW_BLK(j) (VT + (size_t)((1 * 2 + g) * 256 + (j)) * 4096)
#pragma unroll
            for (int p = 0; p < RB - 1; ++p) { const int jb = jlo + p < cur ? jlo + p : cur; dma_issue<true>(STG + p * STG_BUF, KW_BLK(jb), 768, VW_BLK(jb), wave, lane); }
            for (int j = jlo; j <= cur; ++j) {
                A2_WAITBAR(4);
                { const int jn = j + RB - 1 < cur ? j + RB - 1 : cur; dma_issue<true>(STG + ((j - jlo + RB - 1) % RB) * STG_BUF, KW_BLK(jn), 768, VW_BLK(jn), wave, lane); }
                const LAS unsigned char* buf = STG + ((j - jlo) % RB) * STG_BUF;
                if (64 * j <= twhi && 64 * j + 63 >= twlo - (WIN - 1)) { frag_from_lds<true>(fc, buf, col, q4);
                    attn_block2<3>(A, fc, qf, BLh, Mw, tq, 64 * j, q4, (twlo - (64 * j + 63) >= 113) && (twhi - 64 * j < WIN), all2, all2); }
            }
            A2_WAITBAR(0);
            A2_LOADG(gw, 2); float il2[2]; bf16* yp[2];
#pragma unroll
            for (int G = 0; G < 2; ++G) yp[G] = Y + (size_t)(t0 + wave * 8 + G * 4 + (col >> 2)) * DM + 512 + (g * 4 + hh) * 64 + 4 * q4;
            attn_fold<2>(A, tot, gw, il2, yp);
        }
        __syncthreads();
    }
}
__global__ void __launch_bounds__(NWAVES * 64, 2) fwd_kernel(Args a) {
    extern __shared__ __attribute__((aligned(16))) unsigned char lds[];
    Frame F;
    F.lds = (LAS unsigned char*)lds;
    F.tid = threadIdx.x; F.lane = F.tid & 63; F.wave = __builtin_amdgcn_readfirstlane(F.tid >> 6);
    F.G = gridDim.x; F.bid = blockIdx.x;
    volatile LAS unsigned* MISC = (volatile LAS unsigned*)(F.lds + MISC_OFF);
    for (int u = F.tid; u < (LDS_BYTES - LDSCTL_OFF) / 4; u += NWAVES * 64) ((LAS unsigned*)(F.lds + LDSCTL_OFF))[u] = 0u;
    __syncthreads();
    const int lo = a.ph_lo, hi = a.ph_hi;
    const bool multi = (hi - lo) > 1;
    unsigned* barw = WSP(unsigned, WS_CTL) + CW_BAR;
    XcdBarrier bar; bar.bar = barw; bar.x = 0; bar.st = MISC + 8;
    if (multi) bar = xcd_barrier_post(barw, MISC + 8);
#define IN(k) (lo <= (k) && (k) < hi)
#ifdef PROBE_MODE
#define REPS(k) ((PROBE_MODE == 100 + (k)) ? (a.probe == PROBE_MODE ? 2 : 1) : 1)
#else
#define REPS(k) 1
#endif
#define SEAM(k) do { if (IN(k) && IN((k) + 1)) xcd_barrier(bar); } while (0)
    PG8_LAS unsigned char* ring = F.lds + RING_OFF;

    if (IN(0)) for (int rep_ = 0; rep_ < REPS(0); ++rep_) { if (rep_) xcd_barrier(bar); p0_prologue(a, F); } SEAM(0);
    if (IN(1)) for (int rep_ = 0; rep_ < REPS(1); ++rep_) { if (rep_) xcd_barrier(bar); norm_mod_pass<true>(a, F, a.in[I_X], WSP(bf16, WS_HB), a.in[I_GFFN1], 0); } SEAM(1);
    if (IN(2)) for (int rep_ = 0; rep_ < REPS(2); ++rep_) { if (rep_) xcd_barrier(bar);
        pg8::Gemm g{WSP(const bf16, WS_HB), WSP(const bf16, WS_WGU1), SEQ, 2 * DFF, DM}; pg8::StaticOrder S; S.init(SEQ, 2 * DFF, F.G, F.bid);
        pg8::EpiSwiGLU E{WSP(bf16, WS_ACT), DFF};
        pg8::gemm_phase<pg8::EpiSwiGLU, pg8::StaticOrder, PG8_ALIGN, PG8_SP2>(ring, g, S, E);
    } SEAM(2);
    if (IN(3)) for (int rep_ = 0; rep_ < REPS(3); ++rep_) { if (rep_) xcd_barrier(bar);
        pg8::Gemm g{WSP(const bf16, WS_ACT), WSP(const bf16, WS_WD1), SEQ, DM, DFF}; pg8::StaticOrder S; S.init(SEQ, DM, F.G, F.bid);
        pg8::EpiResid E{a.in[I_X], WSP(float, WS_XB), DM, WSP(const float, WS_MOD) + 2 * DM, 0.5f};
        pg8::gemm_phase<pg8::EpiResid, pg8::StaticOrder, false, PG8_SP2>(ring, g, S, E);
    } SEAM(3);
    if (IN(4)) for (int rep_ = 0; rep_ < REPS(4); ++rep_) { if (rep_) xcd_barrier(bar); norm_mod_pass<false>(a, F, WSP(const float, WS_XB), WSP(bf16, WS_HB), a.in[I_GMIX], 1); } SEAM(4);
    if (IN(5)) for (int rep_ = 0; rep_ < REPS(5); ++rep_) { if (rep_) xcd_barrier(bar);
        pg8::Gemm g{WSP(const bf16, WS_HB), WSP(const bf16, WS_WIN), SEQ, DIN_PAD, DM}; pg8::StaticOrder S; S.init(SEQ, DIN_PAD, F.G, F.bid);
        pg8::EpiMix E{WSP(bf16, WS_HG), WSP(bf16, WS_Q), WSP(bf16, WS_KV), WSP(float, WS_GT)};
        pg8::gemm_phase<pg8::EpiMix, pg8::StaticOrder, PG8_ALIGN, PG8_SP2>(ring, g, S, E);
    } SEAM(5);
    if (IN(6)) for (int rep_ = 0; rep_ < REPS(6); ++rep_) { if (rep_) xcd_barrier(bar); conv_phase(a, F); kv_prep_phase(a, F); compress_phase(a, F); } SEAM(6);
    if (IN(7)) for (int rep_ = 0; rep_ < REPS(7); ++rep_) { if (rep_) xcd_barrier(bar); attn2_phase(a, F); } SEAM(7);
    if (IN(8)) for (int rep_ = 0; rep_ < REPS(8); ++rep_) { if (rep_) xcd_barrier(bar);
        pg8::Gemm g{WSP(const bf16, WS_HB), WSP(const bf16, WS_WOUT), SEQ, DM, DM}; pg8::StaticOrder S; S.init(SEQ, DM, F.G, F.bid);
        pg8::EpiResid E{WSP(const float, WS_XB), WSP(float, WS_XB), DM, WSP(const float, WS_MOD) + 5 * DM, 1.0f};
        pg8::gemm_phase<pg8::EpiResid, pg8::StaticOrder, false, PG8_SP2>(ring, g, S, E);
    } SEAM(8);
    if (IN(9)) for (int rep_ = 0; rep_ < REPS(9); ++rep_) { if (rep_) xcd_barrier(bar); norm_mod_pass<false>(a, F, WSP(const float, WS_XB), WSP(bf16, WS_HB), a.in[I_GFFN2], 2); } SEAM(9);
    if (IN(10)) for (int rep_ = 0; rep_ < REPS(10); ++rep_) { if (rep_) xcd_barrier(bar);
        pg8::Gemm g{WSP(const bf16, WS_HB), WSP(const bf16, WS_WGU2), SEQ, 2 * DFF, DM}; pg8::StaticOrder S; S.init(SEQ, 2 * DFF, F.G, F.bid);
        pg8::EpiSwiGLU E{WSP(bf16, WS_ACT), DFF};
        pg8::gemm_phase<pg8::EpiSwiGLU, pg8::StaticOrder, PG8_ALIGN, PG8_SP2>(ring, g, S, E);
    } SEAM(10);
    if (IN(11)) for (int rep_ = 0; rep_ < REPS(11); ++rep_) { if (rep_) xcd_barrier(bar);
        pg8::Gemm g{WSP(const bf16, WS_ACT), WSP(const bf16, WS_WD2), SEQ, DM, DFF}; pg8::StaticOrder S; S.init(SEQ, DM, F.G, F.bid);
        pg8::EpiResid E{WSP(const float, WS_XB), a.out, DM, WSP(const float, WS_MOD) + 8 * DM, 0.5f};
        pg8::gemm_phase<pg8::EpiResid, pg8::StaticOrder, false, PG8_SP2>(ring, g, S, E);
    } SEAM(11);
    if (IN(12)) for (int rep_ = 0; rep_ < REPS(12); ++rep_) { if (rep_) xcd_barrier(bar); final_norm_pass(a, F); }
#undef IN
#undef SEAM
}

extern "C" void kernel_launch(void* const* d_in, const int* in_sizes, int n_in, void* d_out, int out_size, void* d_ws, size_t ws_size, hipStream_t stream) {
    static int grid = 0;
    if (grid == 0) {
        if (n_in != N_IN || in_sizes[0] != SEQ * DM || out_size != SEQ * DM || ws_size < WS_END) { fprintf(stderr, "kernel_launch: unexpected problem shape (n_in %d, ws %zu); nothing launched\n", n_in, ws_size); grid = -1; return; }
        int dev = 0, cus = 0, per_cu = 0;
        if (hipGetDevice(&dev) != hipSuccess || hipDeviceGetAttribute(&cus, hipDeviceAttributeMultiprocessorCount, dev) != hipSuccess) { grid = -1; return; }
        if (hipFuncSetAttribute((const void*)fwd_kernel, hipFuncAttributeMaxDynamicSharedMemorySize, LDS_BYTES) != hipSuccess) { fprintf(stderr, "kernel_launch: hipFuncSetAttribute failed\n"); grid = -1; return; }
        if (hipOccupancyMaxActiveBlocksPerMultiprocessor(&per_cu, (const void*)fwd_kernel, NWAVES * 64, LDS_BYTES) != hipSuccess || per_cu < 1)
            fprintf(stderr, "kernel_launch: note: occupancy query reports %d workgroups per CU\n", per_cu);
        (void)hipGetLastError();
        grid = cus;
    }
    if (grid < 0) return;
    if (hipMemsetAsync((char*)d_ws + WS_CTL, 0, CTL_ZERO_BYTES, stream) != hipSuccess) return;
    Args a{};
    for (int i = 0; i < N_IN; ++i) a.in[i] = (const float*)d_in[i];
    a.out = (float*)d_out; a.ws = (unsigned char*)d_ws;
#ifdef PROBE_MODE
    a.probe = PROBE_MODE;
#endif
#if MK_LAUNCHES == 1
    a.ph_lo = 0; a.ph_hi = N_PHASES;
    hipLaunchKernelGGL(fwd_kernel, dim3(grid), dim3(NWAVES * 64), LDS_BYTES, stream, a);
#else
    for (int p = 0; p < N_PHASES; ++p) { a.ph_lo = p; a.ph_hi = p + 1; hipLaunchKernelGGL(fwd_kernel, dim3(grid), dim3(NWAVES * 64), LDS_BYTES, stream, a); }
#endif
}
```
